# Optimizing an MI355X kernel written in HIP

```python
import jax, jax.numpy as jnp
from jax import lax
import numpy as np

D_MODEL = 2048
BATCH = 4
SEQ = 2048
DEPTH = 2
DEC_BATCH = 8
DEC_SEQ = 32
PAST_LEN = 1024

CHUNK = 64
SUB = 16
N_MIXERS = 2
N_HG_LAYERS = (DEPTH + 1) // 2
N_MLA_LAYERS = DEPTH // 2
HG_EXPAND = 128
HG_HEADS = D_MODEL // HG_EXPAND
HG_DK = HG_EXPAND
HG_DV = D_MODEL // HG_HEADS
HG_DIM = HG_HEADS * HG_DK
MLA_HEADS = 16
Q_LORA = 512
KV_LORA = 512
NOPE_DIM = 128
ROPE_DIM = 64
V_DIM = 128
ROPE_BASE = 10000.0
Q_BLOCK = 128
D_FF = 5632
CONV_K = 3
EPS = 1e-6

kernel_name = 'hybrid_hgrn2_mla_convffn_stream_step'

F32 = jnp.float32


def rms_norm(x, w):
    xf = x.astype(F32)
    y = xf * lax.rsqrt(jnp.mean(xf * xf, axis=-1, keepdims=True) + EPS)
    return (y * w.astype(F32)).astype(x.dtype)


def _gla_chunk(S, inp):
    q, k, v, logf = inp
    B, H, C, dk = q.shape
    ns = C // SUB
    b = jnp.cumsum(logf, axis=2)
    bs = b.reshape(B, H, ns, SUB, dk)
    qs = q.reshape(B, H, ns, SUB, dk)
    ks = k.reshape(B, H, ns, SUB, dk)
    vs = v.reshape(B, H, ns, SUB, -1)
    ref = jnp.concatenate([jnp.zeros_like(bs[:, :, :1, -1]), bs[:, :, :-1, -1]], axis=2)
    q_ref = qs * jnp.exp(bs - ref[:, :, :, None])
    blk = jnp.arange(ns)
    earlier = blk[None, :] < blk[:, None]
    expo = ref[:, :, :, None, None, :] - bs[:, :, None]
    k_ref = ks[:, :, None] * jnp.exp(jnp.where(earlier[:, :, None, None], expo, -jnp.inf))
    a_off = jnp.einsum('bhitk,bhijuk->bhitju', q_ref, k_ref)
    o = jnp.einsum('bhitju,bhjuv->bhitv', a_off, vs)
    pos = jnp.arange(SUB)
    causal = pos[None, :] <= pos[:, None]
    d_expo = bs[:, :, :, :, None, :] - bs[:, :, :, None, :, :]
    decay = jnp.exp(jnp.where(causal[:, :, None], d_expo, -jnp.inf))
    a_diag = jnp.einsum('bhitk,bhituk,bhiuk->bhitu', qs, decay, ks)
    o = o + jnp.einsum('bhitu,bhiuv->bhitv', a_diag, vs)
    o = o.reshape(B, H, C, -1) + jnp.einsum('bhck,bhkv->bhcv', q * jnp.exp(b), S)
    b_last = b[:, :, -1]
    S_new = jnp.exp(b_last)[..., None] * S + jnp.einsum(
        'bhck,bhcv->bhkv', k * jnp.exp(b_last[:, :, None] - b), v)
    return S_new, o


def hgrn2_recurrence(q, k, v, logf, S0):
    B, H, L, _ = q.shape
    n = -(-L // CHUNK)
    padw = ((0, 0), (0, 0), (0, n * CHUNK - L), (0, 0))
    q, k, v, logf = (jnp.pad(t, padw) for t in (q, k, v, logf))
    to_chunks = lambda t: jnp.moveaxis(t.reshape(B, H, n, CHUNK, t.shape[-1]), 2, 0)
    S, o = lax.scan(_gla_chunk, S0, (to_chunks(q), to_chunks(k), to_chunks(v), to_chunks(logf)))
    o = jnp.moveaxis(o, 0, 2).reshape(B, H, n * CHUNK, -1)[:, :, :L]
    return o, S


def hgrn2_mixer(h, S0, w_in, g_norm_w, w_out, lb):
    B, L, _ = h.shape
    q, f, i, g = jnp.split(h @ w_in, 4, axis=-1)
    heads = lambda t, d: t.reshape(B, L, HG_HEADS, d).transpose(0, 2, 1, 3).astype(F32)
    q = jax.nn.silu(heads(q, HG_DK))
    lb = lb.astype(F32).reshape(HG_HEADS, 1, HG_DK)
    fg = lb + (1.0 - lb) * jax.nn.sigmoid(heads(f, HG_DK))
    k = 1.0 - fg
    logf = jnp.log(fg)
    v = heads(i, HG_DV)
    o, S = hgrn2_recurrence(q, k, v, logf, S0.astype(F32))
    o = o.transpose(0, 2, 1, 3)
    o = rms_norm(o, g_norm_w) * jax.nn.silu(g.reshape(B, L, HG_HEADS, HG_DV).astype(F32))
    y = o.reshape(B, L, HG_HEADS * HG_DV).astype(h.dtype) @ w_out
    return y, S.astype(h.dtype)


def rope(x, pos):
    half = ROPE_DIM // 2
    inv = ROPE_BASE ** (-jnp.arange(half, dtype=F32) / half)
    ang = pos[:, None] * inv[None]
    shape = (ang.shape[0],) + (1,) * (x.ndim - 3) + (half,)
    cos = jnp.cos(ang).reshape(shape)
    sin = jnp.sin(ang).reshape(shape)
    xf = x.astype(F32)
    x1, x2 = xf[..., :half], xf[..., half:]
    return jnp.concatenate([x1 * cos - x2 * sin, x2 * cos + x1 * sin], axis=-1).astype(x.dtype)


def chunk_causal_attention(q_nope, q_pe, k_nope, k_pe, v, q_chunk, k_chunk):
    B, Lq, H, _ = q_nope.shape
    blk = Q_BLOCK if Lq % Q_BLOCK == 0 else Lq
    nb = Lq // blk
    scale = (NOPE_DIM + ROPE_DIM) ** -0.5

    def one_block(args):
        qn, qp, qc = args
        s = jnp.einsum('bqhd,bkhd->bhqk', qn, k_nope) + jnp.einsum('bqhr,bkr->bhqk', qp, k_pe)
        s = s.astype(F32) * scale
        s = jnp.where(k_chunk[None, :] <= qc[:, None], s, -jnp.inf)
        p = jax.nn.softmax(s, axis=-1).astype(v.dtype)
        return jnp.einsum('bhqk,bkhv->bqhv', p, v)

    split = lambda t: jnp.moveaxis(t.reshape((B, nb, blk) + t.shape[2:]), 1, 0)
    o = lax.map(one_block, (split(q_nope), split(q_pe), q_chunk.reshape(nb, blk)))
    return jnp.moveaxis(o, 0, 1).reshape(B, Lq, H, -1)


def mla_mixer(h, ckv_cache, kpe_cache, past, w_down, q_norm_w, kv_norm_w, w_uq, w_ukv, w_out):
    B, L, _ = h.shape
    qpos = past + jnp.arange(L)
    pos_f = qpos.astype(F32)
    down = h @ w_down
    c_q = rms_norm(down[..., :Q_LORA], q_norm_w)
    c_kv = rms_norm(down[..., Q_LORA:Q_LORA + KV_LORA], kv_norm_w)
    k_pe = rope(down[..., Q_LORA + KV_LORA:], pos_f)
    q = (c_q @ w_uq).reshape(B, L, MLA_HEADS, NOPE_DIM + ROPE_DIM)
    q_nope = q[..., :NOPE_DIM]
    q_pe = rope(q[..., NOPE_DIM:], pos_f)
    if ckv_cache is None:
        ckv_all, kpe_all = c_kv, k_pe
    else:
        ckv_all = jnp.concatenate([ckv_cache.astype(c_kv.dtype), c_kv], axis=1)
        kpe_all = jnp.concatenate([kpe_cache.astype(k_pe.dtype), k_pe], axis=1)
    Lk = ckv_all.shape[1]
    kv = (ckv_all @ w_ukv).reshape(B, Lk, MLA_HEADS, NOPE_DIM + V_DIM)
    k_nope, v = kv[..., :NOPE_DIM], kv[..., NOPE_DIM:]
    o = chunk_causal_attention(q_nope, q_pe, k_nope, kpe_all, v,
                               qpos // CHUNK, jnp.arange(Lk) // CHUNK)
    y = o.reshape(B, L, MLA_HEADS * V_DIM) @ w_out
    return y, c_kv, k_pe


def conv_ffn(h, buf, w_in, conv_w, conv_b, w_out):
    L = h.shape[1]
    u = h @ w_in
    ext = jnp.concatenate([buf.astype(u.dtype), u], axis=1)
    c = conv_b
    for j in range(CONV_K):
        c = c + conv_w[j] * ext[:, j:j + L]
    gate, up = jnp.split(c, 2, axis=-1)
    y = (jax.nn.silu(gate) * up) @ w_out
    return y, ext[:, L:]


def trunk(x, hg_states, ckv_caches, kpe_caches, conv_states, lower_bounds, norm_w,
          hgrn_w_in, hgrn_gnorm_w, hgrn_w_out, mla_w_down, mla_q_norm_w, mla_kv_norm_w,
          mla_w_uq, mla_w_ukv, mla_w_out, ffn_w_in, ffn_conv_w, ffn_conv_b, ffn_w_out):
    past = 0 if ckv_caches is None else ckv_caches.shape[2]
    new_hg, new_ckv, new_kpe, new_conv = [], [], [], []
    for layer in range(DEPTH):
        idx = layer // N_MIXERS
        h = rms_norm(x, norm_w[layer, 0])
        if layer % N_MIXERS == 0:
            m, s = hgrn2_mixer(h, hg_states[idx], hgrn_w_in[idx], hgrn_gnorm_w[idx],
                               hgrn_w_out[idx], lower_bounds[layer])
            new_hg.append(s)
        else:
            m, c, kp = mla_mixer(h,
                                 None if ckv_caches is None else ckv_caches[idx],
                                 None if kpe_caches is None else kpe_caches[idx],
                                 past, mla_w_down[idx], mla_q_norm_w[idx], mla_kv_norm_w[idx],
                                 mla_w_uq[idx], mla_w_ukv[idx], mla_w_out[idx])
            new_ckv.append(c)
            new_kpe.append(kp)
        x = x + rms_norm(m, norm_w[layer, 1])
        f, buf = conv_ffn(rms_norm(x, norm_w[layer, 2]), conv_states[layer], ffn_w_in[layer],
                          ffn_conv_w[layer], ffn_conv_b[layer], ffn_w_out[layer])
        new_conv.append(buf)
        x = x + rms_norm(f, norm_w[layer, 3])
    return x, jnp.stack(new_hg), jnp.stack(new_ckv), jnp.stack(new_kpe), jnp.stack(new_conv)


def setup_inputs(seed: int = 0) -> dict:
    key = jax.random.key(seed)
    ks = jax.random.split(key, 24)
    nrm = lambda k, shape, scale: jax.random.normal(k, shape, F32) * scale
    gain = lambda k, shape: 1.0 + 0.05 * jax.random.normal(k, shape, F32)
    return {
        'x_prompt': nrm(ks[0], (BATCH, SEQ, D_MODEL), 1.0),
        'x_sample': nrm(ks[1], (DEC_BATCH, DEC_SEQ, D_MODEL), 1.0),
        'state_hgrn': nrm(ks[2], (N_HG_LAYERS, DEC_BATCH, HG_HEADS, HG_DK, HG_DV), 0.5),
        'cache_ckv': nrm(ks[3], (N_MLA_LAYERS, DEC_BATCH, PAST_LEN, KV_LORA), 1.0),
        'cache_kpe': nrm(ks[4], (N_MLA_LAYERS, DEC_BATCH, PAST_LEN, ROPE_DIM), 1.0),
        'state_conv': nrm(ks[5], (DEPTH, DEC_BATCH, CONV_K - 1, 2 * D_FF), 1.0),
        'norm_w': gain(ks[6], (DEPTH, 4, D_MODEL)),
        'lb_logits': nrm(ks[7], (DEPTH + 1, HG_DIM), 0.1),
        'hgrn_w_in': nrm(ks[8], (N_HG_LAYERS, D_MODEL, 4 * HG_DIM), D_MODEL ** -0.5),
        'hgrn_gnorm_w': gain(ks[9], (N_HG_LAYERS, HG_DV)),
        'hgrn_w_out': nrm(ks[10], (N_HG_LAYERS, HG_HEADS * HG_DV, D_MODEL), (HG_HEADS * HG_DV) ** -0.5),
        'mla_w_down': nrm(ks[11], (N_MLA_LAYERS, D_MODEL, Q_LORA + KV_LORA + ROPE_DIM), D_MODEL ** -0.5),
        'mla_q_norm_w': gain(ks[12], (N_MLA_LAYERS, Q_LORA)),
        'mla_kv_norm_w': gain(ks[13], (N_MLA_LAYERS, KV_LORA)),
        'mla_w_uq': nrm(ks[14], (N_MLA_LAYERS, Q_LORA, MLA_HEADS * (NOPE_DIM + ROPE_DIM)), Q_LORA ** -0.5),
        'mla_w_ukv': nrm(ks[15], (N_MLA_LAYERS, KV_LORA, MLA_HEADS * (NOPE_DIM + V_DIM)), KV_LORA ** -0.5),
        'mla_w_out': nrm(ks[16], (N_MLA_LAYERS, MLA_HEADS * V_DIM, D_MODEL), (MLA_HEADS * V_DIM) ** -0.5),
        'ffn_w_in': nrm(ks[17], (DEPTH, D_MODEL, 2 * D_FF), D_MODEL ** -0.5),
        'ffn_conv_w': nrm(ks[18], (DEPTH, CONV_K, 2 * D_FF), CONV_K ** -0.5),
        'ffn_conv_b': nrm(ks[19], (DEPTH, 2 * D_FF), 0.02),
        'ffn_w_out': nrm(ks[20], (DEPTH, D_FF, D_MODEL), D_FF ** -0.5),
    }


def reference(x_prompt, x_sample, state_hgrn, cache_ckv, cache_kpe, state_conv, norm_w, lb_logits,
              hgrn_w_in, hgrn_gnorm_w, hgrn_w_out, mla_w_down, mla_q_norm_w, mla_kv_norm_w,
              mla_w_uq, mla_w_ukv, mla_w_out, ffn_w_in, ffn_conv_w, ffn_conv_b, ffn_w_out):
    lower_bounds = jnp.cumsum(jax.nn.softmax(lb_logits.astype(F32), axis=0), axis=0)
    bp = x_prompt.shape[0]
    hg0 = jnp.zeros((N_HG_LAYERS, bp, HG_HEADS, HG_DK, HG_DV), x_prompt.dtype)
    conv0 = jnp.zeros((DEPTH, bp, CONV_K - 1, 2 * D_FF), x_prompt.dtype)
    y_prompt, hg_p, ckv_p, kpe_p, conv_p = trunk(
        x_prompt, hg0, None, None, conv0, lower_bounds, norm_w,
        hgrn_w_in, hgrn_gnorm_w, hgrn_w_out, mla_w_down, mla_q_norm_w, mla_kv_norm_w,
        mla_w_uq, mla_w_ukv, mla_w_out, ffn_w_in, ffn_conv_w, ffn_conv_b, ffn_w_out)
    y_sample, hg_s, ckv_s, kpe_s, conv_s = trunk(
        x_sample, state_hgrn, cache_ckv, cache_kpe, state_conv, lower_bounds, norm_w,
        hgrn_w_in, hgrn_gnorm_w, hgrn_w_out, mla_w_down, mla_q_norm_w, mla_kv_norm_w,
        mla_w_uq, mla_w_ukv, mla_w_out, ffn_w_in, ffn_conv_w, ffn_conv_b, ffn_w_out)
    return (y_prompt, y_sample, hg_p, hg_s, ckv_p, ckv_s, kpe_p, kpe_s, conv_p, conv_s)
```

```cpp
#include <hip/hip_runtime.h>
#include <hip/hip_cooperative_groups.h>
#include <cstdio>
#include <cstdint>
namespace cg = cooperative_groups;

#ifndef MK_ONE_LAUNCH
#define MK_ONE_LAUNCH 0
#endif

#define LAS __attribute__((address_space(3)))
#define DI __device__ __forceinline__
typedef unsigned short bf16_t;
typedef short bf16x8 __attribute__((ext_vector_type(8)));
typedef float f32x4 __attribute__((ext_vector_type(4)));
typedef float f32x2 __attribute__((ext_vector_type(2)));
typedef float f32x16 __attribute__((ext_vector_type(16)));
typedef unsigned u32x4 __attribute__((ext_vector_type(4)));
typedef unsigned u32x2 __attribute__((ext_vector_type(2)));
typedef __bf16 bf16x2_t __attribute__((ext_vector_type(2)));

constexpr int DM = 2048, NB = 4, SEQ = 2048, DB = 8, DS = 32, PAST = 1024;
constexpr int TP = NB * SEQ, TS = DB * DS, T = TP + TS;
constexpr int HH = 16, DK = 128, DV = 128;
constexpr int QL = 512, KVL = 512, NOPE = 128, ROPE = 64, VD = 128, QHD = NOPE + ROPE;
constexpr int NDOWN = QL + KVL + ROPE, NDOWNP = 1280;
constexpr int FF = 5632, FF2 = 2 * FF;
constexpr int KVSEQ = PAST + DS;
constexpr int KVROWS = TP + DB * KVSEQ;
constexpr float EPS = 1e-6f;
constexpr int NTHREADS = 512, NWAVES = 8;

constexpr size_t O_Y = 0;
constexpr size_t O_HG = (size_t)T * DM;
constexpr size_t O_CKV = O_HG + (size_t)12 * HH * DK * DV;
constexpr size_t O_KPE = O_CKV + (size_t)T * KVL;
constexpr size_t O_CONVP = O_KPE + (size_t)T * ROPE;
constexpr size_t O_CONVS = O_CONVP + (size_t)2 * NB * 2 * FF2;
constexpr size_t O_END = O_CONVS + (size_t)2 * DB * 2 * FF2;

constexpr size_t al256(size_t x) { return (x + 255) & ~(size_t)255; }
constexpr size_t WS_WT_HIN = 0;
constexpr size_t WS_WT_HOUT = WS_WT_HIN + (size_t)8192 * 2048 * 2;
constexpr size_t WS_WT_DOWN = WS_WT_HOUT + (size_t)2048 * 2048 * 2;
constexpr size_t WS_WT_UQ = WS_WT_DOWN + (size_t)NDOWNP * 2048 * 2;
constexpr size_t WS_WT_K = WS_WT_UQ + (size_t)3072 * 512 * 2;
constexpr size_t WS_WT_V = WS_WT_K + (size_t)2048 * 512 * 2;
constexpr size_t WS_WT_MOUT = WS_WT_V + (size_t)2048 * 512 * 2;
constexpr size_t WS_WT_FIN = WS_WT_MOUT + (size_t)2048 * 2048 * 2;
constexpr size_t WS_WT_FOUT = WS_WT_FIN + (size_t)2 * FF2 * 2048 * 2;
constexpr size_t WS_TAB = WS_WT_FOUT + (size_t)2 * 2048 * FF * 2;
constexpr size_t WS_LB = WS_TAB + (size_t)2048 * 32 * 2 * 4;
constexpr size_t WS_X = WS_LB + 2048 * 4;
constexpr size_t WS_H = WS_X + (size_t)T * DM * 4;
constexpr size_t WS_M = WS_H + (size_t)T * DM * 2;
constexpr size_t WS_R = WS_M + (size_t)T * DM * 4;
constexpr size_t WS_QB = WS_R;
constexpr size_t WS_FG = WS_QB + (size_t)T * DM * 2;
constexpr size_t WS_VB = WS_FG + (size_t)T * DM * 4;
constexpr size_t WS_SG = WS_VB + (size_t)T * DM * 2;
constexpr size_t WS_O32 = WS_SG + (size_t)T * DM * 2;
constexpr size_t WS_OG = WS_O32 + (size_t)T * DM * 4;
constexpr size_t WS_RA_END = WS_OG + (size_t)T * DM * 2;
constexpr size_t WS_U = WS_R;
constexpr size_t WS_ACT = WS_U + (size_t)T * FF2 * 2;
constexpr size_t WS_RB_END = WS_ACT + (size_t)T * FF * 2;
constexpr size_t WS_DOWN = WS_R;
constexpr size_t WS_CQ = WS_DOWN + (size_t)T * NDOWNP * 4;
constexpr size_t WS_CKVA = WS_CQ + (size_t)T * QL * 2;
constexpr size_t WS_KPEA = WS_CKVA + (size_t)KVROWS * KVL * 2;
constexpr size_t WS_QA = WS_KPEA + (size_t)KVROWS * ROPE * 2;
constexpr size_t WS_KN = WS_QA + (size_t)T * 3072 * 2;
constexpr size_t WS_VT = WS_KN + (size_t)KVROWS * 2048 * 2;
constexpr size_t WS_AO = WS_VT + (size_t)2048 * KVROWS * 2;
constexpr size_t WS_RC_END = WS_AO + (size_t)T * DM * 2;
constexpr size_t cmax(size_t a, size_t b) { return a > b ? a : b; }
constexpr size_t WS_END = cmax(WS_RA_END, cmax(WS_RB_END, WS_RC_END));

constexpr int LDS_BYTES = 147456;

DI float bf2f(unsigned short b) { return __uint_as_float((unsigned)b << 16); }
DI unsigned pk2(float lo, float hi) { f32x2 v = {lo, hi}; bf16x2_t b = __builtin_convertvector(v, bf16x2_t); return __builtin_bit_cast(unsigned, b); }
DI float fexp(float x) { return __builtin_amdgcn_exp2f(x * 1.4426950408889634f); }
DI float sigmoidf_(float x) { return __builtin_amdgcn_rcpf(1.f + fexp(-x)); }
DI float siluf_(float x) { return x * sigmoidf_(x); }
DI float wave_sum(float v) {
#pragma unroll
    for (int o = 1; o < 64; o <<= 1) v += __shfl_xor(v, o);
    return v;
}

namespace pg8 {
constexpr int BM = 256, BK = 64, HALF = 128, HTB = HALF * BK * 2, STAGE_BYTES = 8 * HTB, NXCD = 8, WGM = 8;
__host__ __device__ __forceinline__ int lds_byte(int r, int c) { const int st = (r >> 4) * 2 + (c >> 5), rr = r & 15, cc = c & 31, ob = rr * 64 + cc * 2; return st * 1024 + (ob ^ (((ob >> 9) & 1) << 5)); }
__host__ __device__ __forceinline__ void stage_rc(int b, int& R, int& C) { const int st = b / 1024, sb = b % 1024, swz = sb ^ (((sb >> 9) & 1) << 5); R = (st >> 1) * 16 + swz / 64; C = (st & 1) * 32 + (swz % 64) / 2; }

struct Unit { int pm, pn; };
struct Gemm { const bf16_t* A; const bf16_t* Bt; int M, N, K; };

struct StaticOrder {
    int nM, nN, nwg, G, c;
    __host__ __device__ void init(int M, int N, int G_, int c_) { nM = M / BM; nN = N / BM; nwg = nM * nN; G = G_; c = c_; }
    __host__ __device__ bool next(int i, Unit& u) const {
        const long L = (long)i * G + c; if (L >= nwg) return false;
        int wgid = (int)L; { const int q = nwg / NXCD, r = nwg % NXCD, xcd = wgid % NXCD, off = wgid / NXCD; wgid = (xcd < r ? xcd * (q + 1) : r * (q + 1) + (xcd - r) * q) + off; }
        const int nig = WGM * nN, gid = wgid / nig, fm = gid * WGM, gsz = (nM - fm) < WGM ? (nM - fm) : WGM;
        u.pm = fm + ((wgid % nig) % gsz); u.pn = (wgid % nig) / gsz; return true;
    }
};

template <class Epi>
__device__ __forceinline__ void gemm_phase(LAS unsigned char* lds, const Gemm g, const StaticOrder& S, const Epi& E) {
    const int tid = threadIdx.x, wid = __builtin_amdgcn_readfirstlane(tid >> 6), lane = tid & 63, wr = wid >> 2, wc = wid & 3, fr = lane & 15, fq = lane >> 4;
    const int K = g.K, nt = K / BK;
    unsigned voffA[2], voffB[2];
#pragma unroll
    for (int i = 0; i < 2; ++i) { int R, C; stage_rc(tid * 16 + i * 8192, R, C);
        voffA[i] = (unsigned)(R * K + C) * 2u; voffB[i] = (unsigned)(R * K + C) * 2u; }
    const size_t kstep = (size_t)(BK * 2);
    const size_t hstep = (size_t)HALF * K * 2;
    const size_t tstep = 2 * hstep;
    const unsigned ldsw = (unsigned)wid * 1024u;
    const int aoff = lds_byte(wr * 64 + fr, fq * 8), boff = lds_byte(wc * 32 + fr, fq * 8);
#define PG8_SA(b, h) (((b) * 2 + (h)) * HTB)
#define PG8_SB(b, h) ((4 + (b) * 2 + (h)) * HTB)
#define PG8_STAGE(bufoff, gbase, voff) do { _Pragma("unroll") for (int _i = 0; _i < 2; ++_i) \
        __builtin_amdgcn_global_load_lds((const unsigned*)((const char*)(gbase) + (voff)[_i]), (LAS unsigned*)(lds + (bufoff) + ldsw + _i * 8192), 16, 0, 0); } while (0)
#define PG8_LDA(dst, b, h) do { _Pragma("unroll") for (int m = 0; m < 4; ++m) _Pragma("unroll") for (int k = 0; k < 2; ++k) dst[m][k] = *(const LAS bf16x8*)(lds + PG8_SA(b, h) + aoff + m * 2048 + k * 1024); } while (0)
#define PG8_LDB(dst, b, h) do { _Pragma("unroll") for (int n = 0; n < 2; ++n) _Pragma("unroll") for (int k = 0; k < 2; ++k) dst[n][k] = *(const LAS bf16x8*)(lds + PG8_SB(b, h) + boff + n * 2048 + k * 1024); } while (0)
#define PG8_MMA(ai, bj, At, Bt) do { __builtin_amdgcn_s_setprio(1); _Pragma("unroll") for (int m = 0; m < 4; ++m) _Pragma("unroll") for (int n = 0; n < 2; ++n) _Pragma("unroll") for (int k = 0; k < 2; ++k) \
        acc[ai][bj][m][n] = __builtin_amdgcn_mfma_f32_16x16x32_bf16(Bt[n][k], At[m][k], acc[ai][bj][m][n], 0, 0, 0); __builtin_amdgcn_s_setprio(0); } while (0)
#define PG8_WAIT_V(n) asm volatile("s_waitcnt vmcnt(" #n ")" ::: "memory")
#define PG8_WAIT_L(n) asm volatile("s_waitcnt lgkmcnt(" #n ")" ::: "memory")
#define PG8_BAR __builtin_amdgcn_s_barrier()
#define PG8_SCHED __builtin_amdgcn_sched_barrier(0)
    Unit cur, nxt; int ui = 0;
    if (!S.next(0, cur)) return;
    f32x4 acc[2][2][4][2];
#pragma unroll
    for (int a = 0; a < 2; ++a)
#pragma unroll
        for (int b = 0; b < 2; ++b)
#pragma unroll
            for (int m = 0; m < 4; ++m)
#pragma unroll
                for (int n = 0; n < 2; ++n) acc[a][b][m][n] = (f32x4){0.f, 0.f, 0.f, 0.f};
    bf16x8 At[4][2], B0[2][2], B1[2][2];
    const char* cA = (const char*)g.A + (size_t)cur.pm * tstep; const char* cB = (const char*)g.Bt + (size_t)cur.pn * tstep;
    PG8_STAGE(PG8_SB(0, 0), cB, voffB); PG8_STAGE(PG8_SB(0, 1), cB + hstep, voffB); PG8_STAGE(PG8_SA(0, 0), cA, voffA); PG8_STAGE(PG8_SA(0, 1), cA + hstep, voffA);
    if (wr == 1) PG8_BAR;
    PG8_WAIT_V(2); PG8_BAR;
    PG8_STAGE(PG8_SB(1, 0), cB + kstep, voffB); PG8_STAGE(PG8_SA(1, 0), cA + kstep, voffA); PG8_STAGE(PG8_SB(1, 1), cB + hstep + kstep, voffB);
    PG8_WAIT_V(6); PG8_BAR;
    for (;;) {
        const bool has_next = S.next(ui + 1, nxt);
        const char* nA = has_next ? (const char*)g.A + (size_t)nxt.pm * tstep : cA; const char* nB = has_next ? (const char*)g.Bt + (size_t)nxt.pn * tstep : cB;
        for (int t = 0; t < nt; t += 2) {
            const bool last = (t == nt - 2);
            const char* a1 = cA + (size_t)(t + 1) * kstep;
            const char* a2 = last ? nA : cA + (size_t)(t + 2) * kstep; const char* b2 = last ? nB : cB + (size_t)(t + 2) * kstep;
            const char* a3 = a2 + kstep; const char* b3 = b2 + kstep;
            PG8_LDB(B0, 0, 0); PG8_LDB(B1, 0, 1); PG8_SCHED; PG8_LDA(At, 0, 0); PG8_STAGE(PG8_SA(1, 1), a1 + hstep, voffA);
            PG8_WAIT_V(8); PG8_WAIT_L(0); PG8_BAR; PG8_MMA(0, 0, At, B0); PG8_MMA(0, 1, At, B1); PG8_BAR; PG8_SCHED;
            PG8_LDA(At, 0, 1); PG8_STAGE(PG8_SB(0, 0), b2, voffB); PG8_STAGE(PG8_SB(0, 1), b2 + hstep, voffB); PG8_STAGE(PG8_SA(0, 0), a2, voffA);
            PG8_WAIT_V(8); PG8_WAIT_L(0); PG8_BAR; PG8_MMA(1, 0, At, B0); PG8_MMA(1, 1, At, B1); PG8_BAR; PG8_SCHED;
            PG8_LDB(B0, 1, 0); PG8_LDB(B1, 1, 1); PG8_SCHED; PG8_LDA(At, 1, 0); PG8_STAGE(PG8_SA(0, 1), a2 + hstep, voffA);
            PG8_WAIT_V(8); PG8_WAIT_L(0); PG8_BAR; PG8_MMA(0, 0, At, B0); PG8_MMA(0, 1, At, B1); PG8_BAR; PG8_SCHED;
            PG8_LDA(At, 1, 1); PG8_STAGE(PG8_SB(1, 0), b3, voffB); PG8_STAGE(PG8_SB(1, 1), b3 + hstep, voffB); PG8_STAGE(PG8_SA(1, 0), a3, voffA);
            PG8_WAIT_V(8); PG8_WAIT_L(0); PG8_BAR; PG8_MMA(1, 0, At, B0); PG8_MMA(1, 1, At, B1); PG8_BAR; PG8_SCHED;
        }
        if (wr == 0) PG8_BAR;
        E(acc, cur, wr, wc, fr, fq);
        if (!has_next) break;
#pragma unroll
        for (int a = 0; a < 2; ++a)
#pragma unroll
            for (int b = 0; b < 2; ++b)
#pragma unroll
                for (int m = 0; m < 4; ++m)
#pragma unroll
                    for (int n = 0; n < 2; ++n) acc[a][b][m][n] = (f32x4){0.f, 0.f, 0.f, 0.f};
        cur = nxt; cA = nA; cB = nB; ++ui;
        if (wr == 1) PG8_BAR;
    }
    PG8_WAIT_V(0);
    PG8_BAR;
#undef PG8_SA
#undef PG8_SB
#undef PG8_STAGE
#undef PG8_LDA
#undef PG8_LDB
#undef PG8_MMA
#undef PG8_WAIT_V
#undef PG8_WAIT_L
#undef PG8_BAR
#undef PG8_SCHED
}
}

struct Args { const float* in[21]; float* out; unsigned char* ws; int ph_lo, ph_hi; };

struct Frame {
    LAS unsigned char* lds;
    int tid, lane, wave, G, bid;
    const float* const* in; float* out; unsigned char* ws;
};

enum EpiKind { EK_F32 = 0, EK_BF16 = 1, EK_HGRN = 2, EK_FFN = 3, EK_Q = 4 };
struct EpiAll {
    int kind, ldc;
    void* C;
    bf16_t* Qb; float* FGp; bf16_t* Vb; bf16_t* SGp; const float* lb;
    float* convP; float* convS;
    const float* tab; float qscale;
    DI void st_bf16(bf16_t* p, f32x4 v) const { u32x2 w; w.x = pk2(v[0], v[1]); w.y = pk2(v[2], v[3]); *(u32x2*)p = w; }
    DI void one(int row, int col, f32x4 v) const {
        if (kind == EK_F32) { *(f32x4*)((float*)C + (size_t)row * ldc + col) = v; }
        else if (kind == EK_BF16) { st_bf16((bf16_t*)C + (size_t)row * ldc + col, v); }
        else if (kind == EK_HGRN) {
            const int sec = col >> 11, c = col & 2047; const size_t off = (size_t)row * DM + c;
            if (sec == 0) { f32x4 o; for (int i = 0; i < 4; ++i) o[i] = siluf_(v[i]); st_bf16(Qb + off, o); }
            else if (sec == 1) { const f32x4 l = *(const f32x4*)(lb + c); f32x4 o; for (int i = 0; i < 4; ++i) o[i] = l[i] + (1.f - l[i]) * sigmoidf_(v[i]); *(f32x4*)(FGp + off) = o; }
            else if (sec == 2) { st_bf16(Vb + off, v); }
            else { f32x4 o; for (int i = 0; i < 4; ++i) o[i] = siluf_(v[i]); st_bf16(SGp + off, o); }
        }
        else if (kind == EK_FFN) {
            st_bf16((bf16_t*)C + (size_t)row * FF2 + col, v);
            if (row < TP) { const int t = row & (SEQ - 1); if (t >= SEQ - 2) *(f32x4*)(convP + ((size_t)((row >> 11) * 2 + (t - (SEQ - 2)))) * FF2 + col) = v; }
            else { const int r = row - TP, t = r & (DS - 1); if (t >= DS - 2) *(f32x4*)(convS + ((size_t)((r >> 5) * 2 + (t - (DS - 2)))) * FF2 + col) = v; }
        }
        else {
            const int hc = col % QHD; f32x4 o = v;
            if (hc >= NOPE) {
                const int i0 = (hc - NOPE) >> 1;
                const int pos = row < TP ? (row & (SEQ - 1)) : PAST + ((row - TP) & (DS - 1));
                const f32x4 cs = *(const f32x4*)(tab + ((size_t)pos * 32 + i0) * 2);
                o[0] = v[0] * cs[0] - v[1] * cs[1]; o[1] = v[1] * cs[0] + v[0] * cs[1];
                o[2] = v[2] * cs[2] - v[3] * cs[3]; o[3] = v[3] * cs[2] + v[2] * cs[3];
            }
            o = o * qscale; st_bf16((bf16_t*)C + (size_t)row * 3072 + col, o);
        }
    }
    DI void operator()(const f32x4 (&acc)[2][2][4][2], const pg8::Unit& u, int wr, int wc, int fr, int fq) const {
#pragma unroll
        for (int ai = 0; ai < 2; ++ai)
#pragma unroll
            for (int m = 0; m < 4; ++m) {
                const int row = u.pm * 256 + ai * 128 + wr * 64 + m * 16 + fr;
#pragma unroll
                for (int bj = 0; bj < 2; ++bj)
#pragma unroll
                    for (int n = 0; n < 2; ++n) one(row, u.pn * 256 + bj * 128 + wc * 32 + n * 16 + fq * 4, acc[ai][bj][m][n]);
            }
    }
};

enum RowMap { RM_ID = 0, RM_UQ = 1, RM_UKV = 2 };
DI int map_row(int mode, int n) {
    if (mode == RM_UQ) { const int h = n / QHD, j = n % QHD; if (j < NOPE) return n; const int i = j - NOPE; return h * QHD + NOPE + (i < 32 ? 2 * i : 2 * (i - 32) + 1); }
    if (mode == RM_UKV) { const int h = n >> 8, j = n & 255; return (j < 128 ? 0 : 2048) + h * 128 + (j & 127); }
    return n;
}
DI void transpose_item(const float* W, int K, int N, bf16_t* WT, int mode, LAS float* scr, int item, int lane) {
    const int nblk = N / 32, kb = item / nblk, nb = item % nblk, k0 = 64 * kb, n0 = 32 * nb;
#pragma unroll 8
    for (int i = 0; i < 32; ++i) { const int kk = 2 * i + (lane >> 5); scr[kk * 33 + (lane & 31)] = W[(size_t)(k0 + kk) * N + n0 + (lane & 31)]; }
    asm volatile("s_waitcnt lgkmcnt(0)" ::: "memory");
    const int c = lane & 7;
#pragma unroll
    for (int j = 0; j < 4; ++j) { const int n = (lane >> 3) + 8 * j; const LAS float* s = scr + (8 * c) * 33 + n;
        u32x4 o; o.x = pk2(s[0 * 33], s[1 * 33]); o.y = pk2(s[2 * 33], s[3 * 33]); o.z = pk2(s[4 * 33], s[5 * 33]); o.w = pk2(s[6 * 33], s[7 * 33]);
        *(u32x4*)(WT + (size_t)map_row(mode, n0 + n) * K + k0 + 8 * c) = o; }
    asm volatile("s_waitcnt lgkmcnt(0)" ::: "memory");
}
DI const float* xrow_ptr(const Frame& F, int row) { return row < TP ? F.in[0] + (size_t)row * DM : F.in[1] + (size_t)(row - TP) * DM; }

DI void norm_row_bf16(const float* xr, const float* w, bf16_t* hr, int lane) {
    f32x4 v[8]; float s = 0.f;
#pragma unroll
    for (int j = 0; j < 8; ++j) { v[j] = *(const f32x4*)(xr + 4 * lane + 256 * j); s += (v[j][0] * v[j][0] + v[j][1] * v[j][1]) + (v[j][2] * v[j][2] + v[j][3] * v[j][3]); }
    const float r = __builtin_amdgcn_rsqf(wave_sum(s) * (1.f / DM) + EPS);
#pragma unroll
    for (int j = 0; j < 8; ++j) { const f32x4 ww = *(const f32x4*)(w + 4 * lane + 256 * j); u32x2 o; o.x = pk2(v[j][0] * r * ww[0], v[j][1] * r * ww[1]); o.y = pk2(v[j][2] * r * ww[2], v[j][3] * r * ww[3]);
        *(u32x2*)(hr + 4 * lane + 256 * j) = o; }
}

DI void phase_prep(const Frame& F) {
    LAS float* scr = (LAS float*)(F.lds + F.wave * 16384);
    const int gw = F.bid * NWAVES + F.wave, NGW = F.G * NWAVES;
    unsigned char* ws = F.ws;
    constexpr int I_HIN = 32 * 256, I_HOUT = 32 * 64, I_DOWN = 32 * 34, I_UQ = 8 * 96, I_UKV = 8 * 128, I_MOUT = 32 * 64, I_FIN = 32 * 352, I_FOUT = 88 * 64;
    constexpr int NITEMS = I_HIN + I_HOUT + I_DOWN + I_UQ + I_UKV + I_MOUT + 2 * I_FIN + 2 * I_FOUT;
    for (int it = gw; it < NITEMS; it += NGW) {
        int r = it; const float* W; bf16_t* WT; int K, N, mode = RM_ID;
        if (r < I_HIN) { W = F.in[8]; K = 2048; N = 8192; WT = (bf16_t*)(ws + WS_WT_HIN); }
        else if ((r -= I_HIN) < I_HOUT) { W = F.in[10]; K = 2048; N = 2048; WT = (bf16_t*)(ws + WS_WT_HOUT); }
        else if ((r -= I_HOUT) < I_DOWN) { W = F.in[11]; K = 2048; N = NDOWN; WT = (bf16_t*)(ws + WS_WT_DOWN); }
        else if ((r -= I_DOWN) < I_UQ) { W = F.in[14]; K = 512; N = 3072; WT = (bf16_t*)(ws + WS_WT_UQ); mode = RM_UQ; }
        else if ((r -= I_UQ) < I_UKV) { W = F.in[15]; K = 512; N = 4096; WT = (bf16_t*)(ws + WS_WT_K); mode = RM_UKV; }
        else if ((r -= I_UKV) < I_MOUT) { W = F.in[16]; K = 2048; N = 2048; WT = (bf16_t*)(ws + WS_WT_MOUT); }
        else if ((r -= I_MOUT) < 2 * I_FIN) { const int l = r / I_FIN; r -= l * I_FIN; W = F.in[17] + (size_t)l * 2048 * FF2; K = 2048; N = FF2; WT = (bf16_t*)(ws + WS_WT_FIN) + (size_t)l * FF2 * 2048; }
        else { r -= 2 * I_FIN; const int l = r / I_FOUT; r -= l * I_FOUT; W = F.in[20] + (size_t)l * FF * 2048; K = FF; N = 2048; WT = (bf16_t*)(ws + WS_WT_FOUT) + (size_t)l * 2048 * FF; }
        transpose_item(W, K, N, WT, mode, scr, r, F.lane);
    }
    { const int gt = F.bid * NTHREADS + F.tid, NGT = F.G * NTHREADS; u32x4* p = (u32x4*)((bf16_t*)(ws + WS_WT_DOWN) + (size_t)NDOWN * 2048);
      for (int i = gt; i < (NDOWNP - NDOWN) * 256; i += NGT) p[i] = (u32x4){0u, 0u, 0u, 0u}; }
    { const int gt = F.bid * NTHREADS + F.tid, NGT = F.G * NTHREADS; float* tab = (float*)(ws + WS_TAB);
      for (int i = gt; i < 2048 * 32; i += NGT) { const int pos = i >> 5, k = i & 31;
          double inv = 1.0;
          for (int q = 0; q < k; ++q) inv *= 0.7498942093324559;
          const double rev = (double)pos * inv * 0.15915494309189535; const float fr = (float)(rev - floor(rev));
          tab[2 * i] = __builtin_amdgcn_cosf(fr); tab[2 * i + 1] = __builtin_amdgcn_sinf(fr); }
      float* lb = (float*)(ws + WS_LB); const float* lg = F.in[7];
      for (int i = gt; i < 2048; i += NGT) { const float a = lg[i], b = lg[2048 + i], c = lg[4096 + i]; const float mx = fmaxf(a, fmaxf(b, c));
          const float ea = fexp(a - mx), eb = fexp(b - mx), ec = fexp(c - mx); lb[i] = ea / (ea + eb + ec); } }
    for (int m = gw; m < T; m += NGW) norm_row_bf16(xrow_ptr(F, m), F.in[6], (bf16_t*)(ws + WS_H) + (size_t)m * DM, F.lane);
}

DI void phase_scan(const Frame& F) {
    LAS float* Lf = (LAS float*)(F.lds);
    LAS bf16_t* Lq = (LAS bf16_t*)(F.lds + 32768);
    LAS float* Lv = (LAS float*)(F.lds + 49152);
    const bf16_t* Qb = (const bf16_t*)(F.ws + WS_QB); const float* FG = (const float*)(F.ws + WS_FG); const bf16_t* Vb = (const bf16_t*)(F.ws + WS_VB);
    float* O32 = (float*)(F.ws + WS_O32);
    const int tid = F.tid, lane = F.lane, w = F.wave;
    for (int item = F.bid; item < 768; item += F.G) {
        int s, h, dvq, L, row0;
        if (item < 256) { s = item >> 6; h = (item >> 2) & 15; dvq = item & 3; L = SEQ; row0 = s * SEQ; }
        else { const int it = item - 256; s = 4 + (it >> 6); h = (it >> 2) & 15; dvq = it & 3; L = DS; row0 = TP + (s - 4) * DS; }
        const int CL = L < 64 ? L : 64, nch = L / CL;
        const int c0 = dvq * 32 + w * 4;
        float S0[4], S1[4];
        if (s < 4) { for (int c = 0; c < 4; ++c) { S0[c] = 0.f; S1[c] = 0.f; } }
        else { const float* st = F.in[2] + ((size_t)((s - 4) * HH + h) * DK + 2 * lane) * DV + c0; const f32x4 a = *(const f32x4*)st, b = *(const f32x4*)(st + DV);
               for (int c = 0; c < 4; ++c) { S0[c] = a[c]; S1[c] = b[c]; } }
        for (int ch = 0; ch < nch; ++ch) {
            const int t0 = ch * CL;
            __syncthreads();
#pragma unroll
            for (int i = 0; i < 4; ++i) { const int e = tid * 4 + 2048 * i, r = e >> 7, c = e & 127; if (r < CL) *(LAS f32x4*)(Lf + e) = *(const f32x4*)(FG + (size_t)(row0 + t0 + r) * DM + h * DK + c); }
#pragma unroll
            for (int i = 0; i < 2; ++i) { const int e = tid * 8 + 4096 * i, r = e >> 7, c = e & 127; if (r < CL) *(LAS u32x4*)(Lq + e) = *(const u32x4*)(Qb + (size_t)(row0 + t0 + r) * DM + h * DK + c); }
            { const int e = tid * 4, r = e >> 5, c = e & 31; if (r < CL) { const u32x2 v = *(const u32x2*)(Vb + (size_t)(row0 + t0 + r) * DM + h * DV + dvq * 32 + c);
                  *(LAS f32x4*)(Lv + e) = (f32x4){__uint_as_float(v.x << 16), __uint_as_float(v.x & 0xffff0000u), __uint_as_float(v.y << 16), __uint_as_float(v.y & 0xffff0000u)}; } }
            __syncthreads();
            for (int t = 0; t < CL; ++t) {
                const f32x2 f2 = *(const LAS f32x2*)(Lf + t * 128 + 2 * lane);
                const unsigned q2 = *(const LAS unsigned*)(Lq + t * 128 + 2 * lane);
                const f32x4 v4 = *(const LAS f32x4*)(Lv + t * 32 + w * 4);
                const float q0 = __uint_as_float(q2 << 16), q1 = __uint_as_float(q2 & 0xffff0000u);
                const float k0 = 1.f - f2[0], k1 = 1.f - f2[1];
                float p[4];
#pragma unroll
                for (int c = 0; c < 4; ++c) { S0[c] = f2[0] * S0[c] + k0 * v4[c]; S1[c] = f2[1] * S1[c] + k1 * v4[c]; p[c] = q0 * S0[c] + q1 * S1[c]; }
                float a0 = (lane & 1) ? p[1] : p[0], b0 = (lane & 1) ? p[0] : p[1];
                float a1 = (lane & 1) ? p[3] : p[2], b1 = (lane & 1) ? p[2] : p[3];
                a0 += __shfl_xor(b0, 1); a1 += __shfl_xor(b1, 1);
                float a = (lane & 2) ? a1 : a0, b = (lane & 2) ? a0 : a1;
                a += __shfl_xor(b, 2);
                a += __shfl_xor(a, 4); a += __shfl_xor(a, 8); a += __shfl_xor(a, 16); a += __shfl_xor(a, 32);
                if (lane < 4) O32[(size_t)(row0 + t0 + t) * DM + h * DV + c0 + lane] = a;
            }
        }
        { float* so = F.out + O_HG + ((size_t)(s * HH + h) * DK + 2 * lane) * DV + c0;
          *(f32x4*)so = (f32x4){S0[0], S0[1], S0[2], S0[3]}; *(f32x4*)(so + DV) = (f32x4){S1[0], S1[1], S1[2], S1[3]}; }
    }
}

DI void phase_gate(const Frame& F) {
    const float* O32 = (const float*)(F.ws + WS_O32); const bf16_t* SG = (const bf16_t*)(F.ws + WS_SG); bf16_t* OG = (bf16_t*)(F.ws + WS_OG);
    const float* gw_ = F.in[9]; const int lane = F.lane;
    const int gw = F.bid * NWAVES + F.wave, NGW = F.G * NWAVES;
    for (int m = gw; m < T; m += NGW) {
#pragma unroll
        for (int j = 0; j < 8; ++j) {
            const int col = 4 * lane + 256 * j;
            const f32x4 v = *(const f32x4*)(O32 + (size_t)m * DM + col);
            float s = (v[0] * v[0] + v[1] * v[1]) + (v[2] * v[2] + v[3] * v[3]);
            s += __shfl_xor(s, 1); s += __shfl_xor(s, 2); s += __shfl_xor(s, 4); s += __shfl_xor(s, 8); s += __shfl_xor(s, 16);
            const float r = __builtin_amdgcn_rsqf(s * (1.f / DV) + EPS);
            const f32x4 g = *(const f32x4*)(gw_ + (col & 127)); const u32x2 sg = *(const u32x2*)(SG + (size_t)m * DM + col);
            u32x2 o; o.x = pk2(v[0] * r * g[0] * __uint_as_float(sg.x << 16), v[1] * r * g[1] * __uint_as_float(sg.x & 0xffff0000u));
            o.y = pk2(v[2] * r * g[2] * __uint_as_float(sg.y << 16), v[3] * r * g[3] * __uint_as_float(sg.y & 0xffff0000u));
            *(u32x2*)(OG + (size_t)m * DM + col) = o;
        }
    }
}

DI void phase_rowpass(const Frame& F, int which) {
    const float* Mb = (const float*)(F.ws + WS_M); float* X = (float*)(F.ws + WS_X); bf16_t* H = (bf16_t*)(F.ws + WS_H);
    const float* nw = F.in[6];
    const float* wa = nw + (which == 0 ? 1 : which == 1 ? 3 : which == 2 ? 5 : 7) * DM;
    const float* wb = which == 3 ? nullptr : nw + (which == 0 ? 2 : which == 1 ? 4 : 6) * DM;
    const int lane = F.lane; const int gw = F.bid * NWAVES + F.wave, NGW = F.G * NWAVES;
    for (int m = gw; m < T; m += NGW) {
        const float* xin = which == 0 ? xrow_ptr(F, m) : X + (size_t)m * DM;
        float* xout = which == 3 ? F.out + O_Y + (size_t)m * DM : X + (size_t)m * DM;
        const float* mr = Mb + (size_t)m * DM;
        f32x4 v[8]; float s = 0.f;
#pragma unroll
        for (int j = 0; j < 8; ++j) { v[j] = *(const f32x4*)(mr + 4 * lane + 256 * j); s += (v[j][0] * v[j][0] + v[j][1] * v[j][1]) + (v[j][2] * v[j][2] + v[j][3] * v[j][3]); }
        const float r1 = __builtin_amdgcn_rsqf(wave_sum(s) * (1.f / DM) + EPS);
        float s2 = 0.f;
#pragma unroll
        for (int j = 0; j < 8; ++j) { const f32x4 ww = *(const f32x4*)(wa + 4 * lane + 256 * j); const f32x4 xi = *(const f32x4*)(xin + 4 * lane + 256 * j);
            v[j] = xi + v[j] * r1 * ww; *(f32x4*)(xout + 4 * lane + 256 * j) = v[j];
            s2 += (v[j][0] * v[j][0] + v[j][1] * v[j][1]) + (v[j][2] * v[j][2] + v[j][3] * v[j][3]); }
        if (wb) {
            const float r2 = __builtin_amdgcn_rsqf(wave_sum(s2) * (1.f / DM) + EPS);
#pragma unroll
            for (int j = 0; j < 8; ++j) { const f32x4 ww = *(const f32x4*)(wb + 4 * lane + 256 * j); u32x2 o; o.x = pk2(v[j][0] * r2 * ww[0], v[j][1] * r2 * ww[1]); o.y = pk2(v[j][2] * r2 * ww[2], v[j][3] * r2 * ww[3]);
                *(u32x2*)(H + (size_t)m * DM + 4 * lane + 256 * j) = o; }
        }
    }
}

DI void phase_conv(const Frame& F, int layer) {
    const bf16_t* U = (const bf16_t*)(F.ws + WS_U); bf16_t* ACT = (bf16_t*)(F.ws + WS_ACT);
    const float* cw = F.in[18] + (size_t)layer * 3 * FF2; const float* cb = F.in[19] + (size_t)layer * FF2; const float* sc = F.in[5] + (size_t)layer * DB * 2 * FF2;
    const int gt = F.bid * NTHREADS + F.tid, NGT = F.G * NTHREADS;
    constexpr int NCG = FF / 8, NITEM = (T / 32) * NCG;
    for (int it = gt; it < NITEM; it += NGT) {
        const int rc = it / NCG, cgp = it % NCG, j0 = cgp * 8, r0 = rc * 32;
        float wg[3][8], wu[3][8], bg[8], bu[8];
#pragma unroll
        for (int k = 0; k < 3; ++k) { const f32x4 a = *(const f32x4*)(cw + k * FF2 + j0), b = *(const f32x4*)(cw + k * FF2 + j0 + 4), c = *(const f32x4*)(cw + k * FF2 + FF + j0), d = *(const f32x4*)(cw + k * FF2 + FF + j0 + 4);
            for (int i = 0; i < 4; ++i) { wg[k][i] = a[i]; wg[k][4 + i] = b[i]; wu[k][i] = c[i]; wu[k][4 + i] = d[i]; } }
        { const f32x4 a = *(const f32x4*)(cb + j0), b = *(const f32x4*)(cb + j0 + 4), c = *(const f32x4*)(cb + FF + j0), d = *(const f32x4*)(cb + FF + j0 + 4);
          for (int i = 0; i < 4; ++i) { bg[i] = a[i]; bg[4 + i] = b[i]; bu[i] = c[i]; bu[4 + i] = d[i]; } }
        float g2[8], g1[8], u2[8], u1[8];
        const bool seq_start = r0 < TP ? ((r0 & (SEQ - 1)) == 0) : true;
        if (!seq_start) {
#pragma unroll
            for (int k = 0; k < 2; ++k) { const u32x4 a = *(const u32x4*)(U + (size_t)(r0 - 2 + k) * FF2 + j0), b = *(const u32x4*)(U + (size_t)(r0 - 2 + k) * FF2 + FF + j0);
                float* gd = k == 0 ? g2 : g1; float* ud = k == 0 ? u2 : u1;
                for (int i = 0; i < 4; ++i) { gd[2 * i] = __uint_as_float(a[i] << 16); gd[2 * i + 1] = __uint_as_float(a[i] & 0xffff0000u); ud[2 * i] = __uint_as_float(b[i] << 16); ud[2 * i + 1] = __uint_as_float(b[i] & 0xffff0000u); } }
        } else if (r0 < TP) {
            for (int i = 0; i < 8; ++i) { g2[i] = 0.f; g1[i] = 0.f; u2[i] = 0.f; u1[i] = 0.f; }
        } else {
            const int b = (r0 - TP) >> 5; const float* sp = sc + (size_t)b * 2 * FF2;
#pragma unroll
            for (int k = 0; k < 2; ++k) { const f32x4 a = *(const f32x4*)(sp + k * FF2 + j0), b2 = *(const f32x4*)(sp + k * FF2 + j0 + 4), c = *(const f32x4*)(sp + k * FF2 + FF + j0), d = *(const f32x4*)(sp + k * FF2 + FF + j0 + 4);
                float* gd = k == 0 ? g2 : g1; float* ud = k == 0 ? u2 : u1;
                for (int i = 0; i < 4; ++i) { gd[i] = a[i]; gd[4 + i] = b2[i]; ud[i] = c[i]; ud[4 + i] = d[i]; } }
        }
        for (int t = 0; t < 32; ++t) {
            const u32x4 a = *(const u32x4*)(U + (size_t)(r0 + t) * FF2 + j0), b = *(const u32x4*)(U + (size_t)(r0 + t) * FF2 + FF + j0);
            float g0[8], u0[8], o[8];
#pragma unroll
            for (int i = 0; i < 4; ++i) { g0[2 * i] = __uint_as_float(a[i] << 16); g0[2 * i + 1] = __uint_as_float(a[i] & 0xffff0000u); u0[2 * i] = __uint_as_float(b[i] << 16); u0[2 * i + 1] = __uint_as_float(b[i] & 0xffff0000u); }
#pragma unroll
            for (int i = 0; i < 8; ++i) { const float cgv = bg[i] + wg[0][i] * g2[i] + wg[1][i] * g1[i] + wg[2][i] * g0[i]; const float cuv = bu[i] + wu[0][i] * u2[i] + wu[1][i] * u1[i] + wu[2][i] * u0[i];
                o[i] = siluf_(cgv) * cuv; g2[i] = g1[i]; g1[i] = g0[i]; u2[i] = u1[i]; u1[i] = u0[i]; }
            u32x4 w; w.x = pk2(o[0], o[1]); w.y = pk2(o[2], o[3]); w.z = pk2(o[4], o[5]); w.w = pk2(o[6], o[7]);
            *(u32x4*)(ACT + (size_t)(r0 + t) * FF + j0) = w;
        }
    }
}

DI int kv_row_of(int row) { if (row < TP) return row; const int r = row - TP; return TP + (r >> 5) * KVSEQ + PAST + (r & 31); }
DI void phase_mlarow(const Frame& F) {
    const float* DOWN = (const float*)(F.ws + WS_DOWN); bf16_t* CQ = (bf16_t*)(F.ws + WS_CQ); bf16_t* CKVA = (bf16_t*)(F.ws + WS_CKVA); bf16_t* KPEA = (bf16_t*)(F.ws + WS_KPEA);
    const float* tab = (const float*)(F.ws + WS_TAB); const float* qw = F.in[12]; const float* kw = F.in[13];
    const int lane = F.lane; const int gw = F.bid * NWAVES + F.wave, NGW = F.G * NWAVES;
    for (int m = gw; m < T; m += NGW) {
        const float* dr = DOWN + (size_t)m * NDOWNP; const int kvr = kv_row_of(m);
        f32x4 a[2], b[2]; float sa = 0.f, sb = 0.f;
#pragma unroll
        for (int j = 0; j < 2; ++j) { a[j] = *(const f32x4*)(dr + 4 * lane + 256 * j); b[j] = *(const f32x4*)(dr + 512 + 4 * lane + 256 * j);
            sa += (a[j][0] * a[j][0] + a[j][1] * a[j][1]) + (a[j][2] * a[j][2] + a[j][3] * a[j][3]); sb += (b[j][0] * b[j][0] + b[j][1] * b[j][1]) + (b[j][2] * b[j][2] + b[j][3] * b[j][3]); }
        const float ra = __builtin_amdgcn_rsqf(wave_sum(sa) * (1.f / QL) + EPS), rb = __builtin_amdgcn_rsqf(wave_sum(sb) * (1.f / KVL) + EPS);
#pragma unroll
        for (int j = 0; j < 2; ++j) { const int c = 4 * lane + 256 * j; const f32x4 w1 = *(const f32x4*)(qw + c), w2 = *(const f32x4*)(kw + c);
            const f32x4 q = a[j] * ra * w1, kv = b[j] * rb * w2;
            u32x2 o; o.x = pk2(q[0], q[1]); o.y = pk2(q[2], q[3]); *(u32x2*)(CQ + (size_t)m * QL + c) = o;
            *(f32x4*)(F.out + O_CKV + (size_t)m * KVL + c) = kv;
            u32x2 o2; o2.x = pk2(kv[0], kv[1]); o2.y = pk2(kv[2], kv[3]); *(u32x2*)(CKVA + (size_t)kvr * KVL + c) = o2; }
        if (lane < 32) { const int pos = m < TP ? (m & (SEQ - 1)) : PAST + ((m - TP) & (DS - 1)); const float x1 = dr[1024 + lane], x2 = dr[1024 + 32 + lane];
            const f32x2 cs = *(const f32x2*)(tab + ((size_t)pos * 32 + lane) * 2); const float o1 = x1 * cs[0] - x2 * cs[1], o2 = x2 * cs[0] + x1 * cs[1];
            F.out[O_KPE + (size_t)m * ROPE + lane] = o1; F.out[O_KPE + (size_t)m * ROPE + 32 + lane] = o2;
            *(unsigned*)(KPEA + (size_t)kvr * ROPE + 2 * lane) = pk2(o1, o2); }
    }
    const float* cckv = F.in[3]; const float* ckpe = F.in[4];
    for (int i = gw; i < DB * PAST; i += NGW) { const int b = i >> 10, p = i & (PAST - 1); const int kvr = TP + b * KVSEQ + p;
#pragma unroll
        for (int j = 0; j < 2; ++j) { const int c = 4 * lane + 256 * j; const f32x4 v = *(const f32x4*)(cckv + (size_t)i * KVL + c); u32x2 o; o.x = pk2(v[0], v[1]); o.y = pk2(v[2], v[3]); *(u32x2*)(CKVA + (size_t)kvr * KVL + c) = o; }
        if (lane < 32) { const float x1 = ckpe[(size_t)i * ROPE + lane], x2 = ckpe[(size_t)i * ROPE + 32 + lane]; *(unsigned*)(KPEA + (size_t)kvr * ROPE + 2 * lane) = pk2(x1, x2); }
    }
}

#define MFMA32(a, b, c) __builtin_amdgcn_mfma_f32_32x32x16_bf16((a), (b), (c), 0, 0, 0)
DI void attn_unit(const Frame& F, int qrow0, int kvbase, int nkeys, int h) {
    const bf16_t* QA = (const bf16_t*)(F.ws + WS_QA); const bf16_t* KN = (const bf16_t*)(F.ws + WS_KN); const bf16_t* KPEA = (const bf16_t*)(F.ws + WS_KPEA); const bf16_t* VT = (const bf16_t*)(F.ws + WS_VT);
    bf16_t* AO = (bf16_t*)(F.ws + WS_AO);
    const int lane = F.lane, r = lane & 31, hf = lane >> 5;
    bf16x8 qf[12];
    { const bf16_t* qp = QA + (size_t)(qrow0 + r) * 3072 + h * QHD + 8 * hf;
#pragma unroll
      for (int s = 0; s < 12; ++s) qf[s] = *(const bf16x8*)(qp + 16 * s); }
    f32x16 ot[4];
#pragma unroll
    for (int d = 0; d < 4; ++d)
#pragma unroll
        for (int i = 0; i < 16; ++i) ot[d][i] = 0.f;
    float mrun = -INFINITY, lrun = 0.f;
    for (int key0 = 0; key0 < nkeys; key0 += 32) {
        const bf16_t* kp = KN + (size_t)(kvbase + key0 + r) * 2048 + h * NOPE + 8 * hf;
        const bf16_t* pp = KPEA + (size_t)(kvbase + key0 + r) * ROPE + 8 * hf;
        f32x16 sc;
#pragma unroll
        for (int i = 0; i < 16; ++i) sc[i] = 0.f;
#pragma unroll
        for (int s = 0; s < 8; ++s) sc = MFMA32(*(const bf16x8*)(kp + 16 * s), qf[s], sc);
#pragma unroll
        for (int s = 0; s < 4; ++s) sc = MFMA32(*(const bf16x8*)(pp + 16 * s), qf[8 + s], sc);
        float mx = sc[0];
#pragma unroll
        for (int i = 1; i < 16; ++i) mx = fmaxf(mx, sc[i]);
        mx = fmaxf(mx, __shfl_xor(mx, 32));
        const float mnew = fmaxf(mrun, mx), alpha = __builtin_amdgcn_exp2f(mrun - mnew);
        float ps = 0.f;
#pragma unroll
        for (int i = 0; i < 16; ++i) { sc[i] = __builtin_amdgcn_exp2f(sc[i] - mnew); ps += sc[i]; }
        lrun = lrun * alpha + ps; mrun = mnew;
#pragma unroll
        for (int d = 0; d < 4; ++d)
#pragma unroll
            for (int i = 0; i < 16; ++i) ot[d][i] *= alpha;
        bf16x8 pf[2];
#pragma unroll
        for (int ks = 0; ks < 2; ++ks) { u32x4 w; w.x = pk2(sc[8 * ks], sc[8 * ks + 1]); w.y = pk2(sc[8 * ks + 2], sc[8 * ks + 3]); w.z = pk2(sc[8 * ks + 4], sc[8 * ks + 5]); w.w = pk2(sc[8 * ks + 6], sc[8 * ks + 7]); pf[ks] = __builtin_bit_cast(bf16x8, w); }
#pragma unroll
        for (int d = 0; d < 4; ++d) {
            const bf16_t* vp = VT + (size_t)(h * VD + d * 32 + r) * KVROWS + kvbase + key0 + 4 * hf;
#pragma unroll
            for (int ks = 0; ks < 2; ++ks) { const u32x2 lo = *(const u32x2*)(vp + 16 * ks), hi = *(const u32x2*)(vp + 16 * ks + 8); const u32x4 w = {lo.x, lo.y, hi.x, hi.y};
                ot[d] = MFMA32(__builtin_bit_cast(bf16x8, w), pf[ks], ot[d]); }
        }
    }
    const float inv = __builtin_amdgcn_rcpf(lrun + __shfl_xor(lrun, 32));
    bf16_t* op = AO + (size_t)(qrow0 + r) * DM + h * VD + 4 * hf;
#pragma unroll
    for (int d = 0; d < 4; ++d)
#pragma unroll
        for (int g = 0; g < 4; ++g) { u32x2 o; o.x = pk2(ot[d][4 * g] * inv, ot[d][4 * g + 1] * inv); o.y = pk2(ot[d][4 * g + 2] * inv, ot[d][4 * g + 3] * inv); *(u32x2*)(op + d * 32 + 8 * g) = o; }
}
DI void phase_attn(const Frame& F) {
    const int NGW = F.G * NWAVES;
    for (int p = F.bid * NWAVES + F.wave; p < NB * HH * 32; p += NGW) {
        const int sh = p >> 5, j = p & 31, s = sh >> 4, h = sh & 15;
#pragma unroll 1
        for (int k = 0; k < 2; ++k) { const int qb = k == 0 ? j : 63 - j; attn_unit(F, s * SEQ + 32 * qb, s * SEQ, 64 * ((qb >> 1) + 1), h); }
    }
    for (int wv = F.bid * NWAVES + F.wave; wv < 2048; wv += NGW) if ((wv & 15) == 7) { const int u = wv >> 4, b = u >> 4, h = u & 15; attn_unit(F, TP + b * DS, TP + b * KVSEQ, KVSEQ, h); }
}

DI void run_gemm(const Frame& F, int gi) {
    unsigned char* ws = F.ws; pg8::Gemm g; EpiAll E{};
    const bf16_t* H = (const bf16_t*)(ws + WS_H);
    switch (gi) {
    case 0: g = {H, (const bf16_t*)(ws + WS_WT_HIN), T, 8192, 2048}; E.kind = EK_HGRN; E.Qb = (bf16_t*)(ws + WS_QB); E.FGp = (float*)(ws + WS_FG); E.Vb = (bf16_t*)(ws + WS_VB); E.SGp = (bf16_t*)(ws + WS_SG); E.lb = (const float*)(ws + WS_LB); break;
    case 1: g = {(const bf16_t*)(ws + WS_OG), (const bf16_t*)(ws + WS_WT_HOUT), T, 2048, 2048}; E.kind = EK_F32; E.C = ws + WS_M; E.ldc = DM; break;
    case 2: g = {H, (const bf16_t*)(ws + WS_WT_FIN), T, FF2, 2048}; E.kind = EK_FFN; E.C = ws + WS_U; E.convP = F.out + O_CONVP; E.convS = F.out + O_CONVS; break;
    case 3: g = {(const bf16_t*)(ws + WS_ACT), (const bf16_t*)(ws + WS_WT_FOUT), T, 2048, FF}; E.kind = EK_F32; E.C = ws + WS_M; E.ldc = DM; break;
    case 4: g = {H, (const bf16_t*)(ws + WS_WT_DOWN), T, NDOWNP, 2048}; E.kind = EK_F32; E.C = ws + WS_DOWN; E.ldc = NDOWNP; break;
    case 5: g = {(const bf16_t*)(ws + WS_CQ), (const bf16_t*)(ws + WS_WT_UQ), T, 3072, 512}; E.kind = EK_Q; E.C = ws + WS_QA; E.tab = (const float*)(ws + WS_TAB); E.qscale = 0.07216878364870322f * 1.4426950408889634f; break;
    case 6: g = {(const bf16_t*)(ws + WS_CKVA), (const bf16_t*)(ws + WS_WT_K), KVROWS, 2048, 512}; E.kind = EK_BF16; E.C = ws + WS_KN; E.ldc = 2048; break;
    case 7: g = {(const bf16_t*)(ws + WS_WT_V), (const bf16_t*)(ws + WS_CKVA), 2048, KVROWS, 512}; E.kind = EK_BF16; E.C = ws + WS_VT; E.ldc = KVROWS; break;
    case 8: g = {(const bf16_t*)(ws + WS_AO), (const bf16_t*)(ws + WS_WT_MOUT), T, 2048, 2048}; E.kind = EK_F32; E.C = ws + WS_M; E.ldc = DM; break;
    case 9: g = {H, (const bf16_t*)(ws + WS_WT_FIN) + (size_t)FF2 * 2048, T, FF2, 2048}; E.kind = EK_FFN; E.C = ws + WS_U; E.convP = F.out + O_CONVP + (size_t)NB * 2 * FF2; E.convS = F.out + O_CONVS + (size_t)DB * 2 * FF2; break;
    default: g = {(const bf16_t*)(ws + WS_ACT), (const bf16_t*)(ws + WS_WT_FOUT) + (size_t)2048 * FF, T, 2048, FF}; E.kind = EK_F32; E.C = ws + WS_M; E.ldc = DM; break;
    }
    pg8::StaticOrder S; S.init(g.M, g.N, F.G, F.bid);
    pg8::gemm_phase<EpiAll>(F.lds, g, S, E);
}

constexpr int N_PHASES = 20;
template <bool COOP>
__global__ void __launch_bounds__(NTHREADS, 2) mk_fwd(Args args) {
    extern __shared__ __attribute__((aligned(16))) unsigned char lds[];
    Frame F;
    F.lds = (LAS unsigned char*)lds;
    F.tid = threadIdx.x; F.lane = F.tid & 63; F.wave = __builtin_amdgcn_readfirstlane(F.tid >> 6); F.G = gridDim.x; F.bid = blockIdx.x;
    F.in = args.in; F.out = args.out; F.ws = args.ws;
    Frame F0 = F;
    for (int ph = args.ph_lo; ph < args.ph_hi; ++ph) {
        Frame F = F0;
        asm volatile("" : "+v"(F.tid), "+v"(F.lane));
        asm volatile("" : "+s"(F.wave), "+s"(F.bid), "+s"(F.G));
        int g0 = 0, g1 = 0;
        switch (ph) {
        case 1: g0 = 0; g1 = 1; break;
        case 4: g0 = 1; g1 = 2; break;
        case 6: g0 = 2; g1 = 3; break;
        case 8: g0 = 3; g1 = 4; break;
        case 10: g0 = 4; g1 = 5; break;
        case 12: g0 = 5; g1 = 8; break;
        case 14: g0 = 8; g1 = 9; break;
        case 16: g0 = 9; g1 = 10; break;
        case 18: g0 = 10; g1 = 11; break;
        default: break;
        }
        if (g1 > g0) {
#pragma unroll 1
            for (int gi = g0; gi < g1; ++gi) run_gemm(F, gi);
        } else {
#ifndef PHM
#define PHM 0xFFFFF
#endif
            switch (ph) {
            case 0: if (PHM & (1 << 0)) phase_prep(F); break;
            case 2: if (PHM & (1 << 2)) phase_scan(F); break;
            case 3: if (PHM & (1 << 3)) phase_gate(F); break;
            case 5: if (PHM & (1 << 5)) phase_rowpass(F, 0); break;
            case 7: if (PHM & (1 << 7)) phase_conv(F, 0); break;
            case 9: if (PHM & (1 << 9)) phase_rowpass(F, 1); break;
            case 11: if (PHM & (1 << 11)) phase_mlarow(F); break;
            case 13: if (PHM & (1 << 13)) phase_attn(F); break;
            case 15: if (PHM & (1 << 15)) phase_rowpass(F, 2); break;
            case 17: if (PHM & (1 << 17)) phase_conv(F, 1); break;
            default: if (PHM & (1 << 19)) phase_rowpass(F, 3); break;
            }
        }
        if (COOP) { if (ph + 1 < args.ph_hi) cg::this_grid().sync(); }
    }
}

extern "C" void kernel_launch(void* const* d_in, const int* in_sizes, int n_in, void* d_out, int out_size, void* d_ws, size_t ws_size, hipStream_t stream) {
    static int grid = 0;
    if (grid == 0) {
        if (n_in != 21 || (size_t)out_size != O_END || ws_size < WS_END) { fprintf(stderr, "kernel_launch: unexpected sizes n_in %d out %d (want %zu) ws %zu (need %zu)\n", n_in, out_size, (size_t)O_END, ws_size, (size_t)WS_END); grid = -1; return; }
        int dev = 0, cus = 0, per_cu = 0;
        hipGetDevice(&dev); hipDeviceGetAttribute(&cus, hipDeviceAttributeMultiprocessorCount, dev);
        hipFuncSetAttribute((const void*)mk_fwd<true>, hipFuncAttributeMaxDynamicSharedMemorySize, LDS_BYTES);
        hipFuncSetAttribute((const void*)mk_fwd<false>, hipFuncAttributeMaxDynamicSharedMemorySize, LDS_BYTES);
        hipOccupancyMaxActiveBlocksPerMultiprocessor(&per_cu, (const void*)mk_fwd<true>, NTHREADS, LDS_BYTES);
        if (per_cu < 1) { fprintf(stderr, "kernel_launch: occupancy query reports %d blocks per CU\n", per_cu); per_cu = 1; }
        (void)hipGetLastError();
        grid = cus;
    }
    if (grid < 0) return;
    Args a{};
    for (int i = 0; i < 21; ++i) a.in[i] = (const float*)d_in[i];
    a.out = (float*)d_out; a.ws = (unsigned char*)d_ws;
#if MK_ONE_LAUNCH
    a.ph_lo = 0; a.ph_hi = N_PHASES;
    void* kargs[] = {&a};
    hipError_t e = hipLaunchCooperativeKernel((const void*)mk_fwd<true>, dim3(grid), dim3(NTHREADS), kargs, LDS_BYTES, stream);
    if (e != hipSuccess) fprintf(stderr, "cooperative launch failed: %s (grid %d)\n", hipGetErrorString(e), grid);
#else
    for (int ph = 0; ph < N_PHASES; ++ph) {
        a.ph_lo = ph; a.ph_hi = ph + 1;
        hipLaunchKernelGGL(mk_fwd<false>, dim3(grid), dim3(NTHREADS), LDS_BYTES, stream, a);
    }
#endif
}
```

```cpp
#include <hip/hip_runtime.h>
#include <hip/hip_cooperative_groups.h>
#include <cstdio>
#include <cstdint>
namespace cg = cooperative_groups;

#ifndef MK_ONE_LAUNCH
#define MK_ONE_LAUNCH 1
#endif

#define LAS __attribute__((address_space(3)))
#define DI __device__ __forceinline__
typedef unsigned short bf16_t;
typedef short bf16x8 __attribute__((ext_vector_type(8)));
typedef float f32x4 __attribute__((ext_vector_type(4)));
typedef float f32x2 __attribute__((ext_vector_type(2)));
typedef float f32x16 __attribute__((ext_vector_type(16)));
typedef unsigned u32x4 __attribute__((ext_vector_type(4)));
typedef unsigned u32x2 __attribute__((ext_vector_type(2)));
typedef __bf16 bf16x2_t __attribute__((ext_vector_type(2)));

constexpr int DM = 2048, NB = 4, SEQ = 2048, DB = 8, DS = 32, PAST = 1024;
constexpr int TP = NB * SEQ, TS = DB * DS, T = TP + TS;
constexpr int HH = 16, DK = 128, DV = 128;
constexpr int QL = 512, KVL = 512, NOPE = 128, ROPE = 64, VD = 128, QHD = NOPE + ROPE;
constexpr int NDOWN = QL + KVL + ROPE, NDOWNP = 1280;
constexpr int FF = 5632, FF2 = 2 * FF;
constexpr int KVSEQ = PAST + DS;
constexpr int KVROWS = TP + DB * KVSEQ;
constexpr float EPS = 1e-6f;
constexpr int NTHREADS = 512, NWAVES = 8;

constexpr size_t O_Y = 0;
constexpr size_t O_HG = (size_t)T * DM;
constexpr size_t O_CKV = O_HG + (size_t)12 * HH * DK * DV;
constexpr size_t O_KPE = O_CKV + (size_t)T * KVL;
constexpr size_t O_CONVP = O_KPE + (size_t)T * ROPE;
constexpr size_t O_CONVS = O_CONVP + (size_t)2 * NB * 2 * FF2;
constexpr size_t O_END = O_CONVS + (size_t)2 * DB * 2 * FF2;

constexpr size_t al256(size_t x) { return (x + 255) & ~(size_t)255; }
constexpr size_t WS_WT_HIN = 0;
constexpr size_t WS_WT_HOUT = WS_WT_HIN + (size_t)8192 * 2048 * 2;
constexpr size_t WS_WT_DOWN = WS_WT_HOUT + (size_t)2048 * 2048 * 2;
constexpr size_t WS_WT_UQ = WS_WT_DOWN + (size_t)NDOWNP * 2048 * 2;
constexpr size_t WS_WT_K = WS_WT_UQ + (size_t)3072 * 512 * 2;
constexpr size_t WS_WT_V = WS_WT_K + (size_t)2048 * 512 * 2;
constexpr size_t WS_WT_MOUT = WS_WT_V + (size_t)2048 * 512 * 2;
constexpr size_t WS_WT_FIN = WS_WT_MOUT + (size_t)2048 * 2048 * 2;
constexpr size_t WS_WT_FOUT = WS_WT_FIN + (size_t)2 * FF2 * 2048 * 2;
constexpr size_t WS_TAB = WS_WT_FOUT + (size_t)2 * 2048 * FF * 2;
constexpr size_t WS_LB = WS_TAB + (size_t)2048 * 32 * 2 * 4;
constexpr size_t WS_X = WS_LB + 2048 * 4;
constexpr size_t WS_H = WS_X + (size_t)T * DM * 4;
constexpr size_t WS_M = WS_H + (size_t)T * DM * 2;
constexpr size_t WS_R = WS_M + (size_t)T * DM * 4;
constexpr size_t WS_QB = WS_R;
constexpr size_t WS_FG = WS_QB + (size_t)T * DM * 2;
constexpr size_t WS_VB = WS_FG + (size_t)T * DM * 4;
constexpr size_t WS_SG = WS_VB + (size_t)T * DM * 2;
constexpr size_t WS_O32 = WS_SG + (size_t)T * DM * 2;
constexpr size_t WS_OG = WS_O32 + (size_t)T * DM * 4;
constexpr size_t WS_RA_END = WS_OG + (size_t)T * DM * 2;
constexpr size_t WS_U = WS_R;
constexpr size_t WS_ACT = WS_U + (size_t)T * FF2 * 2;
constexpr size_t WS_RB_END = WS_ACT + (size_t)T * FF * 2;
constexpr size_t WS_DOWN = WS_R;
constexpr size_t WS_CQ = WS_DOWN + (size_t)T * NDOWNP * 4;
constexpr size_t WS_CKVA = WS_CQ + (size_t)T * QL * 2;
constexpr size_t WS_KPEA = WS_CKVA + (size_t)KVROWS * KVL * 2;
constexpr size_t WS_QA = WS_KPEA + (size_t)KVROWS * ROPE * 2;
constexpr size_t WS_KN = WS_QA + (size_t)T * 3072 * 2;
constexpr size_t WS_VT = WS_KN + (size_t)KVROWS * 2048 * 2;
constexpr size_t WS_AO = WS_VT + (size_t)2048 * KVROWS * 2;
constexpr size_t WS_RC_END = WS_AO + (size_t)T * DM * 2;
constexpr size_t cmax(size_t a, size_t b) { return a > b ? a : b; }
constexpr size_t WS_END = cmax(WS_RA_END, cmax(WS_RB_END, WS_RC_END));

constexpr int LDS_BYTES = 147456;

DI float bf2f(unsigned short b) { return __uint_as_float((unsigned)b << 16); }
DI unsigned pk2(float lo, float hi) { f32x2 v = {lo, hi}; bf16x2_t b = __builtin_convertvector(v, bf16x2_t); return __builtin_bit_cast(unsigned, b); }
DI float fexp(float x) { return __builtin_amdgcn_exp2f(x * 1.4426950408889634f); }
DI float sigmoidf_(float x) { return __builtin_amdgcn_rcpf(1.f + fexp(-x)); }
DI float siluf_(float x) { return x * sigmoidf_(x); }
DI float wave_sum(float v) {
#pragma unroll
    for (int o = 1; o < 64; o <<= 1) v += __shfl_xor(v, o);
    return v;
}

namespace pg8 {
constexpr int BM = 256, BK = 64, HALF = 128, HTB = HALF * BK * 2, STAGE_BYTES = 8 * HTB, NXCD = 8, WGM = 8;
__host__ __device__ __forceinline__ int lds_byte(int r, int c) { const int st = (r >> 4) * 2 + (c >> 5), rr = r & 15, cc = c & 31, ob = rr * 64 + cc * 2; return st * 1024 + (ob ^ (((ob >> 9) & 1) << 5)); }
__host__ __device__ __forceinline__ void stage_rc(int b, int& R, int& C) { const int st = b / 1024, sb = b % 1024, swz = sb ^ (((sb >> 9) & 1) << 5); R = (st >> 1) * 16 + swz / 64; C = (st & 1) * 32 + (swz % 64) / 2; }

struct Unit { int pm, pn; };
struct Gemm { const bf16_t* A; const bf16_t* Bt; int M, N, K; };

struct StaticOrder {
    int nM, nN, nwg, G, c;
    __host__ __device__ void init(int M, int N, int G_, int c_) { nM = M / BM; nN = N / BM; nwg = nM * nN; G = G_; c = c_; }
    __host__ __device__ bool next(int i, Unit& u) const {
        const long L = (long)i * G + c; if (L >= nwg) return false;
        int wgid = (int)L; { const int q = nwg / NXCD, r = nwg % NXCD, xcd = wgid % NXCD, off = wgid / NXCD; wgid = (xcd < r ? xcd * (q + 1) : r * (q + 1) + (xcd - r) * q) + off; }
        const int nig = WGM * nN, gid = wgid / nig, fm = gid * WGM, gsz = (nM - fm) < WGM ? (nM - fm) : WGM;
        u.pm = fm + ((wgid % nig) % gsz); u.pn = (wgid % nig) / gsz; return true;
    }
};

template <class Epi>
__device__ __forceinline__ void gemm_phase(LAS unsigned char* lds, const Gemm g, const StaticOrder& S, const Epi& E) {
    const int tid = threadIdx.x, wid = __builtin_amdgcn_readfirstlane(tid >> 6), lane = tid & 63, wr = wid >> 2, wc = wid & 3, fr = lane & 15, fq = lane >> 4;
    const int K = g.K, nt = K / BK;
    unsigned voffA[2], voffB[2];
#pragma unroll
    for (int i = 0; i < 2; ++i) { int R, C; stage_rc(tid * 16 + i * 8192, R, C);
        voffA[i] = (unsigned)(R * K + C) * 2u; voffB[i] = (unsigned)(R * K + C) * 2u; }
    const size_t kstep = (size_t)(BK * 2);
    const size_t hstep = (size_t)HALF * K * 2;
    const size_t tstep = 2 * hstep;
    const unsigned ldsw = (unsigned)wid * 1024u;
    const int aoff = lds_byte(wr * 64 + fr, fq * 8), boff = lds_byte(wc * 32 + fr, fq * 8);
#define PG8_SA(b, h) (((b) * 2 + (h)) * HTB)
#define PG8_SB(b, h) ((4 + (b) * 2 + (h)) * HTB)
#define PG8_STAGE(bufoff, gbase, voff) do { _Pragma("unroll") for (int _i = 0; _i < 2; ++_i) \
        __builtin_amdgcn_global_load_lds((const unsigned*)((const char*)(gbase) + (voff)[_i]), (LAS unsigned*)(lds + (bufoff) + ldsw + _i * 8192), 16, 0, 0); } while (0)
#define PG8_LDA(dst, b, h) do { _Pragma("unroll") for (int m = 0; m < 4; ++m) _Pragma("unroll") for (int k = 0; k < 2; ++k) dst[m][k] = *(const LAS bf16x8*)(lds + PG8_SA(b, h) + aoff + m * 2048 + k * 1024); } while (0)
#define PG8_LDB(dst, b, h) do { _Pragma("unroll") for (int n = 0; n < 2; ++n) _Pragma("unroll") for (int k = 0; k < 2; ++k) dst[n][k] = *(const LAS bf16x8*)(lds + PG8_SB(b, h) + boff + n * 2048 + k * 1024); } while (0)
#define PG8_MMA(ai, bj, At, Bt) do { __builtin_amdgcn_s_setprio(1); _Pragma("unroll") for (int m = 0; m < 4; ++m) _Pragma("unroll") for (int n = 0; n < 2; ++n) _Pragma("unroll") for (int k = 0; k < 2; ++k) \
        acc[ai][bj][m][n] = __builtin_amdgcn_mfma_f32_16x16x32_bf16(Bt[n][k], At[m][k], acc[ai][bj][m][n], 0, 0, 0); __builtin_amdgcn_s_setprio(0); } while (0)
#define PG8_WAIT_V(n) asm volatile("s_waitcnt vmcnt(" #n ")" ::: "memory")
#define PG8_WAIT_L(n) asm volatile("s_waitcnt lgkmcnt(" #n ")" ::: "memory")
#define PG8_BAR __builtin_amdgcn_s_barrier()
#define PG8_SCHED __builtin_amdgcn_sched_barrier(0)
    Unit cur, nxt; int ui = 0;
    if (!S.next(0, cur)) return;
    f32x4 acc[2][2][4][2];
#pragma unroll
    for (int a = 0; a < 2; ++a)
#pragma unroll
        for (int b = 0; b < 2; ++b)
#pragma unroll
            for (int m = 0; m < 4; ++m)
#pragma unroll
                for (int n = 0; n < 2; ++n) acc[a][b][m][n] = (f32x4){0.f, 0.f, 0.f, 0.f};
    bf16x8 At[4][2], B0[2][2], B1[2][2];
    const char* cA = (const char*)g.A + (size_t)cur.pm * tstep; const char* cB = (const char*)g.Bt + (size_t)cur.pn * tstep;
    PG8_STAGE(PG8_SB(0, 0), cB, voffB); PG8_STAGE(PG8_SB(0, 1), cB + hstep, voffB); PG8_STAGE(PG8_SA(0, 0), cA, voffA); PG8_STAGE(PG8_SA(0, 1), cA + hstep, voffA);
    if (wr == 1) PG8_BAR;
    PG8_WAIT_V(2); PG8_BAR;
    PG8_STAGE(PG8_SB(1, 0), cB + kstep, voffB); PG8_STAGE(PG8_SA(1, 0), cA + kstep, voffA); PG8_STAGE(PG8_SB(1, 1), cB + hstep + kstep, voffB);
    PG8_WAIT_V(6); PG8_BAR;
    for (;;) {
        const bool has_next = S.next(ui + 1, nxt);
        const char* nA = has_next ? (const char*)g.A + (size_t)nxt.pm * tstep : cA; const char* nB = has_next ? (const char*)g.Bt + (size_t)nxt.pn * tstep : cB;
        for (int t = 0; t < nt; t += 2) {
            const bool last = (t == nt - 2);
            const char* a1 = cA + (size_t)(t + 1) * kstep;
            const char* a2 = last ? nA : cA + (size_t)(t + 2) * kstep; const char* b2 = last ? nB : cB + (size_t)(t + 2) * kstep;
            const char* a3 = a2 + kstep; const char* b3 = b2 + kstep;
            PG8_LDB(B0, 0, 0); PG8_LDB(B1, 0, 1); PG8_SCHED; PG8_LDA(At, 0, 0); PG8_STAGE(PG8_SA(1, 1), a1 + hstep, voffA);
            PG8_WAIT_V(8); PG8_WAIT_L(0); PG8_BAR; PG8_MMA(0, 0, At, B0); PG8_MMA(0, 1, At, B1); PG8_BAR; PG8_SCHED;
            PG8_LDA(At, 0, 1); PG8_STAGE(PG8_SB(0, 0), b2, voffB); PG8_STAGE(PG8_SB(0, 1), b2 + hstep, voffB); PG8_STAGE(PG8_SA(0, 0), a2, voffA);
            PG8_WAIT_V(8); PG8_WAIT_L(0); PG8_BAR; PG8_MMA(1, 0, At, B0); PG8_MMA(1, 1, At, B1); PG8_BAR; PG8_SCHED;
            PG8_LDB(B0, 1, 0); PG8_LDB(B1, 1, 1); PG8_SCHED; PG8_LDA(At, 1, 0); PG8_STAGE(PG8_SA(0, 1), a2 + hstep, voffA);
            PG8_WAIT_V(8); PG8_WAIT_L(0); PG8_BAR; PG8_MMA(0, 0, At, B0); PG8_MMA(0, 1, At, B1); PG8_BAR; PG8_SCHED;
            PG8_LDA(At, 1, 1); PG8_STAGE(PG8_SB(1, 0), b3, voffB); PG8_STAGE(PG8_SB(1, 1), b3 + hstep, voffB); PG8_STAGE(PG8_SA(1, 0), a3, voffA);
            PG8_WAIT_V(8); PG8_WAIT_L(0); PG8_BAR; PG8_MMA(1, 0, At, B0); PG8_MMA(1, 1, At, B1); PG8_BAR; PG8_SCHED;
        }
        if (wr == 0) PG8_BAR;
        E(acc, cur, wr, wc, fr, fq);
        if (!has_next) break;
#pragma unroll
        for (int a = 0; a < 2; ++a)
#pragma unroll
            for (int b = 0; b < 2; ++b)
#pragma unroll
                for (int m = 0; m < 4; ++m)
#pragma unroll
                    for (int n = 0; n < 2; ++n) acc[a][b][m][n] = (f32x4){0.f, 0.f, 0.f, 0.f};
        cur = nxt; cA = nA; cB = nB; ++ui;
        if (wr == 1) PG8_BAR;
    }
    PG8_WAIT_V(0);
    PG8_BAR;
#undef PG8_SA
#undef PG8_SB
#undef PG8_STAGE
#undef PG8_LDA
#undef PG8_LDB
#undef PG8_MMA
#undef PG8_WAIT_V
#undef PG8_WAIT_L
#undef PG8_BAR
#undef PG8_SCHED
}
}

struct Args { const float* in[21]; float* out; unsigned char* ws; int ph_lo, ph_hi; };

struct Frame {
    LAS unsigned char* lds;
    int tid, lane, wave, G, bid;
    const float* const* in; float* out; unsigned char* ws;
};

enum EpiKind { EK_F32 = 0, EK_BF16 = 1, EK_HGRN = 2, EK_FFN = 3, EK_Q = 4 };
struct EpiAll {
    int kind, ldc;
    void* C;
    bf16_t* Qb; float* FGp; bf16_t* Vb; bf16_t* SGp; const float* lb;
    float* convP; float* convS;
    const float* tab; float qscale;
    DI void st_bf16(bf16_t* p, f32x4 v) const { u32x2 w; w.x = pk2(v[0], v[1]); w.y = pk2(v[2], v[3]); *(u32x2*)p = w; }
    DI void one(int row, int col, f32x4 v) const {
        if (kind == EK_F32) { *(f32x4*)((float*)C + (size_t)row * ldc + col) = v; }
        else if (kind == EK_BF16) { st_bf16((bf16_t*)C + (size_t)row * ldc + col, v); }
        else if (kind == EK_HGRN) {
            const int sec = col >> 11, c = col & 2047; const size_t off = (size_t)row * DM + c;
            if (sec == 0) { f32x4 o; for (int i = 0; i < 4; ++i) o[i] = siluf_(v[i]); st_bf16(Qb + off, o); }
            else if (sec == 1) { const f32x4 l = *(const f32x4*)(lb + c); f32x4 o; for (int i = 0; i < 4; ++i) o[i] = l[i] + (1.f - l[i]) * sigmoidf_(v[i]); *(f32x4*)(FGp + off) = o; }
            else if (sec == 2) { st_bf16(Vb + off, v); }
            else { f32x4 o; for (int i = 0; i < 4; ++i) o[i] = siluf_(v[i]); st_bf16(SGp + off, o); }
        }
        else if (kind == EK_FFN) {
            st_bf16((bf16_t*)C + (size_t)row * FF2 + col, v);
            if (row < TP) { const int t = row & (SEQ - 1); if (t >= SEQ - 2) *(f32x4*)(convP + ((size_t)((row >> 11) * 2 + (t - (SEQ - 2)))) * FF2 + col) = v; }
            else { const int r = row - TP, t = r & (DS - 1); if (t >= DS - 2) *(f32x4*)(convS + ((size_t)((r >> 5) * 2 + (t - (DS - 2)))) * FF2 + col) = v; }
        }
        else {
            const int hc = col % QHD; f32x4 o = v;
            if (hc >= NOPE) {
                const int i0 = (hc - NOPE) >> 1;
                const int pos = row < TP ? (row & (SEQ - 1)) : PAST + ((row - TP) & (DS - 1));
                const f32x4 cs = *(const f32x4*)(tab + ((size_t)pos * 32 + i0) * 2);
                o[0] = v[0] * cs[0] - v[1] * cs[1]; o[1] = v[1] * cs[0] + v[0] * cs[1];
                o[2] = v[2] * cs[2] - v[3] * cs[3]; o[3] = v[3] * cs[2] + v[2] * cs[3];
            }
            o = o * qscale; st_bf16((bf16_t*)C + (size_t)row * 3072 + col, o);
        }
    }
    DI void operator()(const f32x4 (&acc)[2][2][4][2], const pg8::Unit& u, int wr, int wc, int fr, int fq) const {
#pragma unroll
        for (int ai = 0; ai < 2; ++ai)
#pragma unroll
            for (int m = 0; m < 4; ++m) {
                const int row = u.pm * 256 + ai * 128 + wr * 64 + m * 16 + fr;
#pragma unroll
                for (int bj = 0; bj < 2; ++bj)
#pragma unroll
                    for (int n = 0; n < 2; ++n) one(row, u.pn * 256 + bj * 128 + wc * 32 + n * 16 + fq * 4, acc[ai][bj][m][n]);
            }
    }
};

enum RowMap { RM_ID = 0, RM_UQ = 1, RM_UKV = 2 };
DI int map_row(int mode, int n) {
    if (mode == RM_UQ) { const int h = n / QHD, j = n % QHD; if (j < NOPE) return n; const int i = j - NOPE; return h * QHD + NOPE + (i < 32 ? 2 * i : 2 * (i - 32) + 1); }
    if (mode == RM_UKV) { const int h = n >> 8, j = n & 255; return (j < 128 ? 0 : 2048) + h * 128 + (j & 127); }
    return n;
}
DI void transpose_item(const float* W, int K, int N, bf16_t* WT, int mode, LAS float* scr, int item, int lane) {
    const int nblk = N / 32, kb = item / nblk, nb = item % nblk, k0 = 64 * kb, n0 = 32 * nb;
#pragma unroll 8
    for (int i = 0; i < 32; ++i) { const int kk = 2 * i + (lane >> 5); scr[kk * 33 + (lane & 31)] = W[(size_t)(k0 + kk) * N + n0 + (lane & 31)]; }
    asm volatile("s_waitcnt lgkmcnt(0)" ::: "memory");
    const int c = lane & 7;
#pragma unroll
    for (int j = 0; j < 4; ++j) { const int n = (lane >> 3) + 8 * j; const LAS float* s = scr + (8 * c) * 33 + n;
        u32x4 o; o.x = pk2(s[0 * 33], s[1 * 33]); o.y = pk2(s[2 * 33], s[3 * 33]); o.z = pk2(s[4 * 33], s[5 * 33]); o.w = pk2(s[6 * 33], s[7 * 33]);
        *(u32x4*)(WT + (size_t)map_row(mode, n0 + n) * K + k0 + 8 * c) = o; }
    asm volatile("s_waitcnt lgkmcnt(0)" ::: "memory");
}
DI const float* xrow_ptr(const Frame& F, int row) { return row < TP ? F.in[0] + (size_t)row * DM : F.in[1] + (size_t)(row - TP) * DM; }

DI void norm_row_bf16(const float* xr, const float* w, bf16_t* hr, int lane) {
    f32x4 v[8]; float s = 0.f;
#pragma unroll
    for (int j = 0; j < 8; ++j) { v[j] = *(const f32x4*)(xr + 4 * lane + 256 * j); s += (v[j][0] * v[j][0] + v[j][1] * v[j][1]) + (v[j][2] * v[j][2] + v[j][3] * v[j][3]); }
    const float r = __builtin_amdgcn_rsqf(wave_sum(s) * (1.f / DM) + EPS);
#pragma unroll
    for (int j = 0; j < 8; ++j) { const f32x4 ww = *(const f32x4*)(w + 4 * lane + 256 * j); u32x2 o; o.x = pk2(v[j][0] * r * ww[0], v[j][1] * r * ww[1]); o.y = pk2(v[j][2] * r * ww[2], v[j][3] * r * ww[3]);
        *(u32x2*)(hr + 4 * lane + 256 * j) = o; }
}

DI void phase_prep(const Frame& F) {
    LAS float* scr = (LAS float*)(F.lds + F.wave * 16384);
    const int gw = F.bid * NWAVES + F.wave, NGW = F.G * NWAVES;
    unsigned char* ws = F.ws;
    constexpr int I_HIN = 32 * 256, I_HOUT = 32 * 64, I_DOWN = 32 * 34, I_UQ = 8 * 96, I_UKV = 8 * 128, I_MOUT = 32 * 64, I_FIN = 32 * 352, I_FOUT = 88 * 64;
    constexpr int NITEMS = I_HIN + I_HOUT + I_DOWN + I_UQ + I_UKV + I_MOUT + 2 * I_FIN + 2 * I_FOUT;
    for (int it = gw; it < NITEMS; it += NGW) {
        int r = it; const float* W; bf16_t* WT; int K, N, mode = RM_ID;
        if (r < I_HIN) { W = F.in[8]; K = 2048; N = 8192; WT = (bf16_t*)(ws + WS_WT_HIN); }
        else if ((r -= I_HIN) < I_HOUT) { W = F.in[10]; K = 2048; N = 2048; WT = (bf16_t*)(ws + WS_WT_HOUT); }
        else if ((r -= I_HOUT) < I_DOWN) { W = F.in[11]; K = 2048; N = NDOWN; WT = (bf16_t*)(ws + WS_WT_DOWN); }
        else if ((r -= I_DOWN) < I_UQ) { W = F.in[14]; K = 512; N = 3072; WT = (bf16_t*)(ws + WS_WT_UQ); mode = RM_UQ; }
        else if ((r -= I_UQ) < I_UKV) { W = F.in[15]; K = 512; N = 4096; WT = (bf16_t*)(ws + WS_WT_K); mode = RM_UKV; }
        else if ((r -= I_UKV) < I_MOUT) { W = F.in[16]; K = 2048; N = 2048; WT = (bf16_t*)(ws + WS_WT_MOUT); }
        else if ((r -= I_MOUT) < 2 * I_FIN) { const int l = r / I_FIN; r -= l * I_FIN; W = F.in[17] + (size_t)l * 2048 * FF2; K = 2048; N = FF2; WT = (bf16_t*)(ws + WS_WT_FIN) + (size_t)l * FF2 * 2048; }
        else { r -= 2 * I_FIN; const int l = r / I_FOUT; r -= l * I_FOUT; W = F.in[20] + (size_t)l * FF * 2048; K = FF; N = 2048; WT = (bf16_t*)(ws + WS_WT_FOUT) + (size_t)l * 2048 * FF; }
        transpose_item(W, K, N, WT, mode, scr, r, F.lane);
    }
    { const int gt = F.bid * NTHREADS + F.tid, NGT = F.G * NTHREADS; u32x4* p = (u32x4*)((bf16_t*)(ws + WS_WT_DOWN) + (size_t)NDOWN * 2048);
      for (int i = gt; i < (NDOWNP - NDOWN) * 256; i += NGT) p[i] = (u32x4){0u, 0u, 0u, 0u}; }
    { const int gt = F.bid * NTHREADS + F.tid, NGT = F.G * NTHREADS; float* tab = (float*)(ws + WS_TAB);
      for (int i = gt; i < 2048 * 32; i += NGT) { const int pos = i >> 5, k = i & 31;
          double inv = 1.0;
          for (int q = 0; q < k; ++q) inv *= 0.7498942093324559;
          const double rev = (double)pos * inv * 0.15915494309189535; const float fr = (float)(rev - floor(rev));
          tab[2 * i] = __builtin_amdgcn_cosf(fr); tab[2 * i + 1] = __builtin_amdgcn_sinf(fr); }
      float* lb = (float*)(ws + WS_LB); const float* lg = F.in[7];
      for (int i = gt; i < 2048; i += NGT) { const float a = lg[i], b = lg[2048 + i], c = lg[4096 + i]; const float mx = fmaxf(a, fmaxf(b, c));
          const float ea = fexp(a - mx), eb = fexp(b - mx), ec = fexp(c - mx); lb[i] = ea / (ea + eb + ec); } }
    for (int m = gw; m < T; m += NGW) norm_row_bf16(xrow_ptr(F, m), F.in[6], (bf16_t*)(ws + WS_H) + (size_t)m * DM, F.lane);
}

DI void phase_scan(const Frame& F) {
    LAS float* Lf = (LAS float*)(F.lds);
    LAS bf16_t* Lq = (LAS bf16_t*)(F.lds + 32768);
    LAS float* Lv = (LAS float*)(F.lds + 49152);
    const bf16_t* Qb = (const bf16_t*)(F.ws + WS_QB); const float* FG = (const float*)(F.ws + WS_FG); const bf16_t* Vb = (const bf16_t*)(F.ws + WS_VB);
    float* O32 = (float*)(F.ws + WS_O32);
    const int tid = F.tid, lane = F.lane, w = F.wave;
    for (int item = F.bid; item < 768; item += F.G) {
        int s, h, dvq, L, row0;
        if (item < 256) { s = item >> 6; h = (item >> 2) & 15; dvq = item & 3; L = SEQ; row0 = s * SEQ; }
        else { const int it = item - 256; s = 4 + (it >> 6); h = (it >> 2) & 15; dvq = it & 3; L = DS; row0 = TP + (s - 4) * DS; }
        const int CL = L < 64 ? L : 64, nch = L / CL;
        const int c0 = dvq * 32 + w * 4;
        float S0[4], S1[4];
        if (s < 4) { for (int c = 0; c < 4; ++c) { S0[c] = 0.f; S1[c] = 0.f; } }
        else { const float* st = F.in[2] + ((size_t)((s - 4) * HH + h) * DK + 2 * lane) * DV + c0; const f32x4 a = *(const f32x4*)st, b = *(const f32x4*)(st + DV);
               for (int c = 0; c < 4; ++c) { S0[c] = a[c]; S1[c] = b[c]; } }
        for (int ch = 0; ch < nch; ++ch) {
            const int t0 = ch * CL;
            __syncthreads();
#pragma unroll
            for (int i = 0; i < 4; ++i) { const int e = tid * 4 + 2048 * i, r = e >> 7, c = e & 127; if (r < CL) *(LAS f32x4*)(Lf + e) = *(const f32x4*)(FG + (size_t)(row0 + t0 + r) * DM + h * DK + c); }
#pragma unroll
            for (int i = 0; i < 2; ++i) { const int e = tid * 8 + 4096 * i, r = e >> 7, c = e & 127; if (r < CL) *(LAS u32x4*)(Lq + e) = *(const u32x4*)(Qb + (size_t)(row0 + t0 + r) * DM + h * DK + c); }
            { const int e = tid * 4, r = e >> 5, c = e & 31; if (r < CL) { const u32x2 v = *(const u32x2*)(Vb + (size_t)(row0 + t0 + r) * DM + h * DV + dvq * 32 + c);
                  *(LAS f32x4*)(Lv + e) = (f32x4){__uint_as_float(v.x << 16), __uint_as_float(v.x & 0xffff0000u), __uint_as_float(v.y << 16), __uint_as_float(v.y & 0xffff0000u)}; } }
            __syncthreads();
            for (int t = 0; t < CL; ++t) {
                const f32x2 f2 = *(const LAS f32x2*)(Lf + t * 128 + 2 * lane);
                const unsigned q2 = *(const LAS unsigned*)(Lq + t * 128 + 2 * lane);
                const f32x4 v4 = *(const LAS f32x4*)(Lv + t * 32 + w * 4);
                const float q0 = __uint_as_float(q2 << 16), q1 = __uint_as_float(q2 & 0xffff0000u);
                const float k0 = 1.f - f2[0], k1 = 1.f - f2[1];
                float p[4];
#pragma unroll
                for (int c = 0; c < 4; ++c) { S0[c] = f2[0] * S0[c] + k0 * v4[c]; S1[c] = f2[1] * S1[c] + k1 * v4[c]; p[c] = q0 * S0[c] + q1 * S1[c]; }
                float a0 = (lane & 1) ? p[1] : p[0], b0 = (lane & 1) ? p[0] : p[1];
                float a1 = (lane & 1) ? p[3] : p[2], b1 = (lane & 1) ? p[2] : p[3];
                a0 += __shfl_xor(b0, 1); a1 += __shfl_xor(b1, 1);
                float a = (lane & 2) ? a1 : a0, b = (lane & 2) ? a0 : a1;
                a += __shfl_xor(b, 2);
                a += __shfl_xor(a, 4); a += __shfl_xor(a, 8); a += __shfl_xor(a, 16); a += __shfl_xor(a, 32);
                if (lane < 4) O32[(size_t)(row0 + t0 + t) * DM + h * DV + c0 + lane] = a;
            }
        }
        { float* so = F.out + O_HG + ((size_t)(s * HH + h) * DK + 2 * lane) * DV + c0;
          *(f32x4*)so = (f32x4){S0[0], S0[1], S0[2], S0[3]}; *(f32x4*)(so + DV) = (f32x4){S1[0], S1[1], S1[2], S1[3]}; }
    }
}

DI void phase_gate(const Frame& F) {
    const float* O32 = (const float*)(F.ws + WS_O32); const bf16_t* SG = (const bf16_t*)(F.ws + WS_SG); bf16_t* OG = (bf16_t*)(F.ws + WS_OG);
    const float* gw_ = F.in[9]; const int lane = F.lane;
    const int gw = F.bid * NWAVES + F.wave, NGW = F.G * NWAVES;
    for (int m = gw; m < T; m += NGW) {
#pragma unroll
        for (int j = 0; j < 8; ++j) {
            const int col = 4 * lane + 256 * j;
            const f32x4 v = *(const f32x4*)(O32 + (size_t)m * DM + col);
            float s = (v[0] * v[0] + v[1] * v[1]) + (v[2] * v[2] + v[3] * v[3]);
            s += __shfl_xor(s, 1); s += __shfl_xor(s, 2); s += __shfl_xor(s, 4); s += __shfl_xor(s, 8); s += __shfl_xor(s, 16);
            const float r = __builtin_amdgcn_rsqf(s * (1.f / DV) + EPS);
            const f32x4 g = *(const f32x4*)(gw_ + (col & 127)); const u32x2 sg = *(const u32x2*)(SG + (size_t)m * DM + col);
            u32x2 o; o.x = pk2(v[0] * r * g[0] * __uint_as_float(sg.x << 16), v[1] * r * g[1] * __uint_as_float(sg.x & 0xffff0000u));
            o.y = pk2(v[2] * r * g[2] * __uint_as_float(sg.y << 16), v[3] * r * g[3] * __uint_as_float(sg.y & 0xffff0000u));
            *(u32x2*)(OG + (size_t)m * DM + col) = o;
        }
    }
}

DI void phase_rowpass(const Frame& F, int which) {
    const float* Mb = (const float*)(F.ws + WS_M); float* X = (float*)(F.ws + WS_X); bf16_t* H = (bf16_t*)(F.ws + WS_H);
    const float* nw = F.in[6];
    const float* wa = nw + (which == 0 ? 1 : which == 1 ? 3 : which == 2 ? 5 : 7) * DM;
    const float* wb = which == 3 ? nullptr : nw + (which == 0 ? 2 : which == 1 ? 4 : 6) * DM;
    const int lane = F.lane; const int gw = F.bid * NWAVES + F.wave, NGW = F.G * NWAVES;
    for (int m = gw; m < T; m += NGW) {
        const float* xin = which == 0 ? xrow_ptr(F, m) : X + (size_t)m * DM;
        float* xout = which == 3 ? F.out + O_Y + (size_t)m * DM : X + (size_t)m * DM;
        const float* mr = Mb + (size_t)m * DM;
        f32x4 v[8]; float s = 0.f;
#pragma unroll
        for (int j = 0; j < 8; ++j) { v[j] = *(const f32x4*)(mr + 4 * lane + 256 * j); s += (v[j][0] * v[j][0] + v[j][1] * v[j][1]) + (v[j][2] * v[j][2] + v[j][3] * v[j][3]); }
        const float r1 = __builtin_amdgcn_rsqf(wave_sum(s) * (1.f / DM) + EPS);
        float s2 = 0.f;
#pragma unroll
        for (int j = 0; j < 8; ++j) { const f32x4 ww = *(const f32x4*)(wa + 4 * lane + 256 * j); const f32x4 xi = *(const f32x4*)(xin + 4 * lane + 256 * j);
            v[j] = xi + v[j] * r1 * ww; *(f32x4*)(xout + 4 * lane + 256 * j) = v[j];
            s2 += (v[j][0] * v[j][0] + v[j][1] * v[j][1]) + (v[j][2] * v[j][2] + v[j][3] * v[j][3]); }
        if (wb) {
            const float r2 = __builtin_amdgcn_rsqf(wave_sum(s2) * (1.f / DM) + EPS);
#pragma unroll
            for (int j = 0; j < 8; ++j) { const f32x4 ww = *(const f32x4*)(wb + 4 * lane + 256 * j); u32x2 o; o.x = pk2(v[j][0] * r2 * ww[0], v[j][1] * r2 * ww[1]); o.y = pk2(v[j][2] * r2 * ww[2], v[j][3] * r2 * ww[3]);
                *(u32x2*)(H + (size_t)m * DM + 4 * lane + 256 * j) = o; }
        }
    }
}

DI void phase_conv(const Frame& F, int layer) {
    const bf16_t* U = (const bf16_t*)(F.ws + WS_U); bf16_t* ACT = (bf16_t*)(F.ws + WS_ACT);
    const float* cw = F.in[18] + (size_t)layer * 3 * FF2; const float* cb = F.in[19] + (size_t)layer * FF2; const float* sc = F.in[5] + (size_t)layer * DB * 2 * FF2;
    const int gt = F.bid * NTHREADS + F.tid, NGT = F.G * NTHREADS;
    constexpr int NCG = FF / 8, NITEM = (T / 32) * NCG;
    for (int it = gt; it < NITEM; it += NGT) {
        const int rc = it / NCG, cgp = it % NCG, j0 = cgp * 8, r0 = rc * 32;
        float wg[3][8], wu[3][8], bg[8], bu[8];
#pragma unroll
        for (int k = 0; k < 3; ++k) { const f32x4 a = *(const f32x4*)(cw + k * FF2 + j0), b = *(const f32x4*)(cw + k * FF2 + j0 + 4), c = *(const f32x4*)(cw + k * FF2 + FF + j0), d = *(const f32x4*)(cw + k * FF2 + FF + j0 + 4);
            for (int i = 0; i < 4; ++i) { wg[k][i] = a[i]; wg[k][4 + i] = b[i]; wu[k][i] = c[i]; wu[k][4 + i] = d[i]; } }
        { const f32x4 a = *(const f32x4*)(cb + j0), b = *(const f32x4*)(cb + j0 + 4), c = *(const f32x4*)(cb + FF + j0), d = *(const f32x4*)(cb + FF + j0 + 4);
          for (int i = 0; i < 4; ++i) { bg[i] = a[i]; bg[4 + i] = b[i]; bu[i] = c[i]; bu[4 + i] = d[i]; } }
        float g2[8], g1[8], u2[8], u1[8];
        const bool seq_start = r0 < TP ? ((r0 & (SEQ - 1)) == 0) : true;
        if (!seq_start) {
#pragma unroll
            for (int k = 0; k < 2; ++k) { const u32x4 a = *(const u32x4*)(U + (size_t)(r0 - 2 + k) * FF2 + j0), b = *(const u32x4*)(U + (size_t)(r0 - 2 + k) * FF2 + FF + j0);
                float* gd = k == 0 ? g2 : g1; float* ud = k == 0 ? u2 : u1;
                for (int i = 0; i < 4; ++i) { gd[2 * i] = __uint_as_float(a[i] << 16); gd[2 * i + 1] = __uint_as_float(a[i] & 0xffff0000u); ud[2 * i] = __uint_as_float(b[i] << 16); ud[2 * i + 1] = __uint_as_float(b[i] & 0xffff0000u); } }
        } else if (r0 < TP) {
            for (int i = 0; i < 8; ++i) { g2[i] = 0.f; g1[i] = 0.f; u2[i] = 0.f; u1[i] = 0.f; }
        } else {
            const int b = (r0 - TP) >> 5; const float* sp = sc + (size_t)b * 2 * FF2;
#pragma unroll
            for (int k = 0; k < 2; ++k) { const f32x4 a = *(const f32x4*)(sp + k * FF2 + j0), b2 = *(const f32x4*)(sp + k * FF2 + j0 + 4), c = *(const f32x4*)(sp + k * FF2 + FF + j0), d = *(const f32x4*)(sp + k * FF2 + FF + j0 + 4);
                float* gd = k == 0 ? g2 : g1; float* ud = k == 0 ? u2 : u1;
                for (int i = 0; i < 4; ++i) { gd[i] = a[i]; gd[4 + i] = b2[i]; ud[i] = c[i]; ud[4 + i] = d[i]; } }
        }
        for (int t = 0; t < 32; ++t) {
            const u32x4 a = *(const u32x4*)(U + (size_t)(r0 + t) * FF2 + j0), b = *(const u32x4*)(U + (size_t)(r0 + t) * FF2 + FF + j0);
            float g0[8], u0[8], o[8];
#pragma unroll
            for (int i = 0; i < 4; ++i) { g0[2 * i] = __uint_as_float(a[i] << 16); g0[2 * i + 1] = __uint_as_float(a[i] & 0xffff0000u); u0[2 * i] = __uint_as_float(b[i] << 16); u0[2 * i + 1] = __uint_as_float(b[i] & 0xffff0000u); }
#pragma unroll
            for (int i = 0; i < 8; ++i) { const float cgv = bg[i] + wg[0][i] * g2[i] + wg[1][i] * g1[i] + wg[2][i] * g0[i]; const float cuv = bu[i] + wu[0][i] * u2[i] + wu[1][i] * u1[i] + wu[2][i] * u0[i];
                o[i] = siluf_(cgv) * cuv; g2[i] = g1[i]; g1[i] = g0[i]; u2[i] = u1[i]; u1[i] = u0[i]; }
            u32x4 w; w.x = pk2(o[0], o[1]); w.y = pk2(o[2], o[3]); w.z = pk2(o[4], o[5]); w.w = pk2(o[6], o[7]);
            *(u32x4*)(ACT + (size_t)(r0 + t) * FF + j0) = w;
        }
    }
}

DI int kv_row_of(int row) { if (row < TP) return row; const int r = row - TP; return TP + (r >> 5) * KVSEQ + PAST + (r & 31); }
DI void phase_mlarow(const Frame& F) {
    const float* DOWN = (const float*)(F.ws + WS_DOWN); bf16_t* CQ = (bf16_t*)(F.ws + WS_CQ); bf16_t* CKVA = (bf16_t*)(F.ws + WS_CKVA); bf16_t* KPEA = (bf16_t*)(F.ws + WS_KPEA);
    const float* tab = (const float*)(F.ws + WS_TAB); const float* qw = F.in[12]; const float* kw = F.in[13];
    const int lane = F.lane; const int gw = F.bid * NWAVES + F.wave, NGW = F.G * NWAVES;
    for (int m = gw; m < T; m += NGW) {
        const float* dr = DOWN + (size_t)m * NDOWNP; const int kvr = kv_row_of(m);
        f32x4 a[2], b[2]; float sa = 0.f, sb = 0.f;
#pragma unroll
        for (int j = 0; j < 2; ++j) { a[j] = *(const f32x4*)(dr + 4 * lane + 256 * j); b[j] = *(const f32x4*)(dr + 512 + 4 * lane + 256 * j);
            sa += (a[j][0] * a[j][0] + a[j][1] * a[j][1]) + (a[j][2] * a[j][2] + a[j][3] * a[j][3]); sb += (b[j][0] * b[j][0] + b[j][1] * b[j][1]) + (b[j][2] * b[j][2] + b[j][3] * b[j][3]); }
        const float ra = __builtin_amdgcn_rsqf(wave_sum(sa) * (1.f / QL) + EPS), rb = __builtin_amdgcn_rsqf(wave_sum(sb) * (1.f / KVL) + EPS);
#pragma unroll
        for (int j = 0; j < 2; ++j) { const int c = 4 * lane + 256 * j; const f32x4 w1 = *(const f32x4*)(qw + c), w2 = *(const f32x4*)(kw + c);
            const f32x4 q = a[j] * ra * w1, kv = b[j] * rb * w2;
            u32x2 o; o.x = pk2(q[0], q[1]); o.y = pk2(q[2], q[3]); *(u32x2*)(CQ + (size_t)m * QL + c) = o;
            *(f32x4*)(F.out + O_CKV + (size_t)m * KVL + c) = kv;
            u32x2 o2; o2.x = pk2(kv[0], kv[1]); o2.y = pk2(kv[2], kv[3]); *(u32x2*)(CKVA + (size_t)kvr * KVL + c) = o2; }
        if (lane < 32) { const int pos = m < TP ? (m & (SEQ - 1)) : PAST + ((m - TP) & (DS - 1)); const float x1 = dr[1024 + lane], x2 = dr[1024 + 32 + lane];
            const f32x2 cs = *(const f32x2*)(tab + ((size_t)pos * 32 + lane) * 2); const float o1 = x1 * cs[0] - x2 * cs[1], o2 = x2 * cs[0] + x1 * cs[1];
            F.out[O_KPE + (size_t)m * ROPE + lane] = o1; F.out[O_KPE + (size_t)m * ROPE + 32 + lane] = o2;
            *(unsigned*)(KPEA + (size_t)kvr * ROPE + 2 * lane) = pk2(o1, o2); }
    }
    const float* cckv = F.in[3]; const float* ckpe = F.in[4];
    for (int i = gw; i < DB * PAST; i += NGW) { const int b = i >> 10, p = i & (PAST - 1); const int kvr = TP + b * KVSEQ + p;
#pragma unroll
        for (int j = 0; j < 2; ++j) { const int c = 4 * lane + 256 * j; const f32x4 v = *(const f32x4*)(cckv + (size_t)i * KVL + c); u32x2 o; o.x = pk2(v[0], v[1]); o.y = pk2(v[2], v[3]); *(u32x2*)(CKVA + (size_t)kvr * KVL + c) = o; }
        if (lane < 32) { const float x1 = ckpe[(size_t)i * ROPE + lane], x2 = ckpe[(size_t)i * ROPE + 32 + lane]; *(unsigned*)(KPEA + (size_t)kvr * ROPE + 2 * lane) = pk2(x1, x2); }
    }
}

#define MFMA32(a, b, c) __builtin_amdgcn_mfma_f32_32x32x16_bf16((a), (b), (c), 0, 0, 0)
DI void attn_unit(const Frame& F, int qrow0, int kvbase, int nkeys, int h) {
    const bf16_t* QA = (const bf16_t*)(F.ws + WS_QA); const bf16_t* KN = (const bf16_t*)(F.ws + WS_KN); const bf16_t* KPEA = (const bf16_t*)(F.ws + WS_KPEA); const bf16_t* VT = (const bf16_t*)(F.ws + WS_VT);
    bf16_t* AO = (bf16_t*)(F.ws + WS_AO);
    const int lane = F.lane, r = lane & 31, hf = lane >> 5;
    bf16x8 qf[12];
    { const bf16_t* qp = QA + (size_t)(qrow0 + r) * 3072 + h * QHD + 8 * hf;
#pragma unroll
      for (int s = 0; s < 12; ++s) qf[s] = *(const bf16x8*)(qp + 16 * s); }
    f32x16 ot[4];
#pragma unroll
    for (int d = 0; d < 4; ++d)
#pragma unroll
        for (int i = 0; i < 16; ++i) ot[d][i] = 0.f;
    float mrun = -INFINITY, lrun = 0.f;
    for (int key0 = 0; key0 < nkeys; key0 += 32) {
        const bf16_t* kp = KN + (size_t)(kvbase + key0 + r) * 2048 + h * NOPE + 8 * hf;
        const bf16_t* pp = KPEA + (size_t)(kvbase + key0 + r) * ROPE + 8 * hf;
        f32x16 sc;
#pragma unroll
        for (int i = 0; i < 16; ++i) sc[i] = 0.f;
#pragma unroll
        for (int s = 0; s < 8; ++s) sc = MFMA32(*(const bf16x8*)(kp + 16 * s), qf[s], sc);
#pragma unroll
        for (int s = 0; s < 4; ++s) sc = MFMA32(*(const bf16x8*)(pp + 16 * s), qf[8 + s], sc);
        float mx = sc[0];
#pragma unroll
        for (int i = 1; i < 16; ++i) mx = fmaxf(mx, sc[i]);
        mx = fmaxf(mx, __shfl_xor(mx, 32));
        const float mnew = fmaxf(mrun, mx), alpha = __builtin_amdgcn_exp2f(mrun - mnew);
        float ps = 0.f;
#pragma unroll
        for (int i = 0; i < 16; ++i) { sc[i] = __builtin_amdgcn_exp2f(sc[i] - mnew); ps += sc[i]; }
        lrun = lrun * alpha + ps; mrun = mnew;
#pragma unroll
        for (int d = 0; d < 4; ++d)
#pragma unroll
            for (int i = 0; i < 16; ++i) ot[d][i] *= alpha;
        bf16x8 pf[2];
#pragma unroll
        for (int ks = 0; ks < 2; ++ks) { u32x4 w; w.x = pk2(sc[8 * ks], sc[8 * ks + 1]); w.y = pk2(sc[8 * ks + 2], sc[8 * ks + 3]); w.z = pk2(sc[8 * ks + 4], sc[8 * ks + 5]); w.w = pk2(sc[8 * ks + 6], sc[8 * ks + 7]); pf[ks] = __builtin_bit_cast(bf16x8, w); }
#pragma unroll
        for (int d = 0; d < 4; ++d) {
            const bf16_t* vp = VT + (size_t)(h * VD + d * 32 + r) * KVROWS + kvbase + key0 + 4 * hf;
#pragma unroll
            for (int ks = 0; ks < 2; ++ks) { const u32x2 lo = *(const u32x2*)(vp + 16 * ks), hi = *(const u32x2*)(vp + 16 * ks + 8); const u32x4 w = {lo.x, lo.y, hi.x, hi.y};
                ot[d] = MFMA32(__builtin_bit_cast(bf16x8, w), pf[ks], ot[d]); }
        }
    }
    const float inv = __builtin_amdgcn_rcpf(lrun + __shfl_xor(lrun, 32));
    bf16_t* op = AO + (size_t)(qrow0 + r) * DM + h * VD + 4 * hf;
#pragma unroll
    for (int d = 0; d < 4; ++d)
#pragma unroll
        for (int g = 0; g < 4; ++g) { u32x2 o; o.x = pk2(ot[d][4 * g] * inv, ot[d][4 * g + 1] * inv); o.y = pk2(ot[d][4 * g + 2] * inv, ot[d][4 * g + 3] * inv); *(u32x2*)(op + d * 32 + 8 * g) = o; }
}
DI void phase_attn(const Frame& F) {
    const int NGW = F.G * NWAVES;
    for (int p = F.bid * NWAVES + F.wave; p < NB * HH * 32; p += NGW) {
        const int sh = p >> 5, j = p & 31, s = sh >> 4, h = sh & 15;
#pragma unroll 1
        for (int k = 0; k < 2; ++k) { const int qb = k == 0 ? j : 63 - j; attn_unit(F, s * SEQ + 32 * qb, s * SEQ, 64 * ((qb >> 1) + 1), h); }
    }
    for (int wv = F.bid * NWAVES + F.wave; wv < 2048; wv += NGW) if ((wv & 15) == 7) { const int u = wv >> 4, b = u >> 4, h = u & 15; attn_unit(F, TP + b * DS, TP + b * KVSEQ, KVSEQ, h); }
}

DI void run_gemm(const Frame& F, int gi) {
    unsigned char* ws = F.ws; pg8::Gemm g; EpiAll E{};
    const bf16_t* H = (const bf16_t*)(ws + WS_H);
    switch (gi) {
    case 0: g = {H, (const bf16_t*)(ws + WS_WT_HIN), T, 8192, 2048}; E.kind = EK_HGRN; E.Qb = (bf16_t*)(ws + WS_QB); E.FGp = (float*)(ws + WS_FG); E.Vb = (bf16_t*)(ws + WS_VB); E.SGp = (bf16_t*)(ws + WS_SG); E.lb = (const float*)(ws + WS_LB); break;
    case 1: g = {(const bf16_t*)(ws + WS_OG), (const bf16_t*)(ws + WS_WT_HOUT), T, 2048, 2048}; E.kind = EK_F32; E.C = ws + WS_M; E.ldc = DM; break;
    case 2: g = {H, (const bf16_t*)(ws + WS_WT_FIN), T, FF2, 2048}; E.kind = EK_FFN; E.C = ws + WS_U; E.convP = F.out + O_CONVP; E.convS = F.out + O_CONVS; break;
    case 3: g = {(const bf16_t*)(ws + WS_ACT), (const bf16_t*)(ws + WS_WT_FOUT), T, 2048, FF}; E.kind = EK_F32; E.C = ws + WS_M; E.ldc = DM; break;
    case 4: g = {H, (const bf16_t*)(ws + WS_WT_DOWN), T, NDOWNP, 2048}; E.kind = EK_F32; E.C = ws + WS_DOWN; E.ldc = NDOWNP; break;
    case 5: g = {(const bf16_t*)(ws + WS_CQ), (const bf16_t*)(ws + WS_WT_UQ), T, 3072, 512}; E.kind = EK_Q; E.C = ws + WS_QA; E.tab = (const float*)(ws + WS_TAB); E.qscale = 0.07216878364870322f * 1.4426950408889634f; break;
    case 6: g = {(const bf16_t*)(ws + WS_CKVA), (const bf16_t*)(ws + WS_WT_K), KVROWS, 2048, 512}; E.kind = EK_BF16; E.C = ws + WS_KN; E.ldc = 2048; break;
    case 7: g = {(const bf16_t*)(ws + WS_WT_V), (const bf16_t*)(ws + WS_CKVA), 2048, KVROWS, 512}; E.kind = EK_BF16; E.C = ws + WS_VT; E.ldc = KVROWS; break;
    case 8: g = {(const bf16_t*)(ws + WS_AO), (const bf16_t*)(ws + WS_WT_MOUT), T, 2048, 2048}; E.kind = EK_F32; E.C = ws + WS_M; E.ldc = DM; break;
    case 9: g = {H, (const bf16_t*)(ws + WS_WT_FIN) + (size_t)FF2 * 2048, T, FF2, 2048}; E.kind = EK_FFN; E.C = ws + WS_U; E.convP = F.out + O_CONVP + (size_t)NB * 2 * FF2; E.convS = F.out + O_CONVS + (size_t)DB * 2 * FF2; break;
    default: g = {(const bf16_t*)(ws + WS_ACT), (const bf16_t*)(ws + WS_WT_FOUT) + (size_t)2048 * FF, T, 2048, FF}; E.kind = EK_F32; E.C = ws + WS_M; E.ldc = DM; break;
    }
    pg8::StaticOrder S; S.init(g.M, g.N, F.G, F.bid);
    pg8::gemm_phase<EpiAll>(F.lds, g, S, E);
}

constexpr int N_PHASES = 20;
template <bool COOP>
__global__ void __launch_bounds__(NTHREADS, 2) mk_fwd(Args args) {
    extern __shared__ __attribute__((aligned(16))) unsigned char lds[];
    Frame F;
    F.lds = (LAS unsigned char*)lds;
    F.tid = threadIdx.x; F.lane = F.tid & 63; F.wave = __builtin_amdgcn_readfirstlane(F.tid >> 6); F.G = gridDim.x; F.bid = blockIdx.x;
    F.in = args.in; F.out = args.out; F.ws = args.ws;
    Frame F0 = F;
    for (int ph = args.ph_lo; ph < args.ph_hi; ++ph) {
        Frame F = F0;
        asm volatile("" : "+v"(F.tid), "+v"(F.lane));
        asm volatile("" : "+s"(F.wave), "+s"(F.bid), "+s"(F.G));
        int g0 = 0, g1 = 0;
        switch (ph) {
        case 1: g0 = 0; g1 = 1; break;
        case 4: g0 = 1; g1 = 2; break;
        case 6: g0 = 2; g1 = 3; break;
        case 8: g0 = 3; g1 = 4; break;
        case 10: g0 = 4; g1 = 5; break;
        case 12: g0 = 5; g1 = 8; break;
        case 14: g0 = 8; g1 = 9; break;
        case 16: g0 = 9; g1 = 10; break;
        case 18: g0 = 10; g1 = 11; break;
        default: break;
        }
        if (g1 > g0) {
#pragma unroll 1
            for (int gi = g0; gi < g1; ++gi) run_gemm(F, gi);
        } else {
#ifndef PHM
#define PHM 0xFFFFF
#endif
            switch (ph) {
            case 0: if (PHM & (1 << 0)) phase_prep(F); break;
            case 2: if (PHM & (1 << 2)) phase_scan(F); break;
            case 3: if (PHM & (1 << 3)) phase_gate(F); break;
            case 5: if (PHM & (1 << 5)) phase_rowpass(F, 0); break;
            case 7: if (PHM & (1 << 7)) phase_conv(F, 0); break;
            case 9: if (PHM & (1 << 9)) phase_rowpass(F, 1); break;
            case 11: if (PHM & (1 << 11)) phase_mlarow(F); break;
            case 13: if (PHM & (1 << 13)) phase_attn(F); break;
            case 15: if (PHM & (1 << 15)) phase_rowpass(F, 2); break;
            case 17: if (PHM & (1 << 17)) phase_conv(F, 1); break;
            default: if (PHM & (1 << 19)) phase_rowpass(F, 3); break;
            }
        }
        if (COOP) { if (ph + 1 < args.ph_hi) cg::this_grid().sync(); }
    }
}

extern "C" void kernel_launch(void* const* d_in, const int* in_sizes, int n_in, void* d_out, int out_size, void* d_ws, size_t ws_size, hipStream_t stream) {
    static int grid = 0;
    if (grid == 0) {
        if (n_in != 21 || (size_t)out_size != O_END || ws_size < WS_END) { fprintf(stderr, "kernel_launch: unexpected sizes n_in %d out %d (want %zu) ws %zu (need %zu)\n", n_in, out_size, (size_t)O_END, ws_size, (size_t)WS_END); grid = -1; return; }
        int dev = 0, cus = 0, per_cu = 0;
        hipGetDevice(&dev); hipDeviceGetAttribute(&cus, hipDeviceAttributeMultiprocessorCount, dev);
        hipFuncSetAttribute((const void*)mk_fwd<true>, hipFuncAttributeMaxDynamicSharedMemorySize, LDS_BYTES);
        hipFuncSetAttribute((const void*)mk_fwd<false>, hipFuncAttributeMaxDynamicSharedMemorySize, LDS_BYTES);
        hipOccupancyMaxActiveBlocksPerMultiprocessor(&per_cu, (const void*)mk_fwd<true>, NTHREADS, LDS_BYTES);
        if (per_cu < 1) { fprintf(stderr, "kernel_launch: occupancy query reports %d blocks per CU\n", per_cu); per_cu = 1; }
        (void)hipGetLastError();
        grid = cus;
    }
    if (grid < 0) return;
    Args a{};
    for (int i = 0; i < 21; ++i) a.in[i] = (const float*)d_in[i];
    a.out = (float*)d_out; a.ws = (unsigned char*)d_ws;
#if MK_ONE_LAUNCH
    a.ph_lo = 0; a.ph_hi = N_PHASES;
    void* kargs[] = {&a};
    hipError_t e = hipLaunchCooperativeKernel((const void*)mk_fwd<true>, dim3(grid), dim3(NTHREADS), kargs, LDS_BYTES, stream);
    if (e != hipSuccess) fprintf(stderr, "cooperative launch failed: %s (grid %d)\n", hipGetErrorString(e), grid);
#else
    for (int ph = 0; ph < N_PHASES; ++ph) {
        a.ph_lo = ph; a.ph_hi = ph + 1;
        hipLaunchKernelGGL(mk_fwd<false>, dim3(grid), dim3(NTHREADS), LDS_BYTES, stream, a);
    }
#endif
}
```

```cpp
#include <hip/hip_runtime.h>
#include <hip/hip_cooperative_groups.h>
#include <cstdio>
#include <cstdint>
namespace cg = cooperative_groups;

#ifndef MK_ONE_LAUNCH
#define MK_ONE_LAUNCH 1
#endif

#define LAS __attribute__((address_space(3)))
#define DI __device__ __forceinline__
typedef unsigned short bf16_t;
typedef short bf16x8 __attribute__((ext_vector_type(8)));
typedef float f32x4 __attribute__((ext_vector_type(4)));
typedef float f32x2 __attribute__((ext_vector_type(2)));
typedef float f32x16 __attribute__((ext_vector_type(16)));
typedef unsigned u32x4 __attribute__((ext_vector_type(4)));
typedef unsigned u32x2 __attribute__((ext_vector_type(2)));
typedef __bf16 bf16x2_t __attribute__((ext_vector_type(2)));

constexpr int DM = 2048, NB = 4, SEQ = 2048, DB = 8, DS = 32, PAST = 1024;
constexpr int TP = NB * SEQ, TS = DB * DS, T = TP + TS;
constexpr int HH = 16, DK = 128, DV = 128;
constexpr int QL = 512, KVL = 512, NOPE = 128, ROPE = 64, VD = 128, QHD = NOPE + ROPE;
constexpr int NDOWN = QL + KVL + ROPE, NDOWNP = 1280;
constexpr int FF = 5632, FF2 = 2 * FF;
constexpr int KVSEQ = PAST + DS;
constexpr int KVROWS = TP + DB * KVSEQ;
constexpr float EPS = 1e-6f;
constexpr int NTHREADS = 512, NWAVES = 8;

constexpr size_t O_Y = 0;
constexpr size_t O_HG = (size_t)T * DM;
constexpr size_t O_CKV = O_HG + (size_t)12 * HH * DK * DV;
constexpr size_t O_KPE = O_CKV + (size_t)T * KVL;
constexpr size_t O_CONVP = O_KPE + (size_t)T * ROPE;
constexpr size_t O_CONVS = O_CONVP + (size_t)2 * NB * 2 * FF2;
constexpr size_t O_END = O_CONVS + (size_t)2 * DB * 2 * FF2;

constexpr size_t al256(size_t x) { return (x + 255) & ~(size_t)255; }
constexpr size_t WS_WT_HIN = 0;
constexpr size_t WS_WT_HOUT = WS_WT_HIN + (size_t)8192 * 2048 * 2;
constexpr size_t WS_WT_DOWN = WS_WT_HOUT + (size_t)2048 * 2048 * 2;
constexpr size_t WS_WT_UQ = WS_WT_DOWN + (size_t)NDOWNP * 2048 * 2;
constexpr size_t WS_WT_K = WS_WT_UQ + (size_t)3072 * 512 * 2;
constexpr size_t WS_WT_V = WS_WT_K + (size_t)2048 * 512 * 2;
constexpr size_t WS_WT_MOUT = WS_WT_V + (size_t)2048 * 512 * 2;
constexpr size_t WS_WT_FIN = WS_WT_MOUT + (size_t)2048 * 2048 * 2;
constexpr size_t WS_WT_FOUT = WS_WT_FIN + (size_t)2 * FF2 * 2048 * 2;
constexpr size_t WS_TAB = WS_WT_FOUT + (size_t)2 * 2048 * FF * 2;
constexpr size_t WS_LB = WS_TAB + (size_t)2048 * 32 * 2 * 4;
constexpr size_t WS_X = WS_LB + 2048 * 4;
constexpr size_t WS_H = WS_X + (size_t)T * DM * 4;
constexpr size_t WS_M = WS_H + (size_t)T * DM * 2;
constexpr size_t WS_R = WS_M + (size_t)T * DM * 4;
constexpr size_t WS_QB = WS_R;
constexpr size_t WS_FG = WS_QB + (size_t)T * DM * 2;
constexpr size_t WS_VB = WS_FG + (size_t)T * DM * 4;
constexpr size_t WS_SG = WS_VB + (size_t)T * DM * 2;
constexpr size_t WS_O32 = WS_SG + (size_t)T * DM * 2;
constexpr size_t WS_OG = WS_O32 + (size_t)T * DM * 4;
constexpr size_t WS_RA_END = WS_OG + (size_t)T * DM * 2;
constexpr size_t WS_U = WS_R;
constexpr size_t WS_ACT = WS_U + (size_t)T * FF2 * 2;
constexpr size_t WS_RB_END = WS_ACT + (size_t)T * FF * 2;
constexpr size_t WS_DOWN = WS_R;
constexpr size_t WS_CQ = WS_DOWN + (size_t)T * NDOWNP * 4;
constexpr size_t WS_CKVA = WS_CQ + (size_t)T * QL * 2;
constexpr size_t WS_KPEA = WS_CKVA + (size_t)KVROWS * KVL * 2;
constexpr size_t WS_QA = WS_KPEA + (size_t)KVROWS * ROPE * 2;
constexpr size_t WS_KN = WS_QA + (size_t)T * 3072 * 2;
constexpr size_t WS_VT = WS_KN + (size_t)KVROWS * 2048 * 2;
constexpr size_t WS_AO = WS_VT + (size_t)2048 * KVROWS * 2;
constexpr size_t WS_RC_END = WS_AO + (size_t)T * DM * 2;
constexpr size_t cmax(size_t a, size_t b) { return a > b ? a : b; }
constexpr size_t WS_SLAB = cmax(WS_RA_END, cmax(WS_RB_END, WS_RC_END));
constexpr size_t WS_CTL = WS_SLAB + (size_t)22 * TS * DM * 4;
constexpr size_t CTL_BYTES = 16384;
constexpr size_t WS_END = WS_CTL + CTL_BYTES;

constexpr int KS_2048 = 8, KS_5632 = 22;
constexpr int LDS_BYTES = 147456;

DI float bf2f(unsigned short b) { return __uint_as_float((unsigned)b << 16); }
DI unsigned pk2(float lo, float hi) { f32x2 v = {lo, hi}; bf16x2_t b = __builtin_convertvector(v, bf16x2_t); return __builtin_bit_cast(unsigned, b); }
DI float fexp(float x) { return __builtin_amdgcn_exp2f(x * 1.4426950408889634f); }
DI float sigmoidf_(float x) { return __builtin_amdgcn_rcpf(1.f + fexp(-x)); }
DI float siluf_(float x) { return x * sigmoidf_(x); }
DI float wave_sum(float v) {
#pragma unroll
    for (int o = 1; o < 64; o <<= 1) v += __shfl_xor(v, o);
    return v;
}

namespace pg8 {
constexpr int BM = 256, BK = 64, HALF = 128, HTB = HALF * BK * 2, STAGE_BYTES = 8 * HTB, NXCD = 8, WGM = 8;
__host__ __device__ __forceinline__ int lds_byte(int r, int c) { const int st = (r >> 4) * 2 + (c >> 5), rr = r & 15, cc = c & 31, ob = rr * 64 + cc * 2; return st * 1024 + (ob ^ (((ob >> 9) & 1) << 5)); }
__host__ __device__ __forceinline__ void stage_rc(int b, int& R, int& C) { const int st = b / 1024, sb = b % 1024, swz = sb ^ (((sb >> 9) & 1) << 5); R = (st >> 1) * 16 + swz / 64; C = (st & 1) * 32 + (swz % 64) / 2; }

struct Unit { const char* A; const char* B; int pm, pn, nt, di, aux; };

struct Group { const bf16_t* A; const bf16_t* Bt; int pm0, nM, nN, ks, ntk, di; };
struct PhaseSched {
    Group g[3]; int ng, K, G, c;
    __device__ __forceinline__ bool decode(const Group& gr, int L, Unit& u) const {
        int pml, pn, sl = 0;
        if (gr.ks == 1) {
            const int nwg = gr.nM * gr.nN; int wgid = L;
            { const int q = nwg / NXCD, r = nwg % NXCD, xcd = wgid % NXCD, off = wgid / NXCD; wgid = (xcd < r ? xcd * (q + 1) : r * (q + 1) + (xcd - r) * q) + off; }
            const int nig = WGM * gr.nN, gid = wgid / nig, fm = gid * WGM, gsz = (gr.nM - fm) < WGM ? (gr.nM - fm) : WGM;
            pml = fm + ((wgid % nig) % gsz); pn = (wgid % nig) / gsz;
        } else { sl = L % gr.ks; const int tile = L / gr.ks; pn = tile % gr.nN; pml = tile / gr.nN; }
        u.pm = gr.pm0 + pml; u.pn = pn; u.nt = gr.ntk; u.di = gr.di; u.aux = sl;
        u.A = (const char*)gr.A + ((size_t)u.pm * BM * K + (size_t)sl * gr.ntk * BK) * 2;
        u.B = (const char*)gr.Bt + ((size_t)pn * BM * K + (size_t)sl * gr.ntk * BK) * 2;
        return true;
    }
    __device__ __forceinline__ bool next(int i, Unit& u) const {
        int L = i * G + c;
#pragma unroll
        for (int k = 0; k < 3; ++k) if (k < ng) { const int cnt = g[k].nM * g[k].nN * g[k].ks; if (L < cnt) return decode(g[k], L, u); L -= cnt; }
        return false;
    }
};

template <class Epi>
__device__ __forceinline__ void gemm_phase(LAS unsigned char* lds, const PhaseSched& S, const Epi& E) {
    const int tid = threadIdx.x, wid = __builtin_amdgcn_readfirstlane(tid >> 6), lane = tid & 63, wr = wid >> 2, wc = wid & 3, fr = lane & 15, fq = lane >> 4;
    const int K = S.K;
    unsigned voffA[2], voffB[2];
#pragma unroll
    for (int i = 0; i < 2; ++i) { int R, C; stage_rc(tid * 16 + i * 8192, R, C);
        voffA[i] = (unsigned)(R * K + C) * 2u; voffB[i] = (unsigned)(R * K + C) * 2u; }
    const size_t kstep = (size_t)(BK * 2);
    const size_t hstep = (size_t)HALF * K * 2;
    const unsigned ldsw = (unsigned)wid * 1024u;
    const int aoff = lds_byte(wr * 64 + fr, fq * 8), boff = lds_byte(wc * 32 + fr, fq * 8);
#define PG8_SA(b, h) (((b) * 2 + (h)) * HTB)
#define PG8_SB(b, h) ((4 + (b) * 2 + (h)) * HTB)
#define PG8_STAGE(bufoff, gbase, voff) do { _Pragma("unroll") for (int _i = 0; _i < 2; ++_i) \
        __builtin_amdgcn_global_load_lds((const unsigned*)((const char*)(gbase) + (voff)[_i]), (LAS unsigned*)(lds + (bufoff) + ldsw + _i * 8192), 16, 0, 0); } while (0)
#define PG8_LDA(dst, b, h) do { _Pragma("unroll") for (int m = 0; m < 4; ++m) _Pragma("unroll") for (int k = 0; k < 2; ++k) dst[m][k] = *(const LAS bf16x8*)(lds + PG8_SA(b, h) + aoff + m * 2048 + k * 1024); } while (0)
#define PG8_LDB(dst, b, h) do { _Pragma("unroll") for (int n = 0; n < 2; ++n) _Pragma("unroll") for (int k = 0; k < 2; ++k) dst[n][k] = *(const LAS bf16x8*)(lds + PG8_SB(b, h) + boff + n * 2048 + k * 1024); } while (0)
#define PG8_MMA(ai, bj, At, Bt) do { __builtin_amdgcn_s_setprio(1); _Pragma("unroll") for (int m = 0; m < 4; ++m) _Pragma("unroll") for (int n = 0; n < 2; ++n) _Pragma("unroll") for (int k = 0; k < 2; ++k) \
        acc[ai][bj][m][n] = __builtin_amdgcn_mfma_f32_16x16x32_bf16(Bt[n][k], At[m][k], acc[ai][bj][m][n], 0, 0, 0); __builtin_amdgcn_s_setprio(0); } while (0)
#define PG8_WAIT_V(n) asm volatile("s_waitcnt vmcnt(" #n ")" ::: "memory")
#define PG8_WAIT_L(n) asm volatile("s_waitcnt lgkmcnt(" #n ")" ::: "memory")
#define PG8_BAR __builtin_amdgcn_s_barrier()
#define PG8_SCHED __builtin_amdgcn_sched_barrier(0)
    Unit cur, nxt; int ui = 0;
    if (!S.next(0, cur)) return;
    f32x4 acc[2][2][4][2];
#pragma unroll
    for (int a = 0; a < 2; ++a)
#pragma unroll
        for (int b = 0; b < 2; ++b)
#pragma unroll
            for (int m = 0; m < 4; ++m)
#pragma unroll
                for (int n = 0; n < 2; ++n) acc[a][b][m][n] = (f32x4){0.f, 0.f, 0.f, 0.f};
    bf16x8 At[4][2], B0[2][2], B1[2][2];
    const char* cA = cur.A; const char* cB = cur.B;
    PG8_STAGE(PG8_SB(0, 0), cB, voffB); PG8_STAGE(PG8_SB(0, 1), cB + hstep, voffB); PG8_STAGE(PG8_SA(0, 0), cA, voffA); PG8_STAGE(PG8_SA(0, 1), cA + hstep, voffA);
    if (wr == 1) PG8_BAR;
    PG8_WAIT_V(2); PG8_BAR;
    PG8_STAGE(PG8_SB(1, 0), cB + kstep, voffB); PG8_STAGE(PG8_SA(1, 0), cA + kstep, voffA); PG8_STAGE(PG8_SB(1, 1), cB + hstep + kstep, voffB);
    PG8_WAIT_V(6); PG8_BAR;
    for (;;) {
        const bool has_next = S.next(ui + 1, nxt);
        const char* nA = has_next ? nxt.A : cA; const char* nB = has_next ? nxt.B : cB;
        const int nt = cur.nt;
        for (int t = 0; t < nt; t += 2) {
            const bool last = (t == nt - 2);
            const char* a1 = cA + (size_t)(t + 1) * kstep;
            const char* a2 = last ? nA : cA + (size_t)(t + 2) * kstep; const char* b2 = last ? nB : cB + (size_t)(t + 2) * kstep;
            const char* a3 = a2 + kstep; const char* b3 = b2 + kstep;
            PG8_LDB(B0, 0, 0); PG8_LDB(B1, 0, 1); PG8_SCHED; PG8_LDA(At, 0, 0); PG8_STAGE(PG8_SA(1, 1), a1 + hstep, voffA);
            PG8_WAIT_V(8); PG8_WAIT_L(0); PG8_BAR; PG8_MMA(0, 0, At, B0); PG8_MMA(0, 1, At, B1); PG8_BAR; PG8_SCHED;
            PG8_LDA(At, 0, 1); PG8_STAGE(PG8_SB(0, 0), b2, voffB); PG8_STAGE(PG8_SB(0, 1), b2 + hstep, voffB); PG8_STAGE(PG8_SA(0, 0), a2, voffA);
            PG8_WAIT_V(8); PG8_WAIT_L(0); PG8_BAR; PG8_MMA(1, 0, At, B0); PG8_MMA(1, 1, At, B1); PG8_BAR; PG8_SCHED;
            PG8_LDB(B0, 1, 0); PG8_LDB(B1, 1, 1); PG8_SCHED; PG8_LDA(At, 1, 0); PG8_STAGE(PG8_SA(0, 1), a2 + hstep, voffA);
            PG8_WAIT_V(8); PG8_WAIT_L(0); PG8_BAR; PG8_MMA(0, 0, At, B0); PG8_MMA(0, 1, At, B1); PG8_BAR; PG8_SCHED;
            PG8_LDA(At, 1, 1); PG8_STAGE(PG8_SB(1, 0), b3, voffB); PG8_STAGE(PG8_SB(1, 1), b3 + hstep, voffB); PG8_STAGE(PG8_SA(1, 0), a3, voffA);
            PG8_WAIT_V(8); PG8_WAIT_L(0); PG8_BAR; PG8_MMA(1, 0, At, B0); PG8_MMA(1, 1, At, B1); PG8_BAR; PG8_SCHED;
        }
        if (wr == 0) PG8_BAR;
        E(acc, cur, wr, wc, fr, fq);
        if (!has_next) break;
#pragma unroll
        for (int a = 0; a < 2; ++a)
#pragma unroll
            for (int b = 0; b < 2; ++b)
#pragma unroll
                for (int m = 0; m < 4; ++m)
#pragma unroll
                    for (int n = 0; n < 2; ++n) acc[a][b][m][n] = (f32x4){0.f, 0.f, 0.f, 0.f};
        cur = nxt; cA = nA; cB = nB; ++ui;
        if (wr == 1) PG8_BAR;
    }
    PG8_WAIT_V(0);
    PG8_BAR;
#undef PG8_SA
#undef PG8_SB
#undef PG8_STAGE
#undef PG8_LDA
#undef PG8_LDB
#undef PG8_MMA
#undef PG8_WAIT_V
#undef PG8_WAIT_L
#undef PG8_BAR
#undef PG8_SCHED
}
}

struct Args { const float* in[21]; float* out; unsigned char* ws; int ph_lo, ph_hi; };

struct Frame {
    LAS unsigned char* lds;
    int tid, lane, wave, G, bid;
    const float* const* in; float* out; unsigned char* ws;
};

enum EpiDesc { D_HGRN = 0, D_M = 1, D_MSLAB = 2, D_FFN0 = 3, D_FFN1 = 4, D_DOWN = 5, D_Q = 6, D_KN = 7, D_VT = 8 };
struct EpiAll {
    unsigned char* ws; float* out;
    DI void st_bf16(bf16_t* p, f32x4 v) const { u32x2 w; w.x = pk2(v[0], v[1]); w.y = pk2(v[2], v[3]); *(u32x2*)p = w; }
    DI void one(int di, int aux, int row, int col, f32x4 v) const {
        if (di == D_M) { *(f32x4*)((float*)(ws + WS_M) + (size_t)row * DM + col) = v; }
        else if (di == D_MSLAB) { *(f32x4*)((float*)(ws + WS_SLAB) + ((size_t)aux * TS + (row - TP)) * DM + col) = v; }
        else if (di == D_DOWN) { *(f32x4*)((float*)(ws + WS_DOWN) + (size_t)row * NDOWNP + col) = v; }
        else if (di == D_KN) { st_bf16((bf16_t*)(ws + WS_KN) + (size_t)row * 2048 + col, v); }
        else if (di == D_VT) { st_bf16((bf16_t*)(ws + WS_VT) + (size_t)row * KVROWS + col, v); }
        else if (di == D_HGRN) {
            const int sec = col >> 11, c = col & 2047; const size_t off = (size_t)row * DM + c;
            if (sec == 0) { f32x4 o; for (int i = 0; i < 4; ++i) o[i] = siluf_(v[i]); st_bf16((bf16_t*)(ws + WS_QB) + off, o); }
            else if (sec == 1) { const f32x4 l = *(const f32x4*)((const float*)(ws + WS_LB) + c); f32x4 o; for (int i = 0; i < 4; ++i) o[i] = l[i] + (1.f - l[i]) * sigmoidf_(v[i]); *(f32x4*)((float*)(ws + WS_FG) + off) = o; }
            else if (sec == 2) { st_bf16((bf16_t*)(ws + WS_VB) + off, v); }
            else { f32x4 o; for (int i = 0; i < 4; ++i) o[i] = siluf_(v[i]); st_bf16((bf16_t*)(ws + WS_SG) + off, o); }
        }
        else if (di == D_FFN0 || di == D_FFN1) {
            const int layer = di - D_FFN0;
            st_bf16((bf16_t*)(ws + WS_U) + (size_t)row * FF2 + col, v);
            if (row < TP) { const int t = row & (SEQ - 1); if (t >= SEQ - 2) *(f32x4*)(out + O_CONVP + ((size_t)((layer * NB + (row >> 11)) * 2 + (t - (SEQ - 2)))) * FF2 + col) = v; }
            else { const int r = row - TP, t = r & (DS - 1); if (t >= DS - 2) *(f32x4*)(out + O_CONVS + ((size_t)((layer * DB + (r >> 5)) * 2 + (t - (DS - 2)))) * FF2 + col) = v; }
        }
        else {
            const int hc = col % QHD; f32x4 o = v;
            if (hc >= NOPE) {
                const int i0 = (hc - NOPE) >> 1;
                const int pos = row < TP ? (row & (SEQ - 1)) : PAST + ((row - TP) & (DS - 1));
                const f32x4 cs = *(const f32x4*)((const float*)(ws + WS_TAB) + ((size_t)pos * 32 + i0) * 2);
                o[0] = v[0] * cs[0] - v[1] * cs[1]; o[1] = v[1] * cs[0] + v[0] * cs[1];
                o[2] = v[2] * cs[2] - v[3] * cs[3]; o[3] = v[3] * cs[2] + v[2] * cs[3];
            }
            o = o * (0.07216878364870322f * 1.4426950408889634f); st_bf16((bf16_t*)(ws + WS_QA) + (size_t)row * 3072 + col, o);
        }
    }
    DI void operator()(const f32x4 (&acc)[2][2][4][2], const pg8::Unit& u, int wr, int wc, int fr, int fq) const {
#pragma unroll
        for (int ai = 0; ai < 2; ++ai)
#pragma unroll
            for (int m = 0; m < 4; ++m) {
                const int row = u.pm * 256 + ai * 128 + wr * 64 + m * 16 + fr;
#pragma unroll
                for (int bj = 0; bj < 2; ++bj)
#pragma unroll
                    for (int n = 0; n < 2; ++n) one(u.di, u.aux, row, u.pn * 256 + bj * 128 + wc * 32 + n * 16 + fq * 4, acc[ai][bj][m][n]);
            }
    }
};

enum RowMap { RM_ID = 0, RM_UQ = 1, RM_UKV = 2 };
DI int map_row(int mode, int n) {
    if (mode == RM_UQ) { const int h = n / QHD, j = n % QHD; if (j < NOPE) return n; const int i = j - NOPE; return h * QHD + NOPE + (i < 32 ? 2 * i : 2 * (i - 32) + 1); }
    if (mode == RM_UKV) { const int h = n >> 8, j = n & 255; return (j < 128 ? 0 : 2048) + h * 128 + (j & 127); }
    return n;
}
DI void transpose_item(const float* W, int K, int N, bf16_t* WT, int mode, LAS float* scr, int item, int lane) {
    const int nblk = N / 32, kb = item / nblk, nb = item % nblk, k0 = 64 * kb, n0 = 32 * nb;
#pragma unroll 8
    for (int i = 0; i < 32; ++i) { const int kk = 2 * i + (lane >> 5); scr[kk * 33 + (lane & 31)] = W[(size_t)(k0 + kk) * N + n0 + (lane & 31)]; }
    asm volatile("s_waitcnt lgkmcnt(0)" ::: "memory");
    const int c = lane & 7;
#pragma unroll
    for (int j = 0; j < 4; ++j) { const int n = (lane >> 3) + 8 * j; const LAS float* s = scr + (8 * c) * 33 + n;
        u32x4 o; o.x = pk2(s[0 * 33], s[1 * 33]); o.y = pk2(s[2 * 33], s[3 * 33]); o.z = pk2(s[4 * 33], s[5 * 33]); o.w = pk2(s[6 * 33], s[7 * 33]);
        *(u32x4*)(WT + (size_t)map_row(mode, n0 + n) * K + k0 + 8 * c) = o; }
    asm volatile("s_waitcnt lgkmcnt(0)" ::: "memory");
}
DI const float* xrow_ptr(const Frame& F, int row) { return row < TP ? F.in[0] + (size_t)row * DM : F.in[1] + (size_t)(row - TP) * DM; }

DI void norm_row_bf16(const float* xr, const float* w, bf16_t* hr, int lane) {
    f32x4 v[8]; float s = 0.f;
#pragma unroll
    for (int j = 0; j < 8; ++j) { v[j] = *(const f32x4*)(xr + 4 * lane + 256 * j); s += (v[j][0] * v[j][0] + v[j][1] * v[j][1]) + (v[j][2] * v[j][2] + v[j][3] * v[j][3]); }
    const float r = __builtin_amdgcn_rsqf(wave_sum(s) * (1.f / DM) + EPS);
#pragma unroll
    for (int j = 0; j < 8; ++j) { const f32x4 ww = *(const f32x4*)(w + 4 * lane + 256 * j); u32x2 o; o.x = pk2(v[j][0] * r * ww[0], v[j][1] * r * ww[1]); o.y = pk2(v[j][2] * r * ww[2], v[j][3] * r * ww[3]);
        *(u32x2*)(hr + 4 * lane + 256 * j) = o; }
}

DI void phase_prep(const Frame& F) {
    LAS float* scr = (LAS float*)(F.lds + F.wave * 16384);
    const int gw = F.bid * NWAVES + F.wave, NGW = F.G * NWAVES;
    unsigned char* ws = F.ws;
    constexpr int I_HIN = 32 * 256, I_HOUT = 32 * 64, I_DOWN = 32 * 34, I_UQ = 8 * 96, I_UKV = 8 * 128, I_MOUT = 32 * 64, I_FIN = 32 * 352, I_FOUT = 88 * 64;
    constexpr int NITEMS = I_HIN + I_HOUT + I_DOWN + I_UQ + I_UKV + I_MOUT + 2 * I_FIN + 2 * I_FOUT;
    for (int it = gw; it < NITEMS; it += NGW) {
        int r = it; const float* W; bf16_t* WT; int K, N, mode = RM_ID;
        if (r < I_HIN) { W = F.in[8]; K = 2048; N = 8192; WT = (bf16_t*)(ws + WS_WT_HIN); }
        else if ((r -= I_HIN) < I_HOUT) { W = F.in[10]; K = 2048; N = 2048; WT = (bf16_t*)(ws + WS_WT_HOUT); }
        else if ((r -= I_HOUT) < I_DOWN) { W = F.in[11]; K = 2048; N = NDOWN; WT = (bf16_t*)(ws + WS_WT_DOWN); }
        else if ((r -= I_DOWN) < I_UQ) { W = F.in[14]; K = 512; N = 3072; WT = (bf16_t*)(ws + WS_WT_UQ); mode = RM_UQ; }
        else if ((r -= I_UQ) < I_UKV) { W = F.in[15]; K = 512; N = 4096; WT = (bf16_t*)(ws + WS_WT_K); mode = RM_UKV; }
        else if ((r -= I_UKV) < I_MOUT) { W = F.in[16]; K = 2048; N = 2048; WT = (bf16_t*)(ws + WS_WT_MOUT); }
        else if ((r -= I_MOUT) < 2 * I_FIN) { const int l = r / I_FIN; r -= l * I_FIN; W = F.in[17] + (size_t)l * 2048 * FF2; K = 2048; N = FF2; WT = (bf16_t*)(ws + WS_WT_FIN) + (size_t)l * FF2 * 2048; }
        else { r -= 2 * I_FIN; const int l = r / I_FOUT; r -= l * I_FOUT; W = F.in[20] + (size_t)l * FF * 2048; K = FF; N = 2048; WT = (bf16_t*)(ws + WS_WT_FOUT) + (size_t)l * 2048 * FF; }
        transpose_item(W, K, N, WT, mode, scr, r, F.lane);
    }
    { const int gt = F.bid * NTHREADS + F.tid, NGT = F.G * NTHREADS; u32x4* p = (u32x4*)((bf16_t*)(ws + WS_WT_DOWN) + (size_t)NDOWN * 2048);
      for (int i = gt; i < (NDOWNP - NDOWN) * 256; i += NGT) p[i] = (u32x4){0u, 0u, 0u, 0u}; }
    { const int gt = F.bid * NTHREADS + F.tid, NGT = F.G * NTHREADS; float* tab = (float*)(ws + WS_TAB);
      for (int i = gt; i < 2048 * 32; i += NGT) { const int pos = i >> 5, k = i & 31;
          double inv = 1.0;
          for (int q = 0; q < k; ++q) inv *= 0.7498942093324559;
          const double rev = (double)pos * inv * 0.15915494309189535; const float fr = (float)(rev - floor(rev));
          tab[2 * i] = __builtin_amdgcn_cosf(fr); tab[2 * i + 1] = __builtin_amdgcn_sinf(fr); }
      float* lb = (float*)(ws + WS_LB); const float* lg = F.in[7];
      for (int i = gt; i < 2048; i += NGT) { const float a = lg[i], b = lg[2048 + i], c = lg[4096 + i]; const float mx = fmaxf(a, fmaxf(b, c));
          const float ea = fexp(a - mx), eb = fexp(b - mx), ec = fexp(c - mx); lb[i] = ea / (ea + eb + ec); } }
    for (int m = gw; m < T; m += NGW) norm_row_bf16(xrow_ptr(F, m), F.in[6], (bf16_t*)(ws + WS_H) + (size_t)m * DM, F.lane);
}

DI void phase_scan(const Frame& F) {
    LAS float* Lf = (LAS float*)(F.lds);
    LAS bf16_t* Lq = (LAS bf16_t*)(F.lds + 32768);
    LAS float* Lv = (LAS float*)(F.lds + 49152);
    const bf16_t* Qb = (const bf16_t*)(F.ws + WS_QB); const float* FG = (const float*)(F.ws + WS_FG); const bf16_t* Vb = (const bf16_t*)(F.ws + WS_VB);
    float* O32 = (float*)(F.ws + WS_O32);
    const int tid = F.tid, lane = F.lane, w = F.wave;
    for (int item = F.bid; item < 768; item += F.G) {
        int s, h, dvq, L, row0;
        if (item < 256) { s = item >> 6; h = (item >> 2) & 15; dvq = item & 3; L = SEQ; row0 = s * SEQ; }
        else { const int it = item - 256; s = 4 + (it >> 6); h = (it >> 2) & 15; dvq = it & 3; L = DS; row0 = TP + (s - 4) * DS; }
        const int CL = L < 64 ? L : 64, nch = L / CL;
        const int c0 = dvq * 32 + w * 4;
        float S0[4], S1[4];
        if (s < 4) { for (int c = 0; c < 4; ++c) { S0[c] = 0.f; S1[c] = 0.f; } }
        else { const float* st = F.in[2] + ((size_t)((s - 4) * HH + h) * DK + 2 * lane) * DV + c0; const f32x4 a = *(const f32x4*)st, b = *(const f32x4*)(st + DV);
               for (int c = 0; c < 4; ++c) { S0[c] = a[c]; S1[c] = b[c]; } }
        for (int ch = 0; ch < nch; ++ch) {
            const int t0 = ch * CL;
            __syncthreads();
#pragma unroll
            for (int i = 0; i < 4; ++i) { const int e = tid * 4 + 2048 * i, r = e >> 7, c = e & 127; if (r < CL) *(LAS f32x4*)(Lf + e) = *(const f32x4*)(FG + (size_t)(row0 + t0 + r) * DM + h * DK + c); }
#pragma unroll
            for (int i = 0; i < 2; ++i) { const int e = tid * 8 + 4096 * i, r = e >> 7, c = e & 127; if (r < CL) *(LAS u32x4*)(Lq + e) = *(const u32x4*)(Qb + (size_t)(row0 + t0 + r) * DM + h * DK + c); }
            { const int e = tid * 4, r = e >> 5, c = e & 31; if (r < CL) { const u32x2 v = *(const u32x2*)(Vb + (size_t)(row0 + t0 + r) * DM + h * DV + dvq * 32 + c);
                  *(LAS f32x4*)(Lv + e) = (f32x4){__uint_as_float(v.x << 16), __uint_as_float(v.x & 0xffff0000u), __uint_as_float(v.y << 16), __uint_as_float(v.y & 0xffff0000u)}; } }
            __syncthreads();
            for (int t = 0; t < CL; ++t) {
                const f32x2 f2 = *(const LAS f32x2*)(Lf + t * 128 + 2 * lane);
                const unsigned q2 = *(const LAS unsigned*)(Lq + t * 128 + 2 * lane);
                const f32x4 v4 = *(const LAS f32x4*)(Lv + t * 32 + w * 4);
                const float q0 = __uint_as_float(q2 << 16), q1 = __uint_as_float(q2 & 0xffff0000u);
                const float k0 = 1.f - f2[0], k1 = 1.f - f2[1];
                float p[4];
#pragma unroll
                for (int c = 0; c < 4; ++c) { S0[c] = f2[0] * S0[c] + k0 * v4[c]; S1[c] = f2[1] * S1[c] + k1 * v4[c]; p[c] = q0 * S0[c] + q1 * S1[c]; }
                float a0 = (lane & 1) ? p[1] : p[0], b0 = (lane & 1) ? p[0] : p[1];
                float a1 = (lane & 1) ? p[3] : p[2], b1 = (lane & 1) ? p[2] : p[3];
                a0 += __shfl_xor(b0, 1); a1 += __shfl_xor(b1, 1);
                float a = (lane & 2) ? a1 : a0, b = (lane & 2) ? a0 : a1;
                a += __shfl_xor(b, 2);
                a += __shfl_xor(a, 4); a += __shfl_xor(a, 8); a += __shfl_xor(a, 16); a += __shfl_xor(a, 32);
                if (lane < 4) O32[(size_t)(row0 + t0 + t) * DM + h * DV + c0 + lane] = a;
            }
        }
        { float* so = F.out + O_HG + ((size_t)(s * HH + h) * DK + 2 * lane) * DV + c0;
          *(f32x4*)so = (f32x4){S0[0], S0[1], S0[2], S0[3]}; *(f32x4*)(so + DV) = (f32x4){S1[0], S1[1], S1[2], S1[3]}; }
    }
}

DI void phase_gate(const Frame& F) {
    const float* O32 = (const float*)(F.ws + WS_O32); const bf16_t* SG = (const bf16_t*)(F.ws + WS_SG); bf16_t* OG = (bf16_t*)(F.ws + WS_OG);
    const float* gw_ = F.in[9]; const int lane = F.lane;
    const int gw = F.bid * NWAVES + F.wave, NGW = F.G * NWAVES;
    for (int m = gw; m < T; m += NGW) {
#pragma unroll
        for (int j = 0; j < 8; ++j) {
            const int col = 4 * lane + 256 * j;
            const f32x4 v = *(const f32x4*)(O32 + (size_t)m * DM + col);
            float s = (v[0] * v[0] + v[1] * v[1]) + (v[2] * v[2] + v[3] * v[3]);
            s += __shfl_xor(s, 1); s += __shfl_xor(s, 2); s += __shfl_xor(s, 4); s += __shfl_xor(s, 8); s += __shfl_xor(s, 16);
            const float r = __builtin_amdgcn_rsqf(s * (1.f / DV) + EPS);
            const f32x4 g = *(const f32x4*)(gw_ + (col & 127)); const u32x2 sg = *(const u32x2*)(SG + (size_t)m * DM + col);
            u32x2 o; o.x = pk2(v[0] * r * g[0] * __uint_as_float(sg.x << 16), v[1] * r * g[1] * __uint_as_float(sg.x & 0xffff0000u));
            o.y = pk2(v[2] * r * g[2] * __uint_as_float(sg.y << 16), v[3] * r * g[3] * __uint_as_float(sg.y & 0xffff0000u));
            *(u32x2*)(OG + (size_t)m * DM + col) = o;
        }
    }
}

DI void phase_rowpass(const Frame& F, int which) {
    const float* Mb = (const float*)(F.ws + WS_M); float* X = (float*)(F.ws + WS_X); bf16_t* H = (bf16_t*)(F.ws + WS_H);
    const float* nw = F.in[6];
    const float* wa = nw + (which == 0 ? 1 : which == 1 ? 3 : which == 2 ? 5 : 7) * DM;
    const float* wb = which == 3 ? nullptr : nw + (which == 0 ? 2 : which == 1 ? 4 : 6) * DM;
    const int lane = F.lane; const int gw = F.bid * NWAVES + F.wave, NGW = F.G * NWAVES;
    for (int m = gw; m < T; m += NGW) {
        const float* xin = which == 0 ? xrow_ptr(F, m) : X + (size_t)m * DM;
        float* xout = which == 3 ? F.out + O_Y + (size_t)m * DM : X + (size_t)m * DM;
        f32x4 v[8]; float s = 0.f;
        if (m < TP) {
            const float* mr = Mb + (size_t)m * DM;
#pragma unroll
            for (int j = 0; j < 8; ++j) v[j] = *(const f32x4*)(mr + 4 * lane + 256 * j);
        } else {
            const float* sl = (const float*)(F.ws + WS_SLAB) + (size_t)(m - TP) * DM; const int nsl = (which & 1) ? KS_5632 : KS_2048;
#pragma unroll
            for (int j = 0; j < 8; ++j) v[j] = *(const f32x4*)(sl + 4 * lane + 256 * j);
            for (int q = 1; q < nsl; ++q) {
#pragma unroll
                for (int j = 0; j < 8; ++j) v[j] += *(const f32x4*)(sl + (size_t)q * TS * DM + 4 * lane + 256 * j); }
        }
#pragma unroll
        for (int j = 0; j < 8; ++j) s += (v[j][0] * v[j][0] + v[j][1] * v[j][1]) + (v[j][2] * v[j][2] + v[j][3] * v[j][3]);
        const float r1 = __builtin_amdgcn_rsqf(wave_sum(s) * (1.f / DM) + EPS);
        float s2 = 0.f;
#pragma unroll
        for (int j = 0; j < 8; ++j) { const f32x4 ww = *(const f32x4*)(wa + 4 * lane + 256 * j); const f32x4 xi = *(const f32x4*)(xin + 4 * lane + 256 * j);
            v[j] = xi + v[j] * r1 * ww; *(f32x4*)(xout + 4 * lane + 256 * j) = v[j];
            s2 += (v[j][0] * v[j][0] + v[j][1] * v[j][1]) + (v[j][2] * v[j][2] + v[j][3] * v[j][3]); }
        if (wb) {
            const float r2 = __builtin_amdgcn_rsqf(wave_sum(s2) * (1.f / DM) + EPS);
#pragma unroll
            for (int j = 0; j < 8; ++j) { const f32x4 ww = *(const f32x4*)(wb + 4 * lane + 256 * j); u32x2 o; o.x = pk2(v[j][0] * r2 * ww[0], v[j][1] * r2 * ww[1]); o.y = pk2(v[j][2] * r2 * ww[2], v[j][3] * r2 * ww[3]);
                *(u32x2*)(H + (size_t)m * DM + 4 * lane + 256 * j) = o; }
        }
    }
}

DI void phase_conv(const Frame& F, int layer) {
    const bf16_t* U = (const bf16_t*)(F.ws + WS_U); bf16_t* ACT = (bf16_t*)(F.ws + WS_ACT);
    const float* cw = F.in[18] + (size_t)layer * 3 * FF2; const float* cb = F.in[19] + (size_t)layer * FF2; const float* sc = F.in[5] + (size_t)layer * DB * 2 * FF2;
    const int gt = F.bid * NTHREADS + F.tid, NGT = F.G * NTHREADS;
    constexpr int NCG = FF / 8, NITEM = (T / 32) * NCG;
    for (int it = gt; it < NITEM; it += NGT) {
        const int rc = it / NCG, cgp = it % NCG, j0 = cgp * 8, r0 = rc * 32;
        float wg[3][8], wu[3][8], bg[8], bu[8];
#pragma unroll
        for (int k = 0; k < 3; ++k) { const f32x4 a = *(const f32x4*)(cw + k * FF2 + j0), b = *(const f32x4*)(cw + k * FF2 + j0 + 4), c = *(const f32x4*)(cw + k * FF2 + FF + j0), d = *(const f32x4*)(cw + k * FF2 + FF + j0 + 4);
            for (int i = 0; i < 4; ++i) { wg[k][i] = a[i]; wg[k][4 + i] = b[i]; wu[k][i] = c[i]; wu[k][4 + i] = d[i]; } }
        { const f32x4 a = *(const f32x4*)(cb + j0), b = *(const f32x4*)(cb + j0 + 4), c = *(const f32x4*)(cb + FF + j0), d = *(const f32x4*)(cb + FF + j0 + 4);
          for (int i = 0; i < 4; ++i) { bg[i] = a[i]; bg[4 + i] = b[i]; bu[i] = c[i]; bu[4 + i] = d[i]; } }
        float g2[8], g1[8], u2[8], u1[8];
        const bool seq_start = r0 < TP ? ((r0 & (SEQ - 1)) == 0) : true;
        if (!seq_start) {
#pragma unroll
            for (int k = 0; k < 2; ++k) { const u32x4 a = *(const u32x4*)(U + (size_t)(r0 - 2 + k) * FF2 + j0), b = *(const u32x4*)(U + (size_t)(r0 - 2 + k) * FF2 + FF + j0);
                float* gd = k == 0 ? g2 : g1; float* ud = k == 0 ? u2 : u1;
                for (int i = 0; i < 4; ++i) { gd[2 * i] = __uint_as_float(a[i] << 16); gd[2 * i + 1] = __uint_as_float(a[i] & 0xffff0000u); ud[2 * i] = __uint_as_float(b[i] << 16); ud[2 * i + 1] = __uint_as_float(b[i] & 0xffff0000u); } }
        } else if (r0 < TP) {
            for (int i = 0; i < 8; ++i) { g2[i] = 0.f; g1[i] = 0.f; u2[i] = 0.f; u1[i] = 0.f; }
        } else {
            const int b = (r0 - TP) >> 5; const float* sp = sc + (size_t)b * 2 * FF2;
#pragma unroll
            for (int k = 0; k < 2; ++k) { const f32x4 a = *(const f32x4*)(sp + k * FF2 + j0), b2 = *(const f32x4*)(sp + k * FF2 + j0 + 4), c = *(const f32x4*)(sp + k * FF2 + FF + j0), d = *(const f32x4*)(sp + k * FF2 + FF + j0 + 4);
                float* gd = k == 0 ? g2 : g1; float* ud = k == 0 ? u2 : u1;
                for (int i = 0; i < 4; ++i) { gd[i] = a[i]; gd[4 + i] = b2[i]; ud[i] = c[i]; ud[4 + i] = d[i]; } }
        }
        for (int t = 0; t < 32; ++t) {
            const u32x4 a = *(const u32x4*)(U + (size_t)(r0 + t) * FF2 + j0), b = *(const u32x4*)(U + (size_t)(r0 + t) * FF2 + FF + j0);
            float g0[8], u0[8], o[8];
#pragma unroll
            for (int i = 0; i < 4; ++i) { g0[2 * i] = __uint_as_float(a[i] << 16); g0[2 * i + 1] = __uint_as_float(a[i] & 0xffff0000u); u0[2 * i] = __uint_as_float(b[i] << 16); u0[2 * i + 1] = __uint_as_float(b[i] & 0xffff0000u); }
#pragma unroll
            for (int i = 0; i < 8; ++i) { const float cgv = bg[i] + wg[0][i] * g2[i] + wg[1][i] * g1[i] + wg[2][i] * g0[i]; const float cuv = bu[i] + wu[0][i] * u2[i] + wu[1][i] * u1[i] + wu[2][i] * u0[i];
                o[i] = siluf_(cgv) * cuv; g2[i] = g1[i]; g1[i] = g0[i]; u2[i] = u1[i]; u1[i] = u0[i]; }
            u32x4 w; w.x = pk2(o[0], o[1]); w.y = pk2(o[2], o[3]); w.z = pk2(o[4], o[5]); w.w = pk2(o[6], o[7]);
            *(u32x4*)(ACT + (size_t)(r0 + t) * FF + j0) = w;
        }
    }
}

DI int kv_row_of(int row) { if (row < TP) return row; const int r = row - TP; return TP + (r >> 5) * KVSEQ + PAST + (r & 31); }
DI void phase_mlarow(const Frame& F) {
    const float* DOWN = (const float*)(F.ws + WS_DOWN); bf16_t* CQ = (bf16_t*)(F.ws + WS_CQ); bf16_t* CKVA = (bf16_t*)(F.ws + WS_CKVA); bf16_t* KPEA = (bf16_t*)(F.ws + WS_KPEA);
    const float* tab = (const float*)(F.ws + WS_TAB); const float* qw = F.in[12]; const float* kw = F.in[13];
    const int lane = F.lane; const int gw = F.bid * NWAVES + F.wave, NGW = F.G * NWAVES;
    for (int m = gw; m < T; m += NGW) {
        const float* dr = DOWN + (size_t)m * NDOWNP; const int kvr = kv_row_of(m);
        f32x4 a[2], b[2]; float sa = 0.f, sb = 0.f;
#pragma unroll
        for (int j = 0; j < 2; ++j) { a[j] = *(const f32x4*)(dr + 4 * lane + 256 * j); b[j] = *(const f32x4*)(dr + 512 + 4 * lane + 256 * j);
            sa += (a[j][0] * a[j][0] + a[j][1] * a[j][1]) + (a[j][2] * a[j][2] + a[j][3] * a[j][3]); sb += (b[j][0] * b[j][0] + b[j][1] * b[j][1]) + (b[j][2] * b[j][2] + b[j][3] * b[j][3]); }
        const float ra = __builtin_amdgcn_rsqf(wave_sum(sa) * (1.f / QL) + EPS), rb = __builtin_amdgcn_rsqf(wave_sum(sb) * (1.f / KVL) + EPS);
#pragma unroll
        for (int j = 0; j < 2; ++j) { const int c = 4 * lane + 256 * j; const f32x4 w1 = *(const f32x4*)(qw + c), w2 = *(const f32x4*)(kw + c);
            const f32x4 q = a[j] * ra * w1, kv = b[j] * rb * w2;
            u32x2 o; o.x = pk2(q[0], q[1]); o.y = pk2(q[2], q[3]); *(u32x2*)(CQ + (size_t)m * QL + c) = o;
            *(f32x4*)(F.out + O_CKV + (size_t)m * KVL + c) = kv;
            u32x2 o2; o2.x = pk2(kv[0], kv[1]); o2.y = pk2(kv[2], kv[3]); *(u32x2*)(CKVA + (size_t)kvr * KVL + c) = o2; }
        if (lane < 32) { const int pos = m < TP ? (m & (SEQ - 1)) : PAST + ((m - TP) & (DS - 1)); const float x1 = dr[1024 + lane], x2 = dr[1024 + 32 + lane];
            const f32x2 cs = *(const f32x2*)(tab + ((size_t)pos * 32 + lane) * 2); const float o1 = x1 * cs[0] - x2 * cs[1], o2 = x2 * cs[0] + x1 * cs[1];
            F.out[O_KPE + (size_t)m * ROPE + lane] = o1; F.out[O_KPE + (size_t)m * ROPE + 32 + lane] = o2;
            *(unsigned*)(KPEA + (size_t)kvr * ROPE + 2 * lane) = pk2(o1, o2); }
    }
    const float* cckv = F.in[3]; const float* ckpe = F.in[4];
    for (int i = gw; i < DB * PAST; i += NGW) { const int b = i >> 10, p = i & (PAST - 1); const int kvr = TP + b * KVSEQ + p;
#pragma unroll
        for (int j = 0; j < 2; ++j) { const int c = 4 * lane + 256 * j; const f32x4 v = *(const f32x4*)(cckv + (size_t)i * KVL + c); u32x2 o; o.x = pk2(v[0], v[1]); o.y = pk2(v[2], v[3]); *(u32x2*)(CKVA + (size_t)kvr * KVL + c) = o; }
        if (lane < 32) { const float x1 = ckpe[(size_t)i * ROPE + lane], x2 = ckpe[(size_t)i * ROPE + 32 + lane]; *(unsigned*)(KPEA + (size_t)kvr * ROPE + 2 * lane) = pk2(x1, x2); }
    }
}

#define MFMA32(a, b, c) __builtin_amdgcn_mfma_f32_32x32x16_bf16((a), (b), (c), 0, 0, 0)
DI void attn_unit(const Frame& F, int qrow0, int kvbase, int nkeys, int h) {
    const bf16_t* QA = (const bf16_t*)(F.ws + WS_QA); const bf16_t* KN = (const bf16_t*)(F.ws + WS_KN); const bf16_t* KPEA = (const bf16_t*)(F.ws + WS_KPEA); const bf16_t* VT = (const bf16_t*)(F.ws + WS_VT);
    bf16_t* AO = (bf16_t*)(F.ws + WS_AO);
    const int lane = F.lane, r = lane & 31, hf = lane >> 5;
    bf16x8 qf[12];
    { const bf16_t* qp = QA + (size_t)(qrow0 + r) * 3072 + h * QHD + 8 * hf;
#pragma unroll
      for (int s = 0; s < 12; ++s) qf[s] = *(const bf16x8*)(qp + 16 * s); }
    f32x16 ot[4];
#pragma unroll
    for (int d = 0; d < 4; ++d)
#pragma unroll
        for (int i = 0; i < 16; ++i) ot[d][i] = 0.f;
    float mrun = -INFINITY, lrun = 0.f;
    for (int key0 = 0; key0 < nkeys; key0 += 32) {
        const bf16_t* kp = KN + (size_t)(kvbase + key0 + r) * 2048 + h * NOPE + 8 * hf;
        const bf16_t* pp = KPEA + (size_t)(kvbase + key0 + r) * ROPE + 8 * hf;
        f32x16 sc;
#pragma unroll
        for (int i = 0; i < 16; ++i) sc[i] = 0.f;
#pragma unroll
        for (int s = 0; s < 8; ++s) sc = MFMA32(*(const bf16x8*)(kp + 16 * s), qf[s], sc);
#pragma unroll
        for (int s = 0; s < 4; ++s) sc = MFMA32(*(const bf16x8*)(pp + 16 * s), qf[8 + s], sc);
        float mx = sc[0];
#pragma unroll
        for (int i = 1; i < 16; ++i) mx = fmaxf(mx, sc[i]);
        mx = fmaxf(mx, __shfl_xor(mx, 32));
        const float mnew = fmaxf(mrun, mx), alpha = __builtin_amdgcn_exp2f(mrun - mnew);
        float ps = 0.f;
#pragma unroll
        for (int i = 0; i < 16; ++i) { sc[i] = __builtin_amdgcn_exp2f(sc[i] - mnew); ps += sc[i]; }
        lrun = lrun * alpha + ps; mrun = mnew;
#pragma unroll
        for (int d = 0; d < 4; ++d)
#pragma unroll
            for (int i = 0; i < 16; ++i) ot[d][i] *= alpha;
        bf16x8 pf[2];
#pragma unroll
        for (int ks = 0; ks < 2; ++ks) { u32x4 w; w.x = pk2(sc[8 * ks], sc[8 * ks + 1]); w.y = pk2(sc[8 * ks + 2], sc[8 * ks + 3]); w.z = pk2(sc[8 * ks + 4], sc[8 * ks + 5]); w.w = pk2(sc[8 * ks + 6], sc[8 * ks + 7]); pf[ks] = __builtin_bit_cast(bf16x8, w); }
#pragma unroll
        for (int d = 0; d < 4; ++d) {
            const bf16_t* vp = VT + (size_t)(h * VD + d * 32 + r) * KVROWS + kvbase + key0 + 4 * hf;
#pragma unroll
            for (int ks = 0; ks < 2; ++ks) { const u32x2 lo = *(const u32x2*)(vp + 16 * ks), hi = *(const u32x2*)(vp + 16 * ks + 8); const u32x4 w = {lo.x, lo.y, hi.x, hi.y};
                ot[d] = MFMA32(__builtin_bit_cast(bf16x8, w), pf[ks], ot[d]); }
        }
    }
    const float inv = __builtin_amdgcn_rcpf(lrun + __shfl_xor(lrun, 32));
    bf16_t* op = AO + (size_t)(qrow0 + r) * DM + h * VD + 4 * hf;
#pragma unroll
    for (int d = 0; d < 4; ++d)
#pragma unroll
        for (int g = 0; g < 4; ++g) { u32x2 o; o.x = pk2(ot[d][4 * g] * inv, ot[d][4 * g + 1] * inv); o.y = pk2(ot[d][4 * g + 2] * inv, ot[d][4 * g + 3] * inv); *(u32x2*)(op + d * 32 + 8 * g) = o; }
}
DI void phase_attn(const Frame& F) {
    const int NGW = F.G * NWAVES;
    for (int p = F.bid * NWAVES + F.wave; p < NB * HH * 32; p += NGW) {
        const int sh = p >> 5, j = p & 31, s = sh >> 4, h = sh & 15;
#pragma unroll 1
        for (int k = 0; k < 2; ++k) { const int qb = k == 0 ? j : 63 - j; attn_unit(F, s * SEQ + 32 * qb, s * SEQ, 64 * ((qb >> 1) + 1), h); }
    }
    for (int wv = F.bid * NWAVES + F.wave; wv < 2048; wv += NGW) if ((wv & 15) == 7) { const int u = wv >> 4, b = u >> 4, h = u & 15; attn_unit(F, TP + b * DS, TP + b * KVSEQ, KVSEQ, h); }
}

DI void run_gemm(const Frame& F, int gi) {
    unsigned char* ws = F.ws; pg8::PhaseSched S; S.G = F.G; S.c = F.bid; S.ng = 1;
    const bf16_t* H = (const bf16_t*)(ws + WS_H);
    switch (gi) {
    case 0: S.K = 2048; S.g[0] = {H, (const bf16_t*)(ws + WS_WT_HIN), 0, 33, 32, 1, 32, D_HGRN}; break;
    case 1: S.K = 2048; S.ng = 2; S.g[0] = {(const bf16_t*)(ws + WS_OG), (const bf16_t*)(ws + WS_WT_HOUT), 0, 32, 8, 1, 32, D_M}; S.g[1] = {(const bf16_t*)(ws + WS_OG), (const bf16_t*)(ws + WS_WT_HOUT), 32, 1, 8, KS_2048, 32 / KS_2048, D_MSLAB}; break;
    case 2: S.K = 2048; S.g[0] = {H, (const bf16_t*)(ws + WS_WT_FIN), 0, 33, 44, 1, 32, D_FFN0}; break;
    case 3: S.K = FF; S.ng = 2; S.g[0] = {(const bf16_t*)(ws + WS_ACT), (const bf16_t*)(ws + WS_WT_FOUT), 0, 32, 8, 1, 88, D_M}; S.g[1] = {(const bf16_t*)(ws + WS_ACT), (const bf16_t*)(ws + WS_WT_FOUT), 32, 1, 8, KS_5632, 88 / KS_5632, D_MSLAB}; break;
    case 4: S.K = 2048; S.g[0] = {H, (const bf16_t*)(ws + WS_WT_DOWN), 0, 33, 5, 1, 32, D_DOWN}; break;
    case 5: S.K = 512; S.ng = 3; S.g[0] = {(const bf16_t*)(ws + WS_CKVA), (const bf16_t*)(ws + WS_WT_K), 0, 65, 8, 1, 8, D_KN}; S.g[1] = {(const bf16_t*)(ws + WS_WT_V), (const bf16_t*)(ws + WS_CKVA), 0, 8, 65, 1, 8, D_VT};
            S.g[2] = {(const bf16_t*)(ws + WS_CQ), (const bf16_t*)(ws + WS_WT_UQ), 0, 33, 12, 1, 8, D_Q}; break;
    case 6: S.K = 2048; S.ng = 2; S.g[0] = {(const bf16_t*)(ws + WS_AO), (const bf16_t*)(ws + WS_WT_MOUT), 0, 32, 8, 1, 32, D_M}; S.g[1] = {(const bf16_t*)(ws + WS_AO), (const bf16_t*)(ws + WS_WT_MOUT), 32, 1, 8, KS_2048, 32 / KS_2048, D_MSLAB}; break;
    case 7: S.K = 2048; S.g[0] = {H, (const bf16_t*)(ws + WS_WT_FIN) + (size_t)FF2 * 2048, 0, 33, 44, 1, 32, D_FFN1}; break;
    default: S.K = FF; S.ng = 2; S.g[0] = {(const bf16_t*)(ws + WS_ACT), (const bf16_t*)(ws + WS_WT_FOUT) + (size_t)2048 * FF, 0, 32, 8, 1, 88, D_M}; S.g[1] = {(const bf16_t*)(ws + WS_ACT), (const bf16_t*)(ws + WS_WT_FOUT) + (size_t)2048 * FF, 32, 1, 8, KS_5632, 88 / KS_5632, D_MSLAB}; break;
    }
    EpiAll E{ws, F.out};
    pg8::gemm_phase<EpiAll>(F.lds, S, E);
}

#define XB_TMO      128
#define XB_XCNT(j)  (256  + 64 * (j))
#define XB_XSUB(j)  (1280 + 64 * (j))
#define XB_XGEN(j)  (2304 + 64 * (j))
#define XB_TOP      3328
#define XB_TOPGEN   3392
#define XCD_BAR_WORDS 3456
#define XB_SPIN_CAP (1u << 18)
__device__ __forceinline__ unsigned xb_ld(unsigned* p)              { return __hip_atomic_load(p, __ATOMIC_RELAXED, __HIP_MEMORY_SCOPE_AGENT); }
__device__ __forceinline__ unsigned xb_add(unsigned* p, unsigned v) { return __hip_atomic_fetch_add(p, v, __ATOMIC_RELAXED, __HIP_MEMORY_SCOPE_AGENT); }
__device__ __forceinline__ unsigned xb_xcc_id() { return (unsigned)__builtin_amdgcn_s_getreg((3 << 11) | 20) & 0xFu; }
#define XB_SPIN(cond, bar) do { unsigned _sp = 0; while (cond) { __builtin_amdgcn_s_sleep(1); \
    if ((++_sp & 255u) == 0u) { if (xb_ld(&(bar)[XB_TMO])) break; if (_sp > XB_SPIN_CAP) { atomicAdd(&(bar)[XB_TMO], 1u); break; } } } } while (0)
struct XcdBarrier { unsigned* bar; unsigned x; volatile LAS unsigned* st; };
__device__ __forceinline__ XcdBarrier xcd_barrier_post(unsigned* bar, volatile LAS unsigned* st) {
    XcdBarrier b; b.bar = bar; b.x = xb_xcc_id(); b.st = st;
    if (threadIdx.x == 0) (void)xb_add(&bar[XB_XCNT(b.x)], 1u);
    return b;
}
__device__ __forceinline__ void xcd_barrier_complete(unsigned* bar, unsigned x, unsigned& nloc, unsigned& nx) {
    const unsigned G = gridDim.x * gridDim.y * gridDim.z;
    unsigned sum, cnt, mine, sp = 0u;
    for (;;) {
        sum = 0u; cnt = 0u; mine = 0u;
#pragma unroll
        for (unsigned j = 0; j < 16; ++j) { const unsigned c = xb_ld(&bar[XB_XCNT(j)]); sum += c; cnt += (c > 0u) ? 1u : 0u; mine = (j == x) ? c : mine; }
        if (sum == G) break;
        __builtin_amdgcn_s_sleep(1);
        if ((++sp & 255u) == 0u) { if (xb_ld(&bar[XB_TMO])) break; if (sp > XB_SPIN_CAP) { atomicAdd(&bar[XB_TMO], 1u); break; } }
    }
    nloc = mine > 0u ? mine : 1u; nx = cnt > 0u ? cnt : 1u;
}
__device__ __forceinline__ void xcd_barrier(const XcdBarrier& b) {
    asm volatile("s_waitcnt vmcnt(0)" ::: "memory");
    __syncthreads();
    if (threadIdx.x == 0) {
        unsigned* bar = b.bar;
        __builtin_amdgcn_s_waitcnt(0);
        unsigned nloc = b.st[0], nx = b.st[1];
        if (nloc == 0u) { xcd_barrier_complete(bar, b.x, nloc, nx); b.st[0] = nloc; b.st[1] = nx; }
        const unsigned old = xb_add(&bar[XB_XSUB(b.x)], 1u);
        const unsigned gen = old / nloc;
        if (old + 1u == (gen + 1u) * nloc) {
            __builtin_amdgcn_fence(__ATOMIC_RELEASE, "agent");
            asm volatile("s_waitcnt vmcnt(0)" ::: "memory");
            const unsigned og = xb_add(&bar[XB_TOP], 1u);
            const unsigned tg = og / nx;
            if (og + 1u == (tg + 1u) * nx) xb_add(&bar[XB_TOPGEN], 1u);
            else XB_SPIN(xb_ld(&bar[XB_TOPGEN]) == tg, bar);
            __builtin_amdgcn_fence(__ATOMIC_ACQUIRE, "agent");
            xb_add(&bar[XB_XGEN(b.x)], 1u);
            asm volatile("s_waitcnt vmcnt(0)" ::: "memory");
        } else {
            XB_SPIN(xb_ld(&bar[XB_XGEN(b.x)]) == gen, bar);
            __builtin_amdgcn_fence(__ATOMIC_ACQUIRE, "agent");
            asm volatile("s_waitcnt vmcnt(0)" ::: "memory");
        }
    }
    __syncthreads();
}

constexpr int N_PHASES = 20;
template <bool COOP>
__global__ void __launch_bounds__(NTHREADS, 2) mk_fwd(Args args) {
    extern __shared__ __attribute__((aligned(16))) unsigned char lds[];
    Frame F;
    F.lds = (LAS unsigned char*)lds;
    F.tid = threadIdx.x; F.lane = F.tid & 63; F.wave = __builtin_amdgcn_readfirstlane(F.tid >> 6); F.G = gridDim.x; F.bid = blockIdx.x;
    F.in = args.in; F.out = args.out; F.ws = args.ws;
    volatile LAS unsigned* misc = (volatile LAS unsigned*)(F.lds + 131072);
    if (F.tid < 16) misc[F.tid] = 0u;
    __syncthreads();
    XcdBarrier xbar; xbar.bar = (unsigned*)(args.ws + WS_CTL); xbar.x = 0; xbar.st = nullptr;
    if (COOP) xbar = xcd_barrier_post((unsigned*)(args.ws + WS_CTL), misc + 8);
    Frame F0 = F;
    for (int ph = args.ph_lo; ph < args.ph_hi; ++ph) {
        Frame F = F0;
        asm volatile("" : "+v"(F.tid), "+v"(F.lane));
        asm volatile("" : "+s"(F.wave), "+s"(F.bid), "+s"(F.G));
        int g0 = 0, g1 = 0;
        switch (ph) {
        case 1: g0 = 0; g1 = 1; break;
        case 4: g0 = 1; g1 = 2; break;
        case 6: g0 = 2; g1 = 3; break;
        case 8: g0 = 3; g1 = 4; break;
        case 10: g0 = 4; g1 = 5; break;
        case 12: g0 = 5; g1 = 6; break;
        case 14: g0 = 6; g1 = 7; break;
        case 16: g0 = 7; g1 = 8; break;
        case 18: g0 = 8; g1 = 9; break;
        default: break;
        }
        if (g1 > g0) {
#pragma unroll 1
            for (int gi = g0; gi < g1; ++gi) run_gemm(F, gi);
        } else {
#ifndef PHM
#define PHM 0xFFFFF
#endif
            switch (ph) {
            case 0: if (PHM & (1 << 0)) phase_prep(F); break;
            case 2: if (PHM & (1 << 2)) phase_scan(F); break;
            case 3: if (PHM & (1 << 3)) phase_gate(F); break;
            case 5: if (PHM & (1 << 5)) phase_rowpass(F, 0); break;
            case 7: if (PHM & (1 << 7)) phase_conv(F, 0); break;
            case 9: if (PHM & (1 << 9)) phase_rowpass(F, 1); break;
            case 11: if (PHM & (1 << 11)) phase_mlarow(F); break;
            case 13: if (PHM & (1 << 13)) phase_attn(F); break;
            case 15: if (PHM & (1 << 15)) phase_rowpass(F, 2); break;
            case 17: if (PHM & (1 << 17)) phase_conv(F, 1); break;
            default: if (PHM & (1 << 19)) phase_rowpass(F, 3); break;
            }
        }
        if (COOP) { if (ph + 1 < args.ph_hi) { if (ph == 0) cg::this_grid().sync(); else xcd_barrier(xbar); } }
    }
}

extern "C" void kernel_launch(void* const* d_in, const int* in_sizes, int n_in, void* d_out, int out_size, void* d_ws, size_t ws_size, hipStream_t stream) {
    static int grid = 0;
    if (grid == 0) {
        if (n_in != 21 || (size_t)out_size != O_END || ws_size < WS_END) { fprintf(stderr, "kernel_launch: unexpected sizes n_in %d out %d (want %zu) ws %zu (need %zu)\n", n_in, out_size, (size_t)O_END, ws_size, (size_t)WS_END); grid = -1; return; }
        int dev = 0, cus = 0, per_cu = 0;
        hipGetDevice(&dev); hipDeviceGetAttribute(&cus, hipDeviceAttributeMultiprocessorCount, dev);
        hipFuncSetAttribute((const void*)mk_fwd<true>, hipFuncAttributeMaxDynamicSharedMemorySize, LDS_BYTES);
        hipFuncSetAttribute((const void*)mk_fwd<false>, hipFuncAttributeMaxDynamicSharedMemorySize, LDS_BYTES);
        hipOccupancyMaxActiveBlocksPerMultiprocessor(&per_cu, (const void*)mk_fwd<true>, NTHREADS, LDS_BYTES);
        if (per_cu < 1) { fprintf(stderr, "kernel_launch: occupancy query reports %d blocks per CU\n", per_cu); per_cu = 1; }
        (void)hipGetLastError();
        grid = cus;
    }
    if (grid < 0) return;
    if (hipMemsetAsync((char*)d_ws + WS_CTL, 0, CTL_BYTES, stream) != hipSuccess) { fprintf(stderr, "kernel_launch: memset of the barrier words failed\n"); return; }
    Args a{};
    for (int i = 0; i < 21; ++i) a.in[i] = (const float*)d_in[i];
    a.out = (float*)d_out; a.ws = (unsigned char*)d_ws;
#if MK_ONE_LAUNCH
    a.ph_lo = 0; a.ph_hi = N_PHASES;
    void* kargs[] = {&a};
    hipError_t e = hipLaunchCooperativeKernel((const void*)mk_fwd<true>, dim3(grid), dim3(NTHREADS), kargs, LDS_BYTES, stream);
    if (e != hipSuccess) fprintf(stderr, "cooperative launch failed: %s (grid %d)\n", hipGetErrorString(e), grid);
#else
    for (int ph = 0; ph < N_PHASES; ++ph) {
        a.ph_lo = ph; a.ph_hi = ph + 1;
        hipLaunchKernelGGL(mk_fwd<false>, dim3(grid), dim3(NTHREADS), LDS_BYTES, stream, a);
    }
#endif
}
```

```cpp
#include <hip/hip_runtime.h>
#include <hip/hip_cooperative_groups.h>
#include <cstdio>
#include <cstdint>
namespace cg = cooperative_groups;

#ifndef MK_ONE_LAUNCH
#define MK_ONE_LAUNCH 1
#endif

#ifndef PROBE_KDUP_GI
#define PROBE_KDUP_GI -1
#endif
#ifndef PROBE_PH
#define PROBE_PH -1
#endif
#define PROBE_MULT 2
#define LAS __attribute__((address_space(3)))
#define GAS __attribute__((address_space(1)))
#define DI __device__ __forceinline__
typedef unsigned short bf16_t;
typedef short bf16x8 __attribute__((ext_vector_type(8)));
typedef float f32x4 __attribute__((ext_vector_type(4)));
typedef _Float16 h16x2 __attribute__((ext_vector_type(2)));
typedef float f32x2 __attribute__((ext_vector_type(2)));
typedef float f32x16 __attribute__((ext_vector_type(16)));
typedef unsigned u32x4 __attribute__((ext_vector_type(4)));
typedef unsigned u32x2 __attribute__((ext_vector_type(2)));
typedef __bf16 bf16x2_t __attribute__((ext_vector_type(2)));

constexpr int DM = 2048, NB = 4, SEQ = 2048, DB = 8, DS = 32, PAST = 1024;
constexpr int TP = NB * SEQ, TS = DB * DS, T = TP + TS;
constexpr int HH = 16, DK = 128, DV = 128;
constexpr int QL = 512, KVL = 512, NOPE = 128, ROPE = 64, VD = 128, QHD = NOPE + ROPE;
constexpr int NDOWN = QL + KVL + ROPE, NDOWNP = 1280;
constexpr int FF = 5632, FF2 = 2 * FF;
constexpr int KVSEQ = PAST + DS;
constexpr int KVROWS = TP + DB * KVSEQ;
constexpr float EPS = 1e-6f;
constexpr int NTHREADS = 512, NWAVES = 8;

constexpr size_t O_Y = 0;
constexpr size_t O_HG = (size_t)T * DM;
constexpr size_t O_CKV = O_HG + (size_t)12 * HH * DK * DV;
constexpr size_t O_KPE = O_CKV + (size_t)T * KVL;
constexpr size_t O_CONVP = O_KPE + (size_t)T * ROPE;
constexpr size_t O_CONVS = O_CONVP + (size_t)2 * NB * 2 * FF2;
constexpr size_t O_END = O_CONVS + (size_t)2 * DB * 2 * FF2;

constexpr size_t al256(size_t x) { return (x + 255) & ~(size_t)255; }
constexpr size_t WS_WT_HIN = 0;
constexpr size_t WS_WT_HOUT = WS_WT_HIN + (size_t)8192 * 2048 * 2;
constexpr size_t WS_WT_DOWN = WS_WT_HOUT + (size_t)2048 * 2048 * 2;
constexpr size_t WS_WT_UQ = WS_WT_DOWN + (size_t)NDOWNP * 2048 * 2;
constexpr size_t WS_WT_K = WS_WT_UQ + (size_t)3072 * 512 * 2;
constexpr size_t WS_WT_V = WS_WT_K + (size_t)2048 * 512 * 2;
constexpr size_t WS_WT_MOUT = WS_WT_V + (size_t)2048 * 512 * 2;
constexpr size_t WS_WT_FIN = WS_WT_MOUT + (size_t)2048 * 2048 * 2;
constexpr size_t WS_WT_FOUT = WS_WT_FIN + (size_t)2 * FF2 * 2048 * 2;
constexpr size_t WS_TAB = WS_WT_FOUT + (size_t)2 * 2048 * FF * 2;
constexpr size_t WS_LB = WS_TAB + (size_t)2048 * 32 * 2 * 4;
constexpr size_t WS_X = WS_LB + 2048 * 4;
constexpr size_t WS_HPAD = WS_X + (size_t)T * DM * 4;
constexpr size_t WS_H = WS_HPAD + (size_t)2 * DM * 2;
constexpr size_t WS_M = WS_H + (size_t)T * DM * 2;
constexpr size_t WS_R2 = WS_M;
constexpr size_t WS_R = WS_M + (size_t)T * DM * 4;
constexpr size_t WS_QB = WS_R;
constexpr size_t WS_FG = WS_QB + (size_t)T * DM * 2;
constexpr size_t WS_VT2 = WS_FG + (size_t)T * DM * 4;
constexpr size_t WS_SG = WS_VT2 + (size_t)T * DM * 2;
constexpr size_t WS_OG = WS_SG + (size_t)T * DM * 2;
constexpr size_t WS_RA_END = WS_OG + (size_t)T * DM * 2;
constexpr size_t WS_ACT = WS_R;
constexpr size_t WS_RB_END = WS_ACT + (size_t)T * FF * 2;
constexpr size_t WS_DOWN = WS_R;
constexpr size_t WS_CQ = WS_DOWN + (size_t)T * NDOWNP * 4;
constexpr size_t WS_CKVA = WS_CQ + (size_t)T * QL * 2;
constexpr size_t WS_KPEA = WS_CKVA + (size_t)KVROWS * KVL * 2;
constexpr size_t WS_QA = WS_KPEA + (size_t)KVROWS * ROPE * 2;
constexpr size_t WS_KN = WS_QA + (size_t)T * 3072 * 2;
constexpr size_t WS_VT = WS_KN + (size_t)KVROWS * 2048 * 2;
constexpr size_t WS_AO = WS_VT + (size_t)2048 * KVROWS * 2;
constexpr size_t WS_RC_END = WS_AO + (size_t)T * DM * 2;
constexpr size_t cmax(size_t a, size_t b) { return a > b ? a : b; }
constexpr size_t WS_SLAB = cmax(WS_RA_END, cmax(WS_RB_END, WS_RC_END));
constexpr size_t WS_CTL = WS_SLAB + (size_t)22 * TS * DM * 4;
constexpr size_t CTL_BYTES = 65536;
constexpr size_t WS_XCH = WS_CTL + CTL_BYTES;
constexpr size_t WS_END = WS_XCH + (size_t)2 * 32 * 256 * 8 * 4;

constexpr int KS_2048 = 8, KS_5632 = 11;
constexpr int LDS_BYTES = 147456;
constexpr int MISC_OFF = LDS_BYTES - 512;

template <class T> DI T* as_global(T* p) { return (T*)(GAS T*)p; }
DI float bf2f(unsigned short b) { return __uint_as_float((unsigned)b << 16); }
DI unsigned pk2(float lo, float hi) { f32x2 v = {lo, hi}; bf16x2_t b = __builtin_convertvector(v, bf16x2_t); return __builtin_bit_cast(unsigned, b); }
DI float fexp(float x) { return __builtin_amdgcn_exp2f(x * 1.4426950408889634f); }
DI float sigmoidf_(float x) { return __builtin_amdgcn_rcpf(1.f + fexp(-x)); }
DI float siluf_(float x) { return x * sigmoidf_(x); }
template <int M> DI float xor_lane(float v) { static_assert(M >= 1 && M < 32, "ds_swizzle bit mode"); return __int_as_float(__builtin_amdgcn_ds_swizzle(__float_as_int(v), 0x1f | (M << 10))); }
DI float sum_xor32(float v) { auto rr = __builtin_amdgcn_permlane32_swap(__float_as_uint(v), __float_as_uint(v), false, false); return __uint_as_float(rr[0]) + __uint_as_float(rr[1]); }
DI float max_xor32(float v) { auto rr = __builtin_amdgcn_permlane32_swap(__float_as_uint(v), __float_as_uint(v), false, false); return fmaxf(__uint_as_float(rr[0]), __uint_as_float(rr[1])); }
DI float wave_sum(float v) { v += xor_lane<1>(v); v += xor_lane<2>(v); v += xor_lane<4>(v); v += xor_lane<8>(v); v += xor_lane<16>(v); return sum_xor32(v); }

namespace pg8 {
constexpr int BM = 256, BK = 64, HALF = 128, HTB = HALF * BK * 2, STAGE_BYTES = 8 * HTB, NXCD = 8, WGM = 8;
__host__ __device__ __forceinline__ int lds_byte(int r, int c) { const int st = (r >> 4) * 2 + (c >> 5), rr = r & 15, cc = c & 31, ob = rr * 64 + cc * 2; return st * 1024 + (ob ^ (((ob >> 9) & 1) << 5)); }
__host__ __device__ __forceinline__ void stage_rc(int b, int& R, int& C) { const int st = b / 1024, sb = b % 1024, swz = sb ^ (((sb >> 9) & 1) << 5); R = (st >> 1) * 16 + swz / 64; C = (st & 1) * 32 + (swz % 64) / 2; }

struct Unit { const char* A; const char* B; int r0, pn, nt, di, aux; };

__device__ __forceinline__ void decode_group(const void* A, const void* Bt, int K, int rs0, int rstep, int nM, int nN, int ks, int ntk, int di, int L, Unit& u) {
    int pml, pn, sl = 0;
    if (ks == 1) {
        const int nwg = nM * nN; int wgid = L;
        { const int q = nwg / NXCD, r = nwg % NXCD, xcd = wgid % NXCD, off = wgid / NXCD; wgid = (xcd < r ? xcd * (q + 1) : r * (q + 1) + (xcd - r) * q) + off; }
        const int nig = WGM * nN, gid = wgid / nig, fm = gid * WGM, gsz = (nM - fm) < WGM ? (nM - fm) : WGM;
        pml = fm + ((wgid % nig) % gsz); pn = (wgid % nig) / gsz;
    } else { sl = L % ks; const int tile = L / ks; pn = tile % nN; pml = tile / nN; }
    u.r0 = rs0 + pml * rstep; u.pn = pn; u.nt = ntk; u.di = di; u.aux = sl;
    u.A = (const char*)A + ((long)u.r0 * K + (long)sl * ntk * BK) * 2;
    u.B = (const char*)Bt + ((long)pn * BM * K + (long)sl * ntk * BK) * 2;
}
struct Group { const void* A; const void* Bt; int rs0, rstep, nM, nN, ks, ntk, di; };
struct PhaseSched {
    Group g[3]; int ng, K, G, c;
#if PROBE_KDUP_GI >= 0
    int kdup;
#endif
    __device__ __forceinline__ bool next(int i, Unit& u) const {
        int L = i * G + c;
#pragma unroll
        for (int k = 0; k < 3; ++k) if (k < ng) { const int cnt = g[k].nM * g[k].nN * g[k].ks;
            if (L < cnt) { decode_group(g[k].A, g[k].Bt, K, g[k].rs0, g[k].rstep, g[k].nM, g[k].nN, g[k].ks, g[k].ntk, g[k].di, L, u); return true; } L -= cnt; }
        return false;
    }
};

template <class Epi>
__device__ __forceinline__ void gemm_phase(LAS unsigned char* lds, const PhaseSched& S, const Epi& E, int tid_in) {
    Unit cur, nxt; int ui = 0;
    if (!S.next(0, cur)) return;
    int tid; { unsigned ones = ~0u; asm volatile("" : "+s"(ones)); tid = tid_in * 64 + (int)__builtin_amdgcn_mbcnt_hi(ones, __builtin_amdgcn_mbcnt_lo(ones, 0u)); }
    const int wid = __builtin_amdgcn_readfirstlane(tid >> 6), lane = tid & 63, wr = wid >> 2, wc = wid & 3, fr = lane & 15, fq = lane >> 4;
    const int K = S.K;
    unsigned voffA[2], voffB[2];
#pragma unroll
    for (int i = 0; i < 2; ++i) { int R, C; stage_rc(tid * 16 + i * 8192, R, C);
        voffA[i] = (unsigned)(R * K + C) * 2u; voffB[i] = (unsigned)(R * K + C) * 2u; }
    const size_t kstep = (size_t)(BK * 2);
    const size_t hstep = (size_t)HALF * K * 2;
    const unsigned ldsw = (unsigned)wid * 1024u;
    const int aoff = lds_byte(wr * 64 + fr, fq * 8), boff = lds_byte(wc * 32 + fr, fq * 8);
#define PG8_SA(b, h) (((b) * 2 + (h)) * HTB)
#define PG8_SB(b, h) ((4 + (b) * 2 + (h)) * HTB)
#define PG8_STAGE(bufoff, gbase, voff) do { _Pragma("unroll") for (int _i = 0; _i < 2; ++_i) \
        __builtin_amdgcn_global_load_lds((const unsigned*)((const char*)(gbase) + (voff)[_i]), (LAS unsigned*)(lds + (bufoff) + ldsw + _i * 8192), 16, 0, 0); } while (0)
#define PG8_LDA(dst, b, h) do { _Pragma("unroll") for (int m = 0; m < 4; ++m) _Pragma("unroll") for (int k = 0; k < 2; ++k) dst[m][k] = *(const LAS bf16x8*)(lds + PG8_SA(b, h) + aoff + m * 2048 + k * 1024); } while (0)
#define PG8_LDB(dst, b, h) do { _Pragma("unroll") for (int n = 0; n < 2; ++n) _Pragma("unroll") for (int k = 0; k < 2; ++k) dst[n][k] = *(const LAS bf16x8*)(lds + PG8_SB(b, h) + boff + n * 2048 + k * 1024); } while (0)
#define PG8_MMA(ai, bj, At, Bt) do { __builtin_amdgcn_s_setprio(1); _Pragma("unroll") for (int m = 0; m < 4; ++m) _Pragma("unroll") for (int n = 0; n < 2; ++n) _Pragma("unroll") for (int k = 0; k < 2; ++k) \
        acc[ai][bj][m][n] = __builtin_amdgcn_mfma_f32_16x16x32_bf16(Bt[n][k], At[m][k], acc[ai][bj][m][n], 0, 0, 0); __builtin_amdgcn_s_setprio(0); } while (0)
#define PG8_WAIT_V(n) asm volatile("s_waitcnt vmcnt(" #n ")" ::: "memory")
#define PG8_WAIT_L(n) asm volatile("s_waitcnt lgkmcnt(" #n ")" ::: "memory")
#define PG8_BAR __builtin_amdgcn_s_barrier()
#define PG8_SCHED __builtin_amdgcn_sched_barrier(0)
    f32x4 acc[2][2][4][2];
#pragma unroll
    for (int a = 0; a < 2; ++a)
#pragma unroll
        for (int b = 0; b < 2; ++b)
#pragma unroll
            for (int m = 0; m < 4; ++m)
#pragma unroll
                for (int n = 0; n < 2; ++n) acc[a][b][m][n] = (f32x4){0.f, 0.f, 0.f, 0.f};
    bf16x8 At[4][2], B0[2][2], B1[2][2];
    const char* cA = cur.A; const char* cB = cur.B;
    PG8_STAGE(PG8_SB(0, 0), cB, voffB); PG8_STAGE(PG8_SB(0, 1), cB + hstep, voffB); PG8_STAGE(PG8_SA(0, 0), cA, voffA); PG8_STAGE(PG8_SA(0, 1), cA + hstep, voffA);
    if (wr == 1) PG8_BAR;
    PG8_WAIT_V(2); PG8_BAR;
    PG8_STAGE(PG8_SB(1, 0), cB + kstep, voffB); PG8_STAGE(PG8_SA(1, 0), cA + kstep, voffA); PG8_STAGE(PG8_SB(1, 1), cB + hstep + kstep, voffB);
    PG8_WAIT_V(6); PG8_BAR;
    for (;;) {
        const bool has_next = S.next(ui + 1, nxt);
        const char* nA = has_next ? nxt.A : cA; const char* nB = has_next ? nxt.B : cB;
#if PROBE_KDUP_GI >= 0
        const int ntr = cur.nt, nt = S.kdup ? 2 * ntr : ntr;
#define PG8_TIDX(x) ((x) >= ntr ? (x) - ntr : (x))
#else
        const int nt = cur.nt;
#define PG8_TIDX(x) (x)
#endif
        for (int t = 0; t < nt; t += 2) {
            const bool last = (t == nt - 2);
            const char* a1 = cA + (size_t)(PG8_TIDX(t) + 1) * kstep;
            const char* a2 = last ? nA : cA + (size_t)PG8_TIDX(t + 2) * kstep; const char* b2 = last ? nB : cB + (size_t)PG8_TIDX(t + 2) * kstep;
            const char* a3 = a2 + kstep; const char* b3 = b2 + kstep;
            PG8_LDB(B0, 0, 0); PG8_LDB(B1, 0, 1); PG8_SCHED; PG8_LDA(At, 0, 0); PG8_STAGE(PG8_SA(1, 1), a1 + hstep, voffA);
            PG8_WAIT_V(8); PG8_WAIT_L(0); PG8_BAR; PG8_MMA(0, 0, At, B0); PG8_MMA(0, 1, At, B1); PG8_BAR; PG8_SCHED;
            PG8_LDA(At, 0, 1); PG8_STAGE(PG8_SB(0, 0), b2, voffB); PG8_STAGE(PG8_SB(0, 1), b2 + hstep, voffB); PG8_STAGE(PG8_SA(0, 0), a2, voffA);
            PG8_WAIT_V(8); PG8_WAIT_L(0); PG8_BAR; PG8_MMA(1, 0, At, B0); PG8_MMA(1, 1, At, B1); PG8_BAR; PG8_SCHED;
            PG8_LDB(B0, 1, 0); PG8_LDB(B1, 1, 1); PG8_SCHED; PG8_LDA(At, 1, 0); PG8_STAGE(PG8_SA(0, 1), a2 + hstep, voffA);
            PG8_WAIT_V(8); PG8_WAIT_L(0); PG8_BAR; PG8_MMA(0, 0, At, B0); PG8_MMA(0, 1, At, B1); PG8_BAR; PG8_SCHED;
            PG8_LDA(At, 1, 1); PG8_STAGE(PG8_SB(1, 0), b3, voffB); PG8_STAGE(PG8_SB(1, 1), b3 + hstep, voffB); PG8_STAGE(PG8_SA(1, 0), a3, voffA);
            PG8_WAIT_V(8); PG8_WAIT_L(0); PG8_BAR; PG8_MMA(1, 0, At, B0); PG8_MMA(1, 1, At, B1); PG8_BAR; PG8_SCHED;
        }
        if (wr == 0) PG8_BAR;
        E(acc, cur, wr, wc, fr, fq);
        if (!has_next) break;
#pragma unroll
        for (int a = 0; a < 2; ++a)
#pragma unroll
            for (int b = 0; b < 2; ++b)
#pragma unroll
                for (int m = 0; m < 4; ++m)
#pragma unroll
                    for (int n = 0; n < 2; ++n) acc[a][b][m][n] = (f32x4){0.f, 0.f, 0.f, 0.f};
        cur = nxt; cA = nA; cB = nB; ++ui;
        if (wr == 1) PG8_BAR;
    }
    PG8_WAIT_V(0);
    PG8_BAR;
#undef PG8_TIDX
#undef PG8_SA
#undef PG8_SB
#undef PG8_STAGE
#undef PG8_LDA
#undef PG8_LDB
#undef PG8_MMA
#undef PG8_WAIT_V
#undef PG8_WAIT_L
#undef PG8_BAR
#undef PG8_SCHED
}
}

struct Args { const float* in[21]; float* out; unsigned char* ws; int ph_lo, ph_hi; };

struct Frame {
    LAS unsigned char* lds;
    int tid, lane, wave, G, bid;
    const float* const* in; float* out; unsigned char* ws; int z;
};

template <int TAG = 0> DI Frame with_ids(Frame F) { unsigned ones = ~0u; asm volatile("; ids %1" : "+s"(ones) : "n"(TAG));
    F.lane = (int)__builtin_amdgcn_mbcnt_hi(ones, __builtin_amdgcn_mbcnt_lo(ones, 0u)); F.tid = F.wave * 64 + F.lane; return F; }

enum EpiDesc { D_HGRN = 0, D_M = 1, D_MSLAB = 2, D_FFN0 = 3, D_FFN1 = 4, D_DOWN = 5, D_Q = 6, D_KN = 7, D_VT = 8, D_VT2 = 9, D_VT2S = 10 };
DI float shl16_1(float v) { return __int_as_float(__builtin_amdgcn_update_dpp(0, __float_as_int(v), 0x101, 0xf, 0xf, false)); }
template <int N> DI float ror16(float v) { return __int_as_float(__builtin_amdgcn_update_dpp(0, __float_as_int(v), 0x120 + N, 0xf, 0xf, false)); }
struct EpiAll {
    unsigned char* ws; float* out; LAS unsigned char* lds; const float* const* in; int wave, z, which;
#if PROBE_KDUP_GI >= 0
    int kd;
#endif
    DI int hw_tid() const { unsigned ones = ~0u; asm volatile("" : "+s"(ones)); return wave * 64 + (int)__builtin_amdgcn_mbcnt_hi(ones, __builtin_amdgcn_mbcnt_lo(ones, 0u)); }
    DI void st_bf16(bf16_t* p, f32x4 v) const { u32x2 w; w.x = pk2(v[0], v[1]); w.y = pk2(v[2], v[3]); *(u32x2*)p = w; }
    DI static int PCOL(int fq) { return 4 * fq + ((fq & 1) ? 12 : 0); }
    DI static u32x4 pair16(u32x2 w0, u32x2 w1) {
        auto rx = __builtin_amdgcn_permlane16_swap(w0.x, w1.x, false, false); auto ry = __builtin_amdgcn_permlane16_swap(w0.y, w1.y, false, false);
        u32x4 r = {rx[0], ry[0], rx[1], ry[1]};
        asm volatile("" : "+v"(r.x), "+v"(r.y), "+v"(r.z), "+v"(r.w));
        return r;
    }
    DI static u32x2 pkb(f32x4 v) { return (u32x2){pk2(v[0], v[1]), pk2(v[2], v[3])}; }
    DI void ffn_epi(const f32x4 (&acc)[2][2][4][2], const pg8::Unit& u, int wr, int wc, int fr, int fq) const {
        { int t_ = hw_tid();
          const int lane_ = t_ & 63, wid_ = __builtin_amdgcn_readfirstlane(t_ >> 6); fr = lane_ & 15; fq = lane_ >> 4; wr = wid_ >> 2; wc = wid_ & 3; }
        const int layer = u.di - D_FFN0;
        const float* R2 = (const float*)(ws + WS_R2);
        LAS float* RS = (LAS float*)(lds + 131072 + 8192 + 4096);
        float rs3[2];
#pragma unroll
        for (int ai = 0; ai < 2; ++ai) { int gr_ = u.r0 + 128 * ai + 64 * wr + 48 + fr; gr_ = gr_ < 0 ? 0 : (gr_ >= T ? T - 1 : gr_); rs3[ai] = R2[gr_]; }
        LAS float* HALO = (LAS float*)(lds + 131072);
        LAS float* W4 = (LAS float*)(lds + 131072 + 8192);
        const float* cwl = as_global(in[18 + z]) + (size_t)layer * 3 * FF2; const float* cbl = as_global(in[19 + z]) + (size_t)layer * FF2; const float* sc = as_global(in[5 + z]);
        { const int t_ = hw_tid();
          if (t_ < 256) { int gr_ = u.r0 + t_; gr_ = gr_ < 0 ? 0 : (gr_ >= T ? T - 1 : gr_); RS[t_] = R2[gr_]; }
          if (t_ < 256) { const int v = t_ >> 6, c4 = (t_ & 63) * 4; const float* src = (v < 3 ? cwl + (size_t)v * FF2 : cbl) + (c4 >> 7) * FF + u.pn * 128 + (c4 & 127);
              *(LAS f32x4*)(W4 + v * 256 + c4) = *(const f32x4*)src; } }
        if (fr >= 14) {
#pragma unroll
            for (int ai = 0; ai < 2; ++ai)
#pragma unroll
                for (int bj = 0; bj < 2; ++bj)
#pragma unroll
                    for (int n = 0; n < 2; ++n) *(LAS f32x4*)(HALO + ((2 * ai + wr) * 2 + (fr - 14)) * 256 + 128 * bj + 32 * wc + 16 * n + 4 * fq) = acc[ai][bj][3][n] * rs3[ai];
        }
        asm volatile("s_waitcnt lgkmcnt(0)" ::: "memory"); __builtin_amdgcn_s_barrier(); asm volatile("" ::: "memory");
        const int f0 = u.r0 + 2, l0 = u.r0 + 255;
        const bool special = ((f0 & (SEQ - 1)) <= 1) || ((f0 >> 11) != (l0 >> 11)) || ((l0 & (SEQ - 1)) >= SEQ - 2) || (l0 >= TP);
        bf16_t* ACT = (bf16_t*)(ws + WS_ACT);
#pragma unroll
        for (int ai = 0; ai < 2; ++ai) {
            const int sp = 2 * ai + wr;
#pragma unroll
            for (int m = 0; m < 4; ++m) {
                int lrb = 64 * wr + fr; asm volatile("" : "+v"(lrb));
                const int lr = 128 * ai + 16 * m + lrb, gr = u.r0 + lr;
                const float rsm = RS[lr], rsp = RS[lr >= 16 ? lr - 16 : 0];
                u32x2 wp[2];
#pragma unroll
                for (int n = 0; n < 2; ++n) {
                    const int tc = 32 * wc + 16 * n + 4 * fq, j0 = u.pn * 128 + tc;
                    f32x4 pg, pu;
                    if (m == 0) { pg = (f32x4){0.f, 0.f, 0.f, 0.f}; pu = pg;
                        if (sp >= 1 && fr >= 14) { pg = *(const LAS f32x4*)(HALO + ((sp - 1) * 2 + (fr - 14)) * 256 + tc); pu = *(const LAS f32x4*)(HALO + ((sp - 1) * 2 + (fr - 14)) * 256 + 128 + tc); } }
                    else { pg = acc[ai][0][m > 0 ? m - 1 : 0][n] * rsp; pu = acc[ai][1][m > 0 ? m - 1 : 0][n] * rsp; }
                    const f32x4 g = acc[ai][0][m][n] * rsm, uu = acc[ai][1][m][n] * rsm;
                    f32x4 pg2, pu2, g1r, g2r, u1r, u2r;
#pragma unroll
                    for (int i = 0; i < 4; ++i) { pg2[i] = ror16<2>(pg[i]); pu2[i] = ror16<2>(pu[i]); g1r[i] = ror16<1>(g[i]); g2r[i] = ror16<2>(g[i]); u1r[i] = ror16<1>(uu[i]); u2r[i] = ror16<2>(uu[i]); }
                    asm volatile("" : "+v"(pg2[0]), "+v"(pg2[1]), "+v"(pg2[2]), "+v"(pg2[3]), "+v"(pu2[0]), "+v"(pu2[1]), "+v"(pu2[2]), "+v"(pu2[3]));
                    f32x4 g1, g2, u1, u2, pg1, pu1;
#pragma unroll
                    for (int i = 0; i < 4; ++i) { pg1[i] = shl16_1(pg2[i]); pu1[i] = shl16_1(pu2[i]); }
                    asm volatile("" : "+v"(pg1[0]), "+v"(pg1[1]), "+v"(pg1[2]), "+v"(pg1[3]), "+v"(pu1[0]), "+v"(pu1[1]), "+v"(pu1[2]), "+v"(pu1[3]));
                    asm volatile("" : "+v"(g1r[0]), "+v"(g1r[1]), "+v"(g1r[2]), "+v"(g1r[3]), "+v"(u1r[0]), "+v"(u1r[1]), "+v"(u1r[2]), "+v"(u1r[3]));
                    asm volatile("" : "+v"(g2r[0]), "+v"(g2r[1]), "+v"(g2r[2]), "+v"(g2r[3]), "+v"(u2r[0]), "+v"(u2r[1]), "+v"(u2r[2]), "+v"(u2r[3]));
#pragma unroll
                    for (int i = 0; i < 4; ++i) { g1[i] = fr >= 1 ? g1r[i] : pg1[i]; g2[i] = fr >= 2 ? g2r[i] : pg2[i]; u1[i] = fr >= 1 ? u1r[i] : pu1[i]; u2[i] = fr >= 2 ? u2r[i] : pu2[i]; }
                    if (special && gr < T) {
                        const int p = gr < TP ? (gr & (SEQ - 1)) : ((gr - TP) & (DS - 1));
                        if (p < 2) {
                            const f32x4 z4 = (f32x4){0.f, 0.f, 0.f, 0.f};
                            if (gr >= TP) { const float* sp_ = sc + ((size_t)(layer * DB + ((gr - TP) >> 5)) * 2) * FF2 + j0;
                                if (p == 0) { g2 = *(const f32x4*)sp_; u2 = *(const f32x4*)(sp_ + FF); g1 = *(const f32x4*)(sp_ + FF2); u1 = *(const f32x4*)(sp_ + FF2 + FF); }
                                else { g2 = *(const f32x4*)(sp_ + FF2); u2 = *(const f32x4*)(sp_ + FF2 + FF); } }
                            else { if (p == 0) { g1 = z4; u1 = z4; } g2 = z4; u2 = z4; }
                        }
                        if (lr >= 2) {
                            if (gr < TP) { if (p >= SEQ - 2) { float* o = out + O_CONVP + ((size_t)((layer * NB + (gr >> 11)) * 2 + (p - (SEQ - 2)))) * FF2 + j0; *(f32x4*)o = g; *(f32x4*)(o + FF) = uu; } }
                            else if (p >= DS - 2) { float* o = out + O_CONVS + ((size_t)((layer * DB + ((gr - TP) >> 5)) * 2 + (p - (DS - 2)))) * FF2 + j0; *(f32x4*)o = g; *(f32x4*)(o + FF) = uu; }
                        }
                    }
                    { int wo = tc; asm volatile("" : "+v"(wo));
                      const LAS float* wq = W4 + wo; f32x4 a;
                      { const f32x4 wg0 = *(const LAS f32x4*)wq, wg1 = *(const LAS f32x4*)(wq + 256), wg2 = *(const LAS f32x4*)(wq + 512), bg = *(const LAS f32x4*)(wq + 768);
#pragma unroll
                        for (int i = 0; i < 4; ++i) a[i] = siluf_(bg[i] + wg0[i] * g2[i] + wg1[i] * g1[i] + wg2[i] * g[i]); }
                      __builtin_amdgcn_sched_barrier(0);
                      { const f32x4 wu0 = *(const LAS f32x4*)(wq + 128), wu1 = *(const LAS f32x4*)(wq + 384), wu2 = *(const LAS f32x4*)(wq + 640), bu = *(const LAS f32x4*)(wq + 896);
#pragma unroll
                        for (int i = 0; i < 4; ++i) a[i] *= bu[i] + wu0[i] * u2[i] + wu1[i] * u1[i] + wu2[i] * uu[i]; }
                      wp[n] = pkb(a); }
                }
                { const u32x4 w16 = pair16(wp[0], wp[1]);
                  if (lr >= 2 && gr < T) *(u32x4*)(ACT + (size_t)gr * FF + u.pn * 128 + 32 * wc + PCOL(fq)) = w16; }
                __builtin_amdgcn_sched_barrier(0);
            }
        }
    }
    DI void row_stats(const f32x4 (&acc)[2][2][4][2], int e, int pm, int pn, int wr, int wc, int fr, int fq, int t_, unsigned target) const {
        LAS float* P = (LAS float*)(lds + 131072); LAS float* S = (LAS float*)(lds + 131072 + 4096);
#pragma unroll
        for (int ai = 0; ai < 2; ++ai)
#pragma unroll
            for (int m = 0; m < 4; ++m) { float q = 0.f;
#pragma unroll
                for (int bj = 0; bj < 2; ++bj)
#pragma unroll
                    for (int n = 0; n < 2; ++n) { const f32x4 x = acc[ai][bj][m][n]; q += (x[0] * x[0] + x[1] * x[1]) + (x[2] * x[2] + x[3] * x[3]); }
                q += xor_lane<16>(q); q = sum_xor32(q);
                if (fq == 0) P[(128 * ai + 64 * wr + 16 * m + fr) * 4 + wc] = q; }
        asm volatile("s_waitcnt lgkmcnt(0)" ::: "memory"); __builtin_amdgcn_s_barrier(); asm volatile("" ::: "memory");
        unsigned* slots = (unsigned*)(ws + WS_XCH) + (size_t)((e * 32 + pm) * 256) * 8;
        unsigned* cnt = (unsigned*)(ws + WS_CTL + 16384) + (e * 32 + pm) * 64;
        if (t_ < 256) { const float t = (P[t_ * 4] + P[t_ * 4 + 1]) + (P[t_ * 4 + 2] + P[t_ * 4 + 3]);
            __hip_atomic_store(slots + t_ * 8 + pn, __float_as_uint(t), __ATOMIC_RELAXED, __HIP_MEMORY_SCOPE_AGENT); }
        asm volatile("s_waitcnt vmcnt(0)" ::: "memory");
        if ((t_ & 63) == 0) __hip_atomic_fetch_add(cnt, 1u, __ATOMIC_RELAXED, __HIP_MEMORY_SCOPE_AGENT);
        if (t_ < 64) {
            unsigned sp = 0;
            while ((unsigned)__builtin_amdgcn_readfirstlane(__hip_atomic_load(cnt, __ATOMIC_RELAXED, __HIP_MEMORY_SCOPE_AGENT)) < target) { __builtin_amdgcn_s_sleep(2); if (++sp > (1u << 22)) break; }
        }
        asm volatile("s_waitcnt vmcnt(0) lgkmcnt(0)" ::: "memory"); __builtin_amdgcn_s_barrier(); asm volatile("" ::: "memory");
        if (t_ < 256) { float tot = 0.f;
#pragma unroll
            for (int q = 0; q < 8; ++q) tot += __uint_as_float(__hip_atomic_load(slots + t_ * 8 + q, __ATOMIC_RELAXED, __HIP_MEMORY_SCOPE_AGENT));
            const float rr = __builtin_amdgcn_rsqf(tot * (1.f / DM) + EPS); S[t_] = rr;
            if (e == 1 && pn == 0) ((float*)(ws + WS_R2))[pm * 256 + t_] = rr; }
        asm volatile("s_waitcnt lgkmcnt(0)" ::: "memory"); __builtin_amdgcn_s_barrier(); asm volatile("" ::: "memory");
    }
    DI void res_epi(f32x4 (&acc)[2][2][4][2], const pg8::Unit& u, int wr, int wc, int fr, int fq) const {
        int t_ = hw_tid();
        { const int lane_ = t_ & 63, wid_ = __builtin_amdgcn_readfirstlane(t_ >> 6); fr = lane_ & 15; fq = lane_ >> 4; wr = wid_ >> 2; wc = wid_ & 3; }
        const LAS float* S = (const LAS float*)(lds + 131072 + 4096);
        const int pm = u.r0 >> 8, pn = u.pn; const unsigned target = 64u * (unsigned)(which + 1);
        const float* nw = as_global(in[6 + z]);
        const float* wa = nw + (which == 0 ? 1 : which == 1 ? 3 : which == 2 ? 5 : 7) * DM;
        const float* wb = which == 3 ? nullptr : nw + (which == 0 ? 2 : which == 1 ? 4 : 6) * DM;
        const float* xin32 = as_global(in[0 + z]);
        bf16_t* X16 = (bf16_t*)(ws + WS_X); float* yout = out + O_Y;
        const int col0 = pn * 256 + wc * 32 + 4 * fq;
        LAS float* WL = (LAS float*)(lds + 131072 + 5120);
        if (t_ < 64) *(LAS f32x4*)(WL + t_ * 4) = *(const f32x4*)(wa + pn * 256 + t_ * 4);
        const LAS float* wl = WL + wc * 32 + 4 * fq;
        u32x2 pre[2][4][2][2];
        if (which != 0) {
#pragma unroll
            for (int ai = 0; ai < 2; ++ai)
#pragma unroll
                for (int m = 0; m < 4; ++m) { const size_t ro = (size_t)(u.r0 + 128 * ai + 64 * wr + 16 * m + fr) * DM + col0;
#pragma unroll
                    for (int bj = 0; bj < 2; ++bj)
#pragma unroll
                        for (int n = 0; n < 2; ++n) pre[ai][m][bj][n] = *(const u32x2*)(X16 + ro + bj * 128 + n * 16); }
        }
        row_stats(acc, 0, pm, pn, wr, wc, fr, fq, t_, target);
#pragma unroll
        for (int ai = 0; ai < 2; ++ai)
#pragma unroll
            for (int m = 0; m < 4; ++m) { const int lr = 128 * ai + 64 * wr + 16 * m + fr; const float r1 = S[lr]; const size_t ro = (size_t)(u.r0 + lr) * DM + col0;
#pragma unroll
                for (int bj = 0; bj < 2; ++bj) { u32x2 w2[2];
#pragma unroll
                    for (int n = 0; n < 2; ++n) { const int co = bj * 128 + n * 16; const f32x4 ww = *(const LAS f32x4*)(wl + co);
                        f32x4 xi;
                        if (which == 0) xi = *(const f32x4*)(xin32 + ro + co);
                        else { const u32x2 p = pre[ai][m][bj][n]; xi = (f32x4){__uint_as_float(p.x << 16), __uint_as_float(p.x & 0xffff0000u), __uint_as_float(p.y << 16), __uint_as_float(p.y & 0xffff0000u)}; }
                        const f32x4 v = xi + acc[ai][bj][m][n] * r1 * ww; acc[ai][bj][m][n] = v;
                        if (which == 3) *(f32x4*)(yout + ro + co) = v; else w2[n] = pkb(v); }
                    if (which != 3) *(u32x4*)(X16 + (size_t)(u.r0 + lr) * DM + pn * 256 + wc * 32 + PCOL(fq) + bj * 128) = pair16(w2[0], w2[1]); }
                __builtin_amdgcn_sched_barrier(0); }
        if (wb) row_stats(acc, 1, pm, pn, wr, wc, fr, fq, t_, target);
    }

};
enum EpiGroup { G_HG = 0, G_RES = 1, G_FFN = 2, G_DOWN = 3, G_UP = 4 };
#define EPI_EACH4 _Pragma("unroll") for (int ai = 0; ai < 2; ++ai) _Pragma("unroll") for (int m = 0; m < 4; ++m) _Pragma("unroll") for (int bj = 0; bj < 2; ++bj) _Pragma("unroll") for (int n = 0; n < 2; ++n)
template <int G> struct EpiSel {
    EpiAll e;
    DI static void st_bf16(bf16_t* p, f32x4 v) { u32x2 w; w.x = pk2(v[0], v[1]); w.y = pk2(v[2], v[3]); *(u32x2*)p = w; }
    DI static int PCOL(int fq) { return 4 * fq + ((fq & 1) ? 12 : 0); }
    DI static void st_pair(unsigned char* p, u32x2 w0, u32x2 w1) {
        auto rx = __builtin_amdgcn_permlane16_swap(w0.x, w1.x, false, false);
        auto ry = __builtin_amdgcn_permlane16_swap(w0.y, w1.y, false, false);
        *(u32x4*)p = (u32x4){rx[0], ry[0], rx[1], ry[1]};
    }
    DI static u32x2 pkb(f32x4 v) { return (u32x2){pk2(v[0], v[1]), pk2(v[2], v[3])}; }
    DI static u32x2 pkh(f32x4 v) { const h16x2 p0 = {(_Float16)v[0], (_Float16)v[1]}, p1 = {(_Float16)v[2], (_Float16)v[3]}; return (u32x2){__builtin_bit_cast(unsigned, p0), __builtin_bit_cast(unsigned, p1)}; }
#define EPI_EACH3 _Pragma("unroll") for (int ai = 0; ai < 2; ++ai) _Pragma("unroll") for (int m = 0; m < 4; ++m) _Pragma("unroll") for (int bj = 0; bj < 2; ++bj)
    template <int STRIDE> DI static void plain_bf16(const f32x4 (&acc)[2][2][4][2], unsigned char* base, unsigned off0) {
        EPI_EACH3 st_pair(base + (off0 + (unsigned)(((size_t)(128 * ai + 16 * m) * STRIDE + 128 * bj) * 2)), pkb(acc[ai][bj][m][0]), pkb(acc[ai][bj][m][1]));
    }
    template <int STRIDE> DI static void plain_f32(const f32x4 (&acc)[2][2][4][2], unsigned char* base, unsigned off0) {
        EPI_EACH4 *(f32x4*)(base + (off0 + (unsigned)(((size_t)(128 * ai + 16 * m) * STRIDE + 128 * bj + 16 * n) * 4))) = acc[ai][bj][m][n];
    }
    template <int BJ> DI static void q_half(const f32x4 (&acc)[2][2][4][2], unsigned char* base, unsigned off0, int prow0, bool sample, int hc, int fq) {
        constexpr float QS = 0.07216878364870322f * 1.4426950408889634f;
        if (hc >= NOPE) {
            float f0[2], f1[2];
#pragma unroll
            for (int n = 0; n < 2; ++n) { const int i0 = (hc + 16 * n + 4 * fq - NOPE) >> 1;
                f0[n] = __builtin_amdgcn_exp2f((float)i0 * -0.41524101186092029f) * 0.15915494309189535f; f1[n] = __builtin_amdgcn_exp2f((float)(i0 + 1) * -0.41524101186092029f) * 0.15915494309189535f; }
#pragma unroll
            for (int ai = 0; ai < 2; ++ai)
#pragma unroll
                for (int m = 0; m < 4; ++m) { const int r = prow0 + 128 * ai + 16 * m; const float fp = (float)(sample ? PAST + (r & (DS - 1)) : (r & (SEQ - 1)));
                    u32x2 wq[2];
#pragma unroll
                    for (int n = 0; n < 2; ++n) { const f32x4 v = acc[ai][BJ][m][n]; const float r0 = __builtin_amdgcn_fractf(fp * f0[n]), r1 = __builtin_amdgcn_fractf(fp * f1[n]);
                        const float c0 = __builtin_amdgcn_cosf(r0), s0 = __builtin_amdgcn_sinf(r0), c1 = __builtin_amdgcn_cosf(r1), s1 = __builtin_amdgcn_sinf(r1); f32x4 o;
                        o[0] = v[0] * c0 - v[1] * s0; o[1] = v[1] * c0 + v[0] * s0; o[2] = v[2] * c1 - v[3] * s1; o[3] = v[3] * c1 + v[2] * s1;
                        wq[n] = pkb(o * QS); }
                    st_pair(base + (off0 + (unsigned)((128 * ai + 16 * m) * 3072 + 128 * BJ) * 2u), wq[0], wq[1]); }
        } else {
#pragma unroll
            for (int ai = 0; ai < 2; ++ai)
#pragma unroll
                for (int m = 0; m < 4; ++m) st_pair(base + (off0 + (unsigned)((128 * ai + 16 * m) * 3072 + 128 * BJ) * 2u), pkb(acc[ai][BJ][m][0] * QS), pkb(acc[ai][BJ][m][1] * QS));
        }
    }
    DI void operator()(f32x4 (&acc)[2][2][4][2], const pg8::Unit& u, int wr, int wc, int fr, int fq) const {
#if PROBE_KDUP_GI >= 0
        if (e.kd) {
#pragma unroll
            for (int a = 0; a < 2; ++a)
#pragma unroll
                for (int b = 0; b < 2; ++b)
#pragma unroll
                    for (int m = 0; m < 4; ++m)
#pragma unroll
                        for (int n = 0; n < 2; ++n) acc[a][b][m][n] = acc[a][b][m][n] * 0.5f; }
#endif
        if (G == G_FFN) { e.ffn_epi(acc, u, wr, wc, fr, fq); return; }
        if (G == G_RES && u.di == D_M) { e.res_epi(acc, u, wr, wc, fr, fq); return; }
        { int t_ = e.hw_tid(); const int lane_ = t_ & 63, wid_ = __builtin_amdgcn_readfirstlane(t_ >> 6); fr = lane_ & 15; fq = lane_ >> 4; wr = wid_ >> 2; wc = wid_ & 3; }
        unsigned char* ws = e.ws;
        const int di = u.di, row0 = u.r0 + wr * 64 + fr, col0 = u.pn * 256 + wc * 32 + fq * 4, colp = u.pn * 256 + wc * 32 + PCOL(fq);
        if (G == G_RES) {
            unsigned char* base = ws + WS_SLAB + (size_t)u.aux * TS * DM * 2; const unsigned off0 = (unsigned)((row0 - TP) * DM + colp) * 2u;
            EPI_EACH3 st_pair(base + (off0 + (unsigned)(((size_t)(128 * ai + 16 * m) * DM + 128 * bj) * 2)), pkh(acc[ai][bj][m][0]), pkh(acc[ai][bj][m][1]));
        }
        else if (G == G_DOWN) {
            const float* R2 = (const float*)(ws + WS_R2); float rs[2][4];
#pragma unroll
            for (int ai = 0; ai < 2; ++ai)
#pragma unroll
                for (int m = 0; m < 4; ++m) { const int r_ = row0 + 128 * ai + 16 * m; rs[ai][m] = R2[r_ < T ? r_ : T - 1]; }
            unsigned char* base = ws + WS_DOWN; const unsigned off0 = (unsigned)(row0 * NDOWNP + colp) * 2u;
            EPI_EACH3 st_pair(base + (off0 + (unsigned)(((size_t)(128 * ai + 16 * m) * NDOWNP + 128 * bj) * 2)), pkh(acc[ai][bj][m][0] * rs[ai][m]), pkh(acc[ai][bj][m][1] * rs[ai][m]));
        }
        else if (G == G_HG) {
            if (di == D_HGRN) {
                const int sec = u.pn >> 3, c0 = col0 & 2047; const unsigned eo = (unsigned)(row0 * DM + (colp & 2047));
                if (sec == 1) {
                    unsigned char* base = ws + WS_FG; const LAS float* lbp = (const LAS float*)(e.lds + 131072) + c0;
                    EPI_EACH3 { u32x2 wl[2];
#pragma unroll
                        for (int n = 0; n < 2; ++n) { const f32x4 l = *(const LAS f32x4*)(lbp + 128 * bj + 16 * n); const f32x4 v = acc[ai][bj][m][n]; f32x4 o;
                            for (int i = 0; i < 4; ++i) o[i] = __logf(l[i] + (1.f - l[i]) * sigmoidf_(v[i]));
                            wl[n] = pkh(o); }
                        st_pair(base + (eo * 2u + (unsigned)(((128 * ai + 16 * m) * DM + 128 * bj) * 2)), wl[0], wl[1]); }
                } else {
                    unsigned char* base = ws + (sec == 0 ? WS_QB : WS_SG);
                    EPI_EACH3 { u32x2 wl[2];
#pragma unroll
                        for (int n = 0; n < 2; ++n) { const f32x4 v = acc[ai][bj][m][n]; f32x4 o; for (int i = 0; i < 4; ++i) o[i] = siluf_(v[i]); wl[n] = pkb(o); }
                        st_pair(base + (eo * 2u + (unsigned)(((128 * ai + 16 * m) * DM + 128 * bj) * 2)), wl[0], wl[1]); }
                }
            } else { plain_bf16<T>(acc, ws + WS_VT2 + (di == D_VT2S ? (size_t)TP * 2 : 0), (unsigned)(row0 * T + colp) * 2u); }
        }
        else {
            if (di == D_KN)      plain_bf16<2048>(acc, ws + WS_KN, (unsigned)(row0 * 2048 + colp) * 2u);
            else if (di == D_VT) plain_bf16<KVROWS>(acc, ws + WS_VT, (unsigned)(row0 * KVROWS + colp) * 2u);
            else {
                const int hc0 = (u.pn * 256 + wc * 32) % QHD, hc1 = (u.pn * 256 + 128 + wc * 32) % QHD;
                const bool sample = u.r0 >= TP; const int prow0 = sample ? row0 - TP : row0;
                unsigned char* base = ws + WS_QA; const unsigned off0 = (unsigned)(row0 * 3072 + colp) * 2u;
                q_half<0>(acc, base, off0, prow0, sample, hc0, fq); q_half<1>(acc, base, off0, prow0, sample, hc1, fq);
            }
        }
    }
};
#undef EPI_EACH4
#undef EPI_EACH3


enum RowMap { RM_ID = 0, RM_UQ = 1, RM_UKV = 2, RM_HIN = 3, RM_FIN = 4 };
DI int map_row(int mode, int n) {
    if (mode == RM_UQ) { const int h = n / QHD, j = n % QHD; if (j < NOPE) return n; const int i = j - NOPE; return h * QHD + NOPE + (i < 32 ? 2 * i : 2 * (i - 32) + 1); }
    if (mode == RM_FIN) { const int j = n < FF ? n : n - FF; return 256 * (j >> 7) + (n < FF ? 0 : 128) + (j & 127); }
    if (mode == RM_HIN) { return n < 4096 ? n : (n < 6144 ? n + 2048 : n - 2048); }
    if (mode == RM_UKV) { const int h = n >> 8, j = n & 255; return (j < 128 ? 0 : 2048) + h * 128 + (j & 127); }
    return n;
}
DI void transpose_item(const float* W, int K, int N, bf16_t* WT, int mode, LAS float* scr, int item, int lane, const float* sk) {
    const int nblk = N / 32, kb = item / nblk, nb = item % nblk, k0 = 64 * kb, n0 = 32 * nb;
    float tv[32];
    { const float* wp = W + (size_t)(k0 + (lane >> 5)) * N + n0 + (lane & 31);
#pragma unroll
      for (int i = 0; i < 32; ++i) tv[i] = __builtin_nontemporal_load(wp + (size_t)(2 * i) * N); }
#pragma unroll
    for (int i = 0; i < 32; ++i) scr[(2 * i + (lane >> 5)) * 33 + (lane & 31)] = tv[i];
    asm volatile("s_waitcnt lgkmcnt(0)" ::: "memory");
    const int c = lane & 7;
    f32x4 ka = (f32x4){1.f, 1.f, 1.f, 1.f}, kc = ka;
    if (sk) { ka = *(const f32x4*)(sk + k0 + 8 * c); kc = *(const f32x4*)(sk + k0 + 8 * c + 4); }
#pragma unroll
    for (int j = 0; j < 4; ++j) { const int n = (lane >> 3) + 8 * j; const LAS float* s = scr + (8 * c) * 33 + n;
        u32x4 o; o.x = pk2(s[0 * 33] * ka[0], s[1 * 33] * ka[1]); o.y = pk2(s[2 * 33] * ka[2], s[3 * 33] * ka[3]); o.z = pk2(s[4 * 33] * kc[0], s[5 * 33] * kc[1]); o.w = pk2(s[6 * 33] * kc[2], s[7 * 33] * kc[3]);
        *(u32x4*)(WT + (size_t)map_row(mode, n0 + n) * K + k0 + 8 * c) = o; }
    asm volatile("s_waitcnt lgkmcnt(0)" ::: "memory");
}
DI const float* xrow_ptr(const Frame& F, int row) { return row < TP ? as_global(F.in[0 + F.z]) + (size_t)row * DM : as_global(F.in[1 + F.z]) + (size_t)(row - TP) * DM; }

DI void norm_row_bf16(const float* xr, const float* w, bf16_t* hr, int lane) {
    f32x4 v[8]; float s = 0.f;
#pragma unroll
    for (int j = 0; j < 8; ++j) { v[j] = *(const f32x4*)(xr + 4 * lane + 256 * j); s += (v[j][0] * v[j][0] + v[j][1] * v[j][1]) + (v[j][2] * v[j][2] + v[j][3] * v[j][3]); }
    const float r = __builtin_amdgcn_rsqf(wave_sum(s) * (1.f / DM) + EPS);
#pragma unroll
    for (int j = 0; j < 8; ++j) { const f32x4 ww = *(const f32x4*)(w + 4 * lane + 256 * j); u32x2 o; o.x = pk2(v[j][0] * r * ww[0], v[j][1] * r * ww[1]); o.y = pk2(v[j][2] * r * ww[2], v[j][3] * r * ww[3]);
        *(u32x2*)(hr + 4 * lane + 256 * j) = o; }
}

constexpr int I_HIN = 32 * 256, I_HOUT = 32 * 64, I_DOWN = 32 * 34, I_UQ = 8 * 96, I_UKV = 8 * 128, I_MOUT = 32 * 64, I_FIN = 32 * 352, I_FOUT = 88 * 64;
constexpr int CONV_NITEMS = I_HIN + I_HOUT + I_DOWN + I_UQ + I_UKV + I_MOUT + 2 * I_FIN + 2 * I_FOUT;
DI void convert_items(const Frame& F, int it0, int it1, int gw, int NGW) {
    LAS float* scr = (LAS float*)(F.lds + F.wave * 16384);
    unsigned char* ws = F.ws;
    for (int it = it0 + gw; it < it1; it += NGW) {
        int r = it; const float* W; bf16_t* WT; int K, N, mode = RM_ID; const float* sk = nullptr; const float* nw = as_global(F.in[6 + F.z]);
        if (r < I_HIN) { W = as_global(F.in[8 + F.z]); K = 2048; N = 8192; WT = (bf16_t*)(ws + WS_WT_HIN); mode = RM_HIN; }
        else if ((r -= I_HIN) < I_HOUT) { W = as_global(F.in[10 + F.z]); K = 2048; N = 2048; WT = (bf16_t*)(ws + WS_WT_HOUT); }
        else if ((r -= I_HOUT) < I_DOWN) { W = as_global(F.in[11 + F.z]); K = 2048; N = NDOWN; WT = (bf16_t*)(ws + WS_WT_DOWN); sk = nw + 4 * DM; }
        else if ((r -= I_DOWN) < I_UQ) { W = as_global(F.in[14 + F.z]); K = 512; N = 3072; WT = (bf16_t*)(ws + WS_WT_UQ); mode = RM_UQ; }
        else if ((r -= I_UQ) < I_UKV) { W = as_global(F.in[15 + F.z]); K = 512; N = 4096; WT = (bf16_t*)(ws + WS_WT_K); mode = RM_UKV; }
        else if ((r -= I_UKV) < I_MOUT) { W = as_global(F.in[16 + F.z]); K = 2048; N = 2048; WT = (bf16_t*)(ws + WS_WT_MOUT); }
        else if ((r -= I_MOUT) < 2 * I_FIN) { const int l = r / I_FIN; r -= l * I_FIN; W = as_global(F.in[17 + F.z]) + (size_t)l * 2048 * FF2; K = 2048; N = FF2; WT = (bf16_t*)(ws + WS_WT_FIN) + (size_t)l * FF2 * 2048; mode = RM_FIN; sk = nw + (l == 0 ? 2 : 6) * DM; }
        else { r -= 2 * I_FIN; const int l = r / I_FOUT; r -= l * I_FOUT; W = as_global(F.in[20 + F.z]) + (size_t)l * FF * 2048; K = FF; N = 2048; WT = (bf16_t*)(ws + WS_WT_FOUT) + (size_t)l * 2048 * FF; }
        transpose_item(W, K, N, WT, mode, scr, r, F.lane, sk);
    }
}
DI void convert_items_pipelined(const Frame& F, int it0, int it1, int gw, int NGW) {
    LAS float* scr = (LAS float*)(F.lds + F.wave * 16384);
    const float* W = as_global(F.in[8 + F.z]); bf16_t* WT = (bf16_t*)(F.ws + WS_WT_HIN);
    constexpr int K = 2048, N = 8192, nblk = N / 32;
    int it = it0 + gw; if (it >= it1) return;
    const int lane = F.lane; float tv[32];
    { const int k0 = 64 * (it / nblk), n0 = 32 * (it % nblk); const float* wp = W + (size_t)(k0 + (lane >> 5)) * N + n0 + (lane & 31);
#pragma unroll
      for (int i = 0; i < 32; ++i) tv[i] = __builtin_nontemporal_load(wp + (size_t)(2 * i) * N); }
    for (;;) {
        const int itn = it + NGW; const bool more = itn < it1; float tn[32];
        if (more) { const int k0 = 64 * (itn / nblk), n0 = 32 * (itn % nblk); const float* wp = W + (size_t)(k0 + (lane >> 5)) * N + n0 + (lane & 31);
#pragma unroll
            for (int i = 0; i < 32; ++i) tn[i] = __builtin_nontemporal_load(wp + (size_t)(2 * i) * N); }
        { const int k0 = 64 * (it / nblk), n0 = 32 * (it % nblk);
#pragma unroll
          for (int i = 0; i < 32; ++i) scr[(2 * i + (lane >> 5)) * 33 + (lane & 31)] = tv[i];
          asm volatile("s_waitcnt lgkmcnt(0)" ::: "memory");
          const int c = lane & 7;
#pragma unroll
          for (int j = 0; j < 4; ++j) { const int n = (lane >> 3) + 8 * j; const LAS float* p = scr + (8 * c) * 33 + n;
              u32x4 o; o.x = pk2(p[0 * 33], p[1 * 33]); o.y = pk2(p[2 * 33], p[3 * 33]); o.z = pk2(p[4 * 33], p[5 * 33]); o.w = pk2(p[6 * 33], p[7 * 33]);
              *(u32x4*)(WT + (size_t)map_row(RM_HIN, n0 + n) * K + k0 + 8 * c) = o; }
          asm volatile("s_waitcnt lgkmcnt(0)" ::: "memory"); }
        if (!more) break;
        it = itn;
#pragma unroll
        for (int i = 0; i < 32; ++i) tv[i] = tn[i];
    }
}
DI void phase_prep(const Frame& F) {
    const int gw = F.bid * NWAVES + F.wave, NGW = F.G * NWAVES;
    unsigned char* ws = F.ws;
    convert_items_pipelined(F, 0, I_HIN, gw, NGW);
    unsigned zz = 0u; asm volatile("" : "+v"(zz)); const u32x4 zero4 = {zz, zz, zz, zz};
    if (gw == 0) { u32x4* hp = (u32x4*)(ws + WS_HPAD); for (int i = F.lane; i < 2 * DM * 2 / 16; i += 64) hp[i] = zero4; }
    { const int gt = F.bid * NTHREADS + F.tid, NGT = F.G * NTHREADS; u32x4* p = (u32x4*)((bf16_t*)(ws + WS_WT_DOWN) + (size_t)NDOWN * 2048);
      for (int i = gt; i < (NDOWNP - NDOWN) * 256; i += NGT) p[i] = zero4; }
    { const int gt = F.bid * NTHREADS + F.tid, NGT = F.G * NTHREADS; float* tab = (float*)(ws + WS_TAB);
      for (int i = gt; i < 2048 * 32; i += NGT) { const int pos = i >> 5, k = i & 31;
          double inv = 1.0;
          for (int q = 0; q < k; ++q) inv *= 0.7498942093324559;
          const double rev = (double)pos * inv * 0.15915494309189535; const float fr = (float)(rev - floor(rev));
          tab[2 * i] = __builtin_amdgcn_cosf(fr); tab[2 * i + 1] = __builtin_amdgcn_sinf(fr); }
      float* lb = (float*)(ws + WS_LB); const float* lg = as_global(F.in[7 + F.z]);
      for (int i = gt; i < 2048; i += NGT) { const float a = lg[i], b = lg[2048 + i], c = lg[4096 + i]; const float mx = fmaxf(a, fmaxf(b, c));
          const float ea = fexp(a - mx), eb = fexp(b - mx), ec = fexp(c - mx); lb[i] = ea / (ea + eb + ec); } }
    { const float* nw0 = as_global(F.in[6 + F.z]); const int lane = F.lane;
      int m = gw; f32x4 v[8];
      if (m < T) { const float* xr = xrow_ptr(F, m);
#pragma unroll
          for (int j = 0; j < 8; ++j) v[j] = __builtin_nontemporal_load((const f32x4*)(xr + 4 * lane + 256 * j)); }
      while (m < T) {
          const int mn = m + NGW; f32x4 vn[8];
          if (mn < T) { const float* xr = xrow_ptr(F, mn);
#pragma unroll
              for (int j = 0; j < 8; ++j) vn[j] = __builtin_nontemporal_load((const f32x4*)(xr + 4 * lane + 256 * j)); }
          float sq = 0.f;
#pragma unroll
          for (int j = 0; j < 8; ++j) sq += (v[j][0] * v[j][0] + v[j][1] * v[j][1]) + (v[j][2] * v[j][2] + v[j][3] * v[j][3]);
          const float rr = __builtin_amdgcn_rsqf(wave_sum(sq) * (1.f / DM) + EPS);
          bf16_t* hr = (bf16_t*)(ws + WS_H) + (size_t)m * DM;
#pragma unroll
          for (int j = 0; j < 8; ++j) { const f32x4 ww = *(const f32x4*)(nw0 + 4 * lane + 256 * j); u32x2 o; o.x = pk2(v[j][0] * rr * ww[0], v[j][1] * rr * ww[1]); o.y = pk2(v[j][2] * rr * ww[2], v[j][3] * rr * ww[3]);
              *(u32x2*)(hr + 4 * lane + 256 * j) = o; }
          m = mn;
#pragma unroll
          for (int j = 0; j < 8; ++j) v[j] = vn[j];
      } }
}

#define MFMA32(a, b, c) __builtin_amdgcn_mfma_f32_32x32x16_bf16((a), (b), (c), 0, 0, 0)
DI int crow16(int reg, int hf) { return (reg & 3) + 8 * (reg >> 2) + 4 * hf; }
DI bf16x8 pack_half(const f32x16& x, int ks) {
    u32x4 w; w.x = pk2(x[8 * ks], x[8 * ks + 1]); w.y = pk2(x[8 * ks + 2], x[8 * ks + 3]); w.z = pk2(x[8 * ks + 4], x[8 * ks + 5]); w.w = pk2(x[8 * ks + 6], x[8 * ks + 7]); return __builtin_bit_cast(bf16x8, w);
}
DI void phase_scan(const Frame& F) {
    constexpr int PQ = 272, PK2 = 144;
    constexpr int L_QT = 0, L_KT = 64 * PQ, L_Q2 = 2 * 64 * PQ, L_K2T = 3 * 64 * PQ, L_P = L_K2T + 128 * PK2, L_DEC = L_P + 8 * 128 * 4, L_OB = L_DEC + 512;
    constexpr int OBP = 68;
    static_assert(L_OB + 2 * 128 * OBP * 4 + 512 <= MISC_OFF, "scan LDS map");
    LAS unsigned char* lds = F.lds;
    LAS float* P = (LAS float*)(lds + L_P); LAS float* DEC = (LAS float*)(lds + L_DEC); LAS float* OB = (LAS float*)(lds + L_OB);
    const bf16_t* Qb = (const bf16_t*)(F.ws + WS_QB); const _Float16* FG = (const _Float16*)(F.ws + WS_FG); const bf16_t* VT2 = (const bf16_t*)(F.ws + WS_VT2);
    const bf16_t* SG = (const bf16_t*)(F.ws + WS_SG); bf16_t* OG = (bf16_t*)(F.ws + WS_OG); const float* gnw = as_global(F.in[9 + F.z]);
    const int lane = F.lane, w = F.wave, r = lane & 31, hf = lane >> 5, dvb = w & 3, half = w >> 2;
    const bool late_sample = F.G == 256;
    if (late_sample && F.bid >= 64 && F.bid < 192) convert_items(F, I_HIN, CONV_NITEMS, (F.bid - 64) * NWAVES + F.wave, 192 * NWAVES);
    if (late_sample && F.bid >= 64 && F.bid < 192) {
        if (F.wave == 0) { unsigned sp = 0; unsigned* cnt = (unsigned*)(F.ws + WS_CTL + 32768);
            while ((unsigned)__builtin_amdgcn_readfirstlane(__hip_atomic_load(cnt, __ATOMIC_RELAXED, __HIP_MEMORY_SCOPE_AGENT)) < 64u) { __builtin_amdgcn_s_sleep(32); if (++sp > (1u << 18)) break; }
            __builtin_amdgcn_fence(__ATOMIC_ACQUIRE, "agent"); asm volatile("s_waitcnt vmcnt(0)" ::: "memory"); }
        __syncthreads();
    }
    for (int item = F.bid; item < 192; item += F.G) {
        int s, h, L, row0;
        if (item < 64) { s = item >> 4; h = item & 15; L = SEQ; row0 = s * SEQ; }
        else { const int it = item - 64; s = 4 + (it >> 4); h = it & 15; L = DS; row0 = TP + (s - 4) * DS; }
        const int nch = (L + 63) >> 6;
        f32x16 St[2];
        if (s < 4) {
#pragma unroll
            for (int d = 0; d < 2; ++d)
#pragma unroll
                for (int i = 0; i < 16; ++i) St[d][i] = 0.f;
        } else {
            int sb = (64 * half + 4 * hf) * DV + dvb * 32 + r; asm volatile("" : "+v"(sb));
            const float* st = as_global(F.in[2 + F.z]) + (size_t)((s - 4) * HH + h) * DK * DV + sb;
#pragma unroll
            for (int d = 0; d < 2; ++d)
#pragma unroll
                for (int i = 0; i < 16; ++i) St[d][i] = st[(32 * d + (i & 3) + 8 * (i >> 2)) * DV];
        }
        const int vrow = (h * DV + dvb * 32 + r) * T + row0;
        LAS float* GW = (LAS float*)(lds + L_OB + 2 * 128 * OBP * 4);
        if (F.tid < 128) GW[F.tid] = gnw[F.tid];
        unsigned fgN[8], qN[8], sgN[8]; u32x4 vnN[4]; u32x2 vkN[2][2];
#define SCAN_LOAD_A(CH) do { const int t0_ = (CH) * 64, nv_ = (L - t0_) < 64 ? (L - t0_) : 64; \
            int rb_ = (row0 + t0_) * DM + h * DK + 2 * lane; asm volatile("" : "+v"(rb_)); \
            _Pragma("unroll") for (int i = 0; i < 8; ++i) { const int ti = 8 * w + i, tl = ti < nv_ ? ti : nv_ - 1; \
                fgN[i] = *(const unsigned*)(FG + rb_ + tl * DM); qN[i] = *(const unsigned*)(Qb + rb_ + tl * DM); } } while (0)
#define SCAN_LOAD_V(CH) do { const int t0_ = (CH) * 64, nv_ = (L - t0_) < 64 ? (L - t0_) : 64; int vo_ = vrow + t0_; asm volatile("" : "+v"(vo_));   \
            _Pragma("unroll") for (int ks = 0; ks < 4; ++ks) { const int c_ = 16 * ks < nv_ ? 16 * ks : 0; vnN[ks] = *(const u32x4*)(VT2 + (vo_ + c_ + 8 * hf)); } \
            _Pragma("unroll") for (int k2 = 0; k2 < 2; ++k2) { const int c_ = (32 * half < nv_ ? 32 * half : 0) + 16 * k2 + 4 * hf; \
                vkN[k2][0] = *(const u32x2*)(VT2 + (vo_ + c_)); vkN[k2][1] = *(const u32x2*)(VT2 + (vo_ + c_ + 8)); } } while (0)
#define SCAN_LOAD_G(CH) do { const int t0_ = (CH) * 64, nv_ = (L - t0_) < 64 ? (L - t0_) : 64; \
            int rb_ = (row0 + t0_) * DM + h * DK + 2 * lane; asm volatile("" : "+v"(rb_)); \
            _Pragma("unroll") for (int i = 0; i < 8; ++i) { const int ti = 8 * w + i, tl = ti < nv_ ? ti : nv_ - 1; sgN[i] = *(const unsigned*)(SG + rb_ + tl * DM); } } while (0)
        SCAN_LOAD_A(0); SCAN_LOAD_V(0); SCAN_LOAD_G(0);
        for (int ch = 0; ch < nch; ++ch) {
            const int t0 = ch * 64, nvalid = (L - t0) < 64 ? (L - t0) : 64;
            int rbase = (row0 + t0 + 8 * w) * DM + h * DK + 2 * lane; asm volatile("" : "+v"(rbase));
            float fgv[8][2], qv[8][2];
            if (nvalid == 64) {
#pragma unroll
                for (int i = 0; i < 8; ++i) { const h16x2 lp = __builtin_bit_cast(h16x2, fgN[i]); fgv[i][0] = (float)lp.x; fgv[i][1] = (float)lp.y; qv[i][0] = __uint_as_float(qN[i] << 16); qv[i][1] = __uint_as_float(qN[i] & 0xffff0000u); }
            } else {
#pragma unroll
                for (int i = 0; i < 8; ++i) { const bool ok = (8 * w + i) < nvalid;
                    const h16x2 lp = __builtin_bit_cast(h16x2, fgN[i]); fgv[i][0] = ok ? (float)lp.x : 0.f; fgv[i][1] = ok ? (float)lp.y : 0.f;
                    qv[i][0] = ok ? __uint_as_float(qN[i] << 16) : 0.f; qv[i][1] = ok ? __uint_as_float(qN[i] & 0xffff0000u) : 0.f; }
            }
            float cum[8][2]; float run0 = 0.f, run1 = 0.f;
#pragma unroll
            for (int i = 0; i < 8; ++i) { run0 += fgv[i][0]; run1 += fgv[i][1]; cum[i][0] = run0; cum[i][1] = run1; }
            *(LAS f32x2*)(P + w * 128 + 2 * lane) = (f32x2){run0, run1};
            __syncthreads();
            float pre0 = 0.f, pre1 = 0.f, ref0 = 0.f, ref1 = 0.f, bl0 = 0.f, bl1 = 0.f;
#pragma unroll
            for (int q = 0; q < 8; ++q) { const f32x2 p = *(const LAS f32x2*)(P + q * 128 + 2 * lane); if (q < w) { pre0 += p[0]; pre1 += p[1]; } if (q < 4) { ref0 += p[0]; ref1 += p[1]; } bl0 += p[0]; bl1 += p[1]; }
            const float er0 = fexp(ref0), er1 = fexp(ref1), c20 = fexp(bl0 - ref0), c21 = fexp(bl1 - ref1);
            if (w == 0) *(LAS f32x2*)(DEC + 2 * lane) = (f32x2){fexp(bl0), fexp(bl1)};
            float k2c[2][8];
#pragma unroll
            for (int i = 0; i < 8; ++i) { const int t = 8 * w + i;
                const float e0 = fexp(pre0 + cum[i][0] - ref0), e1 = fexp(pre1 + cum[i][1] - ref1);
                const float qt0 = qv[i][0] * e0, qt1 = qv[i][1] * e1;
                const float kt0 = (1.f - fexp(fgv[i][0])) * __builtin_amdgcn_rcpf(e0), kt1 = (1.f - fexp(fgv[i][1])) * __builtin_amdgcn_rcpf(e1);
                *(LAS unsigned*)(lds + L_QT + t * PQ + 4 * lane) = pk2(qt0, qt1);
                *(LAS unsigned*)(lds + L_KT + t * PQ + 4 * lane) = pk2(kt0, kt1);
                *(LAS unsigned*)(lds + L_Q2 + t * PQ + 4 * lane) = pk2(qt0 * er0, qt1 * er1);
                k2c[0][i] = kt0 * c20; k2c[1][i] = kt1 * c21; }
#pragma unroll
            for (int c = 0; c < 2; ++c) { u32x4 o; o.x = pk2(k2c[c][0], k2c[c][1]); o.y = pk2(k2c[c][2], k2c[c][3]); o.z = pk2(k2c[c][4], k2c[c][5]); o.w = pk2(k2c[c][6], k2c[c][7]);
                *(LAS u32x4*)(lds + L_K2T + (2 * lane + c) * PK2 + 16 * w) = o; }
            __syncthreads();
            if (ch + 1 < nch) SCAN_LOAD_A(ch + 1);
            u32x4 vn[4]; u32x2 vk[2][2];
#pragma unroll
            for (int ks = 0; ks < 4; ++ks) { const bool ok = 16 * ks < nvalid; vn[ks] = ok ? vnN[ks] : (u32x4){0u, 0u, 0u, 0u}; }
#pragma unroll
            for (int k2 = 0; k2 < 2; ++k2) { const bool ok = 32 * half < nvalid; vk[k2][0] = ok ? vkN[k2][0] : (u32x2){0u, 0u}; vk[k2][1] = ok ? vkN[k2][1] : (u32x2){0u, 0u}; }
            if (ch + 1 < nch) SCAN_LOAD_V(ch + 1);
            f32x16 O[2];
#pragma unroll
            for (int d = 0; d < 2; ++d)
#pragma unroll
                for (int i = 0; i < 16; ++i) O[d][i] = 0.f;
            const bool live = (32 * half) < nvalid;
            if (live) {
#pragma unroll
                for (int tb = 0; tb < 2; ++tb) {
                    if (tb == 0 && half == 1) continue;
                    f32x16 X;
#pragma unroll
                    for (int i = 0; i < 16; ++i) X[i] = 0.f;
#pragma unroll
                    for (int ks = 0; ks < 8; ++ks) X = MFMA32(*(const LAS bf16x8*)(lds + L_KT + (32 * half + r) * PQ + 32 * ks + 16 * hf), *(const LAS bf16x8*)(lds + L_QT + (32 * tb + r) * PQ + 32 * ks + 16 * hf), X);
                    if (tb == half) {
#pragma unroll
                        for (int i = 0; i < 16; ++i) X[i] = (crow16(i, hf) <= r) ? X[i] : 0.f;
                    }
#pragma unroll
                    for (int k2 = 0; k2 < 2; ++k2) { const u32x4 vb = {vk[k2][0].x, vk[k2][0].y, vk[k2][1].x, vk[k2][1].y};
                        O[tb] = MFMA32(pack_half(X, k2), __builtin_bit_cast(bf16x8, vb), O[tb]); }
                }
            }
#pragma unroll
            for (int d = 0; d < 2; ++d)
#pragma unroll
                for (int k2 = 0; k2 < 2; ++k2) { const bf16x8 sb = pack_half(St[d], k2);
#pragma unroll
                    for (int tb = 0; tb < 2; ++tb) { const LAS unsigned char* qp = lds + L_Q2 + (32 * tb + r) * PQ + 2 * (64 * half + 32 * d + 16 * k2 + 4 * hf);
                        const u32x2 lo = *(const LAS u32x2*)qp, hi = *(const LAS u32x2*)(qp + 16); const u32x4 qa = {lo.x, lo.y, hi.x, hi.y};
                        O[tb] = MFMA32(__builtin_bit_cast(bf16x8, qa), sb, O[tb]); } }
#pragma unroll
            for (int tb = 0; tb < 2; ++tb)
#pragma unroll
                for (int g = 0; g < 4; ++g) *(LAS f32x4*)(OB + (half * 128 + dvb * 32 + r) * OBP + 32 * tb + 8 * g + 4 * hf) = (f32x4){O[tb][4 * g], O[tb][4 * g + 1], O[tb][4 * g + 2], O[tb][4 * g + 3]};
#pragma unroll
            for (int d = 0; d < 2; ++d) {
#pragma unroll
                for (int g = 0; g < 4; ++g) { const f32x4 dc = *(const LAS f32x4*)(DEC + 64 * half + 32 * d + 8 * g + 4 * hf);
#pragma unroll
                    for (int j = 0; j < 4; ++j) St[d][4 * g + j] *= dc[j]; }
#pragma unroll
                for (int ks = 0; ks < 4; ++ks) if (16 * ks < nvalid || nvalid == 64)
                    St[d] = MFMA32(*(const LAS bf16x8*)(lds + L_K2T + (64 * half + 32 * d + r) * PK2 + 32 * ks + 16 * hf), __builtin_bit_cast(bf16x8, vn[ks]), St[d]);
            }
            __syncthreads();
            { float o0[8], o1[8], q[8];
#pragma unroll
              for (int gq = 0; gq < 2; ++gq) {
                  const f32x4 a0 = *(const LAS f32x4*)(OB + (2 * lane) * OBP + 8 * w + 4 * gq), a1 = *(const LAS f32x4*)(OB + (2 * lane + 1) * OBP + 8 * w + 4 * gq);
                  const f32x4 b0 = *(const LAS f32x4*)(OB + (128 + 2 * lane) * OBP + 8 * w + 4 * gq), b1 = *(const LAS f32x4*)(OB + (128 + 2 * lane + 1) * OBP + 8 * w + 4 * gq);
#pragma unroll
                  for (int j = 0; j < 4; ++j) { const int i = 4 * gq + j; o0[i] = a0[j] + b0[j]; o1[i] = a1[j] + b1[j]; q[i] = o0[i] * o0[i] + o1[i] * o1[i]; } }
              float h4[4], h2[2], h1;
#pragma unroll
              for (int j = 0; j < 4; ++j) { const float keep = (lane & 1) ? q[2 * j + 1] : q[2 * j], send = (lane & 1) ? q[2 * j] : q[2 * j + 1]; h4[j] = keep + xor_lane<1>(send); }
#pragma unroll
              for (int j = 0; j < 2; ++j) { const float keep = (lane & 2) ? h4[2 * j + 1] : h4[2 * j], send = (lane & 2) ? h4[2 * j] : h4[2 * j + 1]; h2[j] = keep + xor_lane<2>(send); }
              { const float keep = (lane & 4) ? h2[1] : h2[0], send = (lane & 4) ? h2[0] : h2[1]; h1 = keep + xor_lane<4>(send); }
              h1 += xor_lane<8>(h1); h1 += xor_lane<16>(h1); h1 = sum_xor32(h1);
              const float rr_l = __builtin_amdgcn_rsqf(h1 * (1.f / DV) + EPS);
              const f32x2 gwv = *(const LAS f32x2*)(GW + 2 * lane); const float gw0 = gwv.x, gw1 = gwv.y;
#pragma unroll
              for (int i = 0; i < 8; ++i) { const int t = 8 * w + i;
                  const float rr = __int_as_float(__builtin_amdgcn_readlane(__float_as_int(rr_l), i));
                  if (t < nvalid) *(unsigned*)(OG + rbase + i * DM) = pk2(o0[i] * rr * gw0 * __uint_as_float(sgN[i] << 16), o1[i] * rr * gw1 * __uint_as_float(sgN[i] & 0xffff0000u)); } }
            if (ch + 1 < nch) SCAN_LOAD_G(ch + 1);
        }
        { int sb = (64 * half + 4 * hf) * DV + dvb * 32 + r; asm volatile("" : "+v"(sb));
          float* so = F.out + O_HG + (size_t)(s * HH + h) * DK * DV + sb;
#pragma unroll
          for (int d = 0; d < 2; ++d)
#pragma unroll
              for (int i = 0; i < 16; ++i) so[(32 * d + (i & 3) + 8 * (i >> 2)) * DV] = St[d][i]; }
    }
    if (!late_sample) {
        const int cb0 = F.G > 64 ? 64 : 0;
        if (F.bid >= cb0) { __syncthreads(); const Frame F3 = with_ids(F); convert_items(F3, I_HIN, CONV_NITEMS, (F3.bid - cb0) * NWAVES + F3.wave, (F3.G - cb0) * NWAVES); }
    }
}
DI void scan_late_tail(const Frame& F) {
    asm volatile("s_waitcnt vmcnt(0)" ::: "memory"); __syncthreads();
    const Frame F2 = with_ids(F);
    if (F2.tid == 0) { __builtin_amdgcn_fence(__ATOMIC_RELEASE, "agent"); asm volatile("s_waitcnt vmcnt(0)" ::: "memory");
        __hip_atomic_fetch_add((unsigned*)(F2.ws + WS_CTL + 32768), 1u, __ATOMIC_RELAXED, __HIP_MEMORY_SCOPE_AGENT); }
    __syncthreads();
    convert_items(F2, I_HIN, CONV_NITEMS, (F2.bid - 64) * NWAVES + F2.wave, 192 * NWAVES);
}

typedef _Float16 h16x4 __attribute__((ext_vector_type(4)));
DI f32x4 ld_h4(const _Float16* p) { const h16x4 h = *(const h16x4*)p; return (f32x4){(float)h[0], (float)h[1], (float)h[2], (float)h[3]}; }
DI void phase_rowpass(const Frame& F, int which) {
    const float* nw = as_global(F.in[6 + F.z]);
    const float* wa = nw + (which == 0 ? 1 : which == 1 ? 3 : which == 2 ? 5 : 7) * DM;
    const float* wb = which == 3 ? nullptr : nw + (which == 0 ? 2 : which == 1 ? 4 : 6) * DM;
    const int lane = F.lane, w = F.wave;
    { LAS float* red = (LAS float*)F.lds;
      const int nsl = (which & 1) ? KS_5632 : KS_2048; const int c = 256 * w + 4 * lane;
      for (int sr = F.bid; sr < TS; sr += F.G) {
          const int m = TP + sr;
          const _Float16* sl = (const _Float16*)(F.ws + WS_SLAB) + (size_t)sr * DM + c;
          f32x4 v = (f32x4){0.f, 0.f, 0.f, 0.f};
          if (which & 1) {
#pragma unroll
              for (int q = 0; q < KS_5632; ++q) v += ld_h4(sl + (size_t)q * TS * DM);
          } else {
#pragma unroll
              for (int q = 0; q < KS_2048; ++q) v += ld_h4(sl + (size_t)q * TS * DM);
          }
          (void)nsl;
          bf16_t* X16 = (bf16_t*)(F.ws + WS_X) + (size_t)m * DM;
          f32x4 xi;
          if (which == 0) xi = *(const f32x4*)(as_global(F.in[1 + F.z]) + (size_t)sr * DM + c);
          else { const u32x2 p = *(const u32x2*)(X16 + c); xi = (f32x4){__uint_as_float(p.x << 16), __uint_as_float(p.x & 0xffff0000u), __uint_as_float(p.y << 16), __uint_as_float(p.y & 0xffff0000u)}; }
          const f32x4 ww = *(const f32x4*)(wa + c);
          const float s1 = wave_sum((v[0] * v[0] + v[1] * v[1]) + (v[2] * v[2] + v[3] * v[3]));
          __syncthreads();
          if (lane == 0) red[w] = s1;
          __syncthreads();
          float t1 = 0.f;
#pragma unroll
          for (int q = 0; q < 8; ++q) t1 += red[q];
          const float r1 = __builtin_amdgcn_rsqf(t1 * (1.f / DM) + EPS);
          const f32x4 x1 = xi + v * r1 * ww;
          if (which == 3) *(f32x4*)(F.out + O_Y + (size_t)m * DM + c) = x1;
          else { u32x2 o; o.x = pk2(x1[0], x1[1]); o.y = pk2(x1[2], x1[3]); *(u32x2*)(X16 + c) = o; }
          if (wb) {
              const float s2 = wave_sum((x1[0] * x1[0] + x1[1] * x1[1]) + (x1[2] * x1[2] + x1[3] * x1[3]));
              if (lane == 0) red[8 + w] = s2;
              __syncthreads();
              float t2 = 0.f;
#pragma unroll
              for (int q = 0; q < 8; ++q) t2 += red[8 + q];
              const float r2 = __builtin_amdgcn_rsqf(t2 * (1.f / DM) + EPS);
              if (w == 0 && lane == 0) ((float*)(F.ws + WS_R2))[m] = r2;
          }
      }
    }
}

DI int kv_row_of(int row) { if (row < TP) return row; const int r = row - TP; return TP + (r >> 5) * KVSEQ + PAST + (r & 31); }
DI void phase_mlarow(const Frame& F) {
    const _Float16* DOWN = (const _Float16*)(F.ws + WS_DOWN); bf16_t* CQ = (bf16_t*)(F.ws + WS_CQ); bf16_t* CKVA = (bf16_t*)(F.ws + WS_CKVA); bf16_t* KPEA = (bf16_t*)(F.ws + WS_KPEA);
    const float* tab = (const float*)(F.ws + WS_TAB); const float* qw = as_global(F.in[12 + F.z]); const float* kw = as_global(F.in[13 + F.z]);
    const int lane = F.lane; const int gw = F.bid * NWAVES + F.wave, NGW = F.G * NWAVES;
    { int m = gw; f32x4 a[2], b[2]; float x1 = 0.f, x2 = 0.f;
#define MLA_LOAD(M, A_, B_, X1_, X2_) do { const _Float16* dr_ = DOWN + (size_t)(M) * NDOWNP; \
          _Pragma("unroll") for (int j = 0; j < 2; ++j) { A_[j] = ld_h4(dr_ + 4 * lane + 256 * j); B_[j] = ld_h4(dr_ + 512 + 4 * lane + 256 * j); } \
          X1_ = (float)dr_[1024 + (lane & 31)]; X2_ = (float)dr_[1024 + 32 + (lane & 31)]; } while (0)
      if (m < T) MLA_LOAD(m, a, b, x1, x2);
      while (m < T) {
          const int mn = m + NGW; f32x4 an[2], bn[2]; float x1n = 0.f, x2n = 0.f;
          if (mn < T) MLA_LOAD(mn, an, bn, x1n, x2n);
          const int kvr = kv_row_of(m); float sa = 0.f, sb = 0.f;
#pragma unroll
          for (int j = 0; j < 2; ++j) { sa += (a[j][0] * a[j][0] + a[j][1] * a[j][1]) + (a[j][2] * a[j][2] + a[j][3] * a[j][3]); sb += (b[j][0] * b[j][0] + b[j][1] * b[j][1]) + (b[j][2] * b[j][2] + b[j][3] * b[j][3]); }
          const float ra = __builtin_amdgcn_rsqf(wave_sum(sa) * (1.f / QL) + EPS), rb = __builtin_amdgcn_rsqf(wave_sum(sb) * (1.f / KVL) + EPS);
#pragma unroll
          for (int j = 0; j < 2; ++j) { const int c = 4 * lane + 256 * j; const f32x4 w1 = *(const f32x4*)(qw + c), w2 = *(const f32x4*)(kw + c);
              const f32x4 q = a[j] * ra * w1, kv = b[j] * rb * w2;
              u32x2 o; o.x = pk2(q[0], q[1]); o.y = pk2(q[2], q[3]); *(u32x2*)(CQ + (size_t)m * QL + c) = o;
              *(f32x4*)(F.out + O_CKV + (size_t)m * KVL + c) = kv;
              u32x2 o2; o2.x = pk2(kv[0], kv[1]); o2.y = pk2(kv[2], kv[3]); *(u32x2*)(CKVA + (size_t)kvr * KVL + c) = o2; }
          if (lane < 32) { const int pos = m < TP ? (m & (SEQ - 1)) : PAST + ((m - TP) & (DS - 1));
              const f32x2 cs = *(const f32x2*)(tab + ((size_t)pos * 32 + lane) * 2); const float o1 = x1 * cs[0] - x2 * cs[1], o2 = x2 * cs[0] + x1 * cs[1];
              F.out[O_KPE + (size_t)m * ROPE + lane] = o1; F.out[O_KPE + (size_t)m * ROPE + 32 + lane] = o2;
              *(unsigned*)(KPEA + (size_t)kvr * ROPE + 2 * lane) = pk2(o1, o2); }
          m = mn; a[0] = an[0]; a[1] = an[1]; b[0] = bn[0]; b[1] = bn[1]; x1 = x1n; x2 = x2n;
      }
#undef MLA_LOAD
    }
}

DI void convert_caches(const Frame& F, int gw, int NGW) {
    bf16_t* CKVA = (bf16_t*)(F.ws + WS_CKVA); bf16_t* KPEA = (bf16_t*)(F.ws + WS_KPEA); const int lane = F.lane;
    { const float* cckv = as_global(F.in[3 + F.z]); const float* ckpe = as_global(F.in[4 + F.z]);
      int i = gw; f32x4 v[2]; float x1 = 0.f, x2 = 0.f;
#define MLC_LOAD(I, V_, X1_, X2_) do { _Pragma("unroll") for (int j = 0; j < 2; ++j) V_[j] = __builtin_nontemporal_load((const f32x4*)(cckv + (size_t)(I) * KVL + 4 * lane + 256 * j)); \
          X1_ = ckpe[(size_t)(I) * ROPE + (lane & 31)]; X2_ = ckpe[(size_t)(I) * ROPE + 32 + (lane & 31)]; } while (0)
      if (i < DB * PAST) MLC_LOAD(i, v, x1, x2);
      while (i < DB * PAST) {
          const int in_ = i + NGW; f32x4 vn[2]; float x1n = 0.f, x2n = 0.f;
          if (in_ < DB * PAST) MLC_LOAD(in_, vn, x1n, x2n);
          const int b = i >> 10, p = i & (PAST - 1); const int kvr = TP + b * KVSEQ + p;
#pragma unroll
          for (int j = 0; j < 2; ++j) { const int c = 4 * lane + 256 * j; u32x2 o; o.x = pk2(v[j][0], v[j][1]); o.y = pk2(v[j][2], v[j][3]); *(u32x2*)(CKVA + (size_t)kvr * KVL + c) = o; }
          if (lane < 32) *(unsigned*)(KPEA + (size_t)kvr * ROPE + 2 * lane) = pk2(x1, x2);
          i = in_; v[0] = vn[0]; v[1] = vn[1]; x1 = x1n; x2 = x2n;
      }
#undef MLC_LOAD
    }
}

struct AttnState { f32x16 ot[4]; float mrun, lrun; };
DI void attn_softmax_pv_begin(f32x16& sc, AttnState& st, bf16x8 (&pf)[2]) {
    float mx = sc[0];
#pragma unroll
    for (int i = 1; i < 16; ++i) mx = fmaxf(mx, sc[i]);
    mx = max_xor32(mx);
    const float mnew = fmaxf(st.mrun, mx), alpha = __builtin_amdgcn_exp2f(st.mrun - mnew);
    float ps = 0.f;
#pragma unroll
    for (int i = 0; i < 16; ++i) { sc[i] = __builtin_amdgcn_exp2f(sc[i] - mnew); ps += sc[i]; }
    st.lrun = st.lrun * alpha + ps; st.mrun = mnew;
#pragma unroll
    for (int d = 0; d < 4; ++d)
#pragma unroll
        for (int i = 0; i < 16; ++i) st.ot[d][i] *= alpha;
    pf[0] = pack_half(sc, 0); pf[1] = pack_half(sc, 1);
}
constexpr int AK_PITCH = 400, AV_PITCH = 136, A_VOFF = 64 * AK_PITCH, A_BUF = A_VOFF + 128 * AV_PITCH;
static_assert(2 * A_BUF <= 131072, "attention LDS map");
DI void attn_prompt_unit(const Frame& F, int s, int h, int qb8) {
    const bf16_t* QA = (const bf16_t*)(F.ws + WS_QA); const bf16_t* KN = (const bf16_t*)(F.ws + WS_KN); const bf16_t* KPEA = (const bf16_t*)(F.ws + WS_KPEA); const bf16_t* VT = (const bf16_t*)(F.ws + WS_VT);
    bf16_t* AO = (bf16_t*)(F.ws + WS_AO);
    LAS unsigned char* lds = F.lds;
    const int tid = F.tid, lane = F.lane, w = F.wave, r = lane & 31, hf = lane >> 5;
    const int kvbase = s * SEQ, qrow0 = s * SEQ + 256 * qb8 + 32 * w, nT = 4 * (qb8 + 1), my_last = 4 * qb8 + (w >> 1);
    bf16x8 qf[12];
    { const bf16_t* qp = QA + (size_t)(qrow0 + r) * 3072 + h * QHD + 8 * hf;
#pragma unroll
      for (int k = 0; k < 12; ++k) qf[k] = *(const bf16x8*)(qp + 16 * k); }
    AttnState st;
#pragma unroll
    for (int d = 0; d < 4; ++d)
#pragma unroll
        for (int i = 0; i < 16; ++i) st.ot[d][i] = 0.f;
    st.mrun = -INFINITY; st.lrun = 0.f;
    unsigned kno[2], vto[2]; int kndst[2], vtdst[2];
#pragma unroll
    for (int i = 0; i < 2; ++i) { const int p = tid + 512 * i;
        kno[i] = (unsigned)((p >> 4) * 2048 + 8 * (p & 15)); kndst[i] = (p >> 4) * AK_PITCH + 16 * (p & 15);
        vto[i] = (unsigned)((p >> 3) * KVROWS + 8 * (p & 7)); vtdst[i] = A_VOFF + (p >> 3) * AV_PITCH + 16 * (p & 7); }
    const unsigned peo = (unsigned)((tid >> 3) * ROPE + 8 * (tid & 7)); const int pedst = (tid >> 3) * AK_PITCH + 256 + 16 * (tid & 7);
    const bf16_t* knB = KN + (size_t)kvbase * 2048 + h * NOPE; const bf16_t* peB = KPEA + (size_t)kvbase * ROPE; const bf16_t* vtB = VT + (size_t)(h * VD) * KVROWS + kvbase;
    u32x4 sk0, sk1, sp, sv0, sv1;
#define ATT_LOAD(T) do { const bf16_t* kn_ = knB + (size_t)(T) * 64 * 2048; const bf16_t* pe_ = peB + (size_t)(T) * 64 * ROPE; const bf16_t* vt_ = vtB + (T) * 64; \
        sk0 = *(const u32x4*)(kn_ + kno[0]); sk1 = *(const u32x4*)(kn_ + kno[1]); sp = *(const u32x4*)(pe_ + peo); sv0 = *(const u32x4*)(vt_ + vto[0]); sv1 = *(const u32x4*)(vt_ + vto[1]); } while (0)
#define ATT_WRITE(B) do { LAS unsigned char* b_ = lds + (B) * A_BUF; \
        *(LAS u32x4*)(b_ + kndst[0]) = sk0; *(LAS u32x4*)(b_ + kndst[1]) = sk1; *(LAS u32x4*)(b_ + pedst) = sp; \
        *(LAS u32x2*)(b_ + vtdst[0]) = (u32x2){sv0.x, sv0.y}; *(LAS u32x2*)(b_ + vtdst[0] + 8) = (u32x2){sv0.z, sv0.w}; \
        *(LAS u32x2*)(b_ + vtdst[1]) = (u32x2){sv1.x, sv1.y}; *(LAS u32x2*)(b_ + vtdst[1] + 8) = (u32x2){sv1.z, sv1.w}; } while (0)
    ATT_LOAD(0); ATT_WRITE(0);
    __syncthreads();
    for (int t = 0; t < nT; ++t) {
        if (t + 1 < nT) ATT_LOAD(t + 1);
        if (t <= my_last) {
            const LAS unsigned char* kb = lds + (t & 1) * A_BUF; const LAS unsigned char* vb = kb + A_VOFF;
#pragma unroll 1
            for (int hh = 0; hh < 2; ++hh) {
                bf16x8 kf[12];
#pragma unroll
                for (int k = 0; k < 12; ++k) kf[k] = *(const LAS bf16x8*)(kb + (32 * hh + r) * AK_PITCH + 32 * k + 16 * hf);
                __builtin_amdgcn_sched_barrier(0);
                f32x16 sc;
#pragma unroll
                for (int i = 0; i < 16; ++i) sc[i] = 0.f;
#pragma unroll
                for (int k = 0; k < 12; ++k) sc = MFMA32(kf[k], qf[k], sc);
                u32x2 vlo[8], vhi[8];
#pragma unroll
                for (int d = 0; d < 4; ++d)
#pragma unroll
                    for (int ks = 0; ks < 2; ++ks) { const LAS unsigned char* vp = vb + (32 * d + r) * AV_PITCH + 2 * (32 * hh + 16 * ks + 4 * hf);
                        vlo[2 * d + ks] = *(const LAS u32x2*)vp; vhi[2 * d + ks] = *(const LAS u32x2*)(vp + 16); }
                __builtin_amdgcn_sched_barrier(0);
                bf16x8 pf[2]; attn_softmax_pv_begin(sc, st, pf);
#pragma unroll
                for (int d = 0; d < 4; ++d)
#pragma unroll
                    for (int ks = 0; ks < 2; ++ks) { const u32x4 vv = {vlo[2 * d + ks].x, vlo[2 * d + ks].y, vhi[2 * d + ks].x, vhi[2 * d + ks].y};
                        st.ot[d] = MFMA32(__builtin_bit_cast(bf16x8, vv), pf[ks], st.ot[d]); }
            }
        }
        if (t + 1 < nT) ATT_WRITE((t + 1) & 1);
        __syncthreads();
    }
#undef ATT_LOAD
#undef ATT_WRITE
    const float inv = __builtin_amdgcn_rcpf(sum_xor32(st.lrun));
    bf16_t* op = AO + (size_t)(qrow0 + r) * DM + h * VD + 4 * hf;
#pragma unroll
    for (int d = 0; d < 4; ++d)
#pragma unroll
        for (int g = 0; g < 4; ++g) { u32x2 o; o.x = pk2(st.ot[d][4 * g] * inv, st.ot[d][4 * g + 1] * inv); o.y = pk2(st.ot[d][4 * g + 2] * inv, st.ot[d][4 * g + 3] * inv); *(u32x2*)(op + d * 32 + 8 * g) = o; }
}
DI void attn_sample_unit(const Frame& F, int b, int h) {
    const bf16_t* QA = (const bf16_t*)(F.ws + WS_QA); const bf16_t* KN = (const bf16_t*)(F.ws + WS_KN); const bf16_t* KPEA = (const bf16_t*)(F.ws + WS_KPEA); const bf16_t* VT = (const bf16_t*)(F.ws + WS_VT);
    bf16_t* AO = (bf16_t*)(F.ws + WS_AO);
    const int lane = F.lane, w = F.wave, r = lane & 31, hf = lane >> 5;
    const int qrow0 = TP + b * DS, kvbase = TP + b * KVSEQ;
    const int tb = 4 * w + (w > 0 ? 1 : 0), te = tb + (w == 0 ? 5 : 4);
    bf16x8 qf[12];
    { const bf16_t* qp = QA + (size_t)(qrow0 + r) * 3072 + h * QHD + 8 * hf;
#pragma unroll
      for (int k = 0; k < 12; ++k) qf[k] = *(const bf16x8*)(qp + 16 * k); }
    AttnState st;
#pragma unroll
    for (int d = 0; d < 4; ++d)
#pragma unroll
        for (int i = 0; i < 16; ++i) st.ot[d][i] = 0.f;
    st.mrun = -INFINITY; st.lrun = 0.f;
    for (int t = tb; t < te; ++t) {
        const int key0 = 32 * t;
        const bf16_t* kp = KN + (size_t)(kvbase + key0 + r) * 2048 + h * NOPE + 8 * hf;
        const bf16_t* pp = KPEA + (size_t)(kvbase + key0 + r) * ROPE + 8 * hf;
        f32x16 sc;
#pragma unroll
        for (int i = 0; i < 16; ++i) sc[i] = 0.f;
#pragma unroll
        for (int k = 0; k < 8; ++k) sc = MFMA32(*(const bf16x8*)(kp + 16 * k), qf[k], sc);
#pragma unroll
        for (int k = 0; k < 4; ++k) sc = MFMA32(*(const bf16x8*)(pp + 16 * k), qf[8 + k], sc);
        bf16x8 pf[2]; attn_softmax_pv_begin(sc, st, pf);
#pragma unroll
        for (int d = 0; d < 4; ++d) {
            const bf16_t* vp = VT + (size_t)(h * VD + d * 32 + r) * KVROWS + kvbase + key0 + 4 * hf;
#pragma unroll
            for (int ks = 0; ks < 2; ++ks) { const u32x2 lo = *(const u32x2*)(vp + 16 * ks), hi = *(const u32x2*)(vp + 16 * ks + 8); const u32x4 vv = {lo.x, lo.y, hi.x, hi.y};
                st.ot[d] = MFMA32(__builtin_bit_cast(bf16x8, vv), pf[ks], st.ot[d]); }
        }
    }
    LAS float* OT = (LAS float*)F.lds; LAS float* ML = (LAS float*)(F.lds + 131072);
    const float lsum = sum_xor32(st.lrun);
#pragma unroll
    for (int d = 0; d < 4; ++d)
#pragma unroll
        for (int i = 0; i < 16; ++i) OT[(w * 64 + 16 * d + i) * 64 + lane] = st.ot[d][i];
    if (hf == 0) { ML[w * 64 + r] = st.mrun; ML[w * 64 + 32 + r] = lsum; }
    __syncthreads();
    float M = -INFINITY;
#pragma unroll
    for (int q = 0; q < 8; ++q) M = fmaxf(M, ML[q * 64 + r]);
    float sc8[8], Lt = 0.f;
#pragma unroll
    for (int q = 0; q < 8; ++q) { sc8[q] = __builtin_amdgcn_exp2f(ML[q * 64 + r] - M); Lt += ML[q * 64 + 32 + r] * sc8[q]; }
    const float inv = __builtin_amdgcn_rcpf(Lt);
    const int d = w >> 1;
    bf16_t* op = AO + (size_t)(qrow0 + r) * DM + h * VD + 4 * hf + d * 32;
#pragma unroll
    for (int gg = 0; gg < 2; ++gg) { const int g = 2 * (w & 1) + gg; float o[4];
#pragma unroll
        for (int j = 0; j < 4; ++j) { float acc = 0.f;
#pragma unroll
            for (int q = 0; q < 8; ++q) acc += OT[(q * 64 + 16 * d + 4 * g + j) * 64 + lane] * sc8[q];
            o[j] = acc * inv; }
        u32x2 ov; ov.x = pk2(o[0], o[1]); ov.y = pk2(o[2], o[3]); *(u32x2*)(op + 8 * g) = ov; }
    __syncthreads();
}
DI void phase_attn(const Frame& F) {
    const int vcu = (F.G % 8 == 0) ? (F.bid % 8) * (F.G / 8) + F.bid / 8 : F.bid;
    for (int p = vcu; p < NB * HH * 4; p += F.G) { const int sh = p >> 2, pr = p & 3, s = sh >> 4, h = sh & 15;
        const int n = pr == 0 ? 1 : pr == 3 ? 3 : 2;
#pragma unroll 1
        for (int k = 0; k < n; ++k) { int qb8 = pr == 0 ? 6 : pr == 1 ? (k == 0 ? 5 : 0) : pr == 2 ? (k == 0 ? 7 : 2) : (k == 0 ? 4 : k == 1 ? 3 : 1);
            asm volatile("" : "+s"(qb8)); attn_prompt_unit(F, s, h, qb8); }
    }
    const Frame F2 = with_ids<9>(F);
    for (int p = vcu; p < NB * HH * 4; p += F2.G) if ((p & 3) < 2) { const int u = (p >> 2) * 2 + (p & 3); attn_sample_unit(F2, u >> 4, u & 15); }
}

#define GRP(Aoff, Boff, rs0, rstep, nM, nN, ks, ntk, di) { S.g[S.ng] = {ws + (Aoff), ws + (Boff), rs0, rstep, nM, nN, ks, ntk, di}; ++S.ng; }
DI void run_gemm(const Frame& F, int gi) {
    unsigned char* ws = F.ws; pg8::PhaseSched S; S.ng = 0; S.G = F.G; S.c = F.bid; S.K = (gi == 3 || gi == 8) ? FF : (gi == 5 ? 512 : 2048);
    if (gi == 9) { S.G = 64; S.c = F.bid - (F.G - 64); }
    switch (gi) {
    case 0: GRP(WS_H, WS_WT_HIN, 0, 256, 32, 24, 1, 32, D_HGRN) GRP(WS_WT_HIN + (size_t)6144 * 2048 * 2, WS_H, 0, 256, 8, 32, 1, 32, D_VT2) break;
    case 9: GRP(WS_H, WS_WT_HIN, TP, 256, 1, 24, 1, 32, D_HGRN) GRP(WS_WT_HIN + (size_t)6144 * 2048 * 2, WS_H + (size_t)TP * 2048 * 2, 0, 256, 8, 1, 1, 32, D_VT2S) break;
    case 1: GRP(WS_OG, WS_WT_HOUT, 0, 256, 32, 8, 1, 32, D_M) GRP(WS_OG, WS_WT_HOUT, TP, 256, 1, 8, KS_2048, 32 / KS_2048, D_MSLAB) break;
    case 2: GRP(WS_X, WS_WT_FIN, -2, 254, 34, 44, 1, 32, D_FFN0) break;
    case 3: GRP(WS_ACT, WS_WT_FOUT, 0, 256, 32, 8, 1, 88, D_M) GRP(WS_ACT, WS_WT_FOUT, TP, 256, 1, 8, KS_5632, 88 / KS_5632, D_MSLAB) break;
    case 4: GRP(WS_X, WS_WT_DOWN, 0, 256, 33, 5, 1, 32, D_DOWN) break;
    case 5: GRP(WS_CKVA, WS_WT_K, 0, 256, 65, 8, 1, 8, D_KN) GRP(WS_WT_V, WS_CKVA, 0, 256, 8, 65, 1, 8, D_VT) GRP(WS_CQ, WS_WT_UQ, 0, 256, 33, 12, 1, 8, D_Q) break;
    case 6: GRP(WS_AO, WS_WT_MOUT, 0, 256, 32, 8, 1, 32, D_M) GRP(WS_AO, WS_WT_MOUT, TP, 256, 1, 8, KS_2048, 32 / KS_2048, D_MSLAB) break;
    case 7: GRP(WS_X, WS_WT_FIN + (size_t)FF2 * 2048 * 2, -2, 254, 34, 44, 1, 32, D_FFN1) break;
    default: GRP(WS_ACT, WS_WT_FOUT + (size_t)2048 * FF * 2, 0, 256, 32, 8, 1, 88, D_M) GRP(WS_ACT, WS_WT_FOUT + (size_t)2048 * FF * 2, TP, 256, 1, 8, KS_5632, 88 / KS_5632, D_MSLAB) break;
    }
#if PROBE_KDUP_GI >= 0
    EpiAll E{F.ws, F.out, F.lds, F.in, F.wave, F.z, gi == 1 ? 0 : gi == 3 ? 1 : gi == 6 ? 2 : 3, gi == PROBE_KDUP_GI}; S.kdup = (gi == PROBE_KDUP_GI);
#else
    EpiAll E{F.ws, F.out, F.lds, F.in, F.wave, F.z, gi == 1 ? 0 : gi == 3 ? 1 : gi == 6 ? 2 : 3};
#endif
    if (gi == 0 || gi == 9) {
        const Frame F2 = with_ids(F); *(LAS f32x4*)(F2.lds + 131072 + F2.tid * 16) = *(const f32x4*)((const float*)(ws + WS_LB) + F2.tid * 4);
        __syncthreads(); }
    { const int sg = (F.bid >> 3) & 3;
      if (gi == 0)                 { for (int i = 0; i < sg; ++i) __builtin_amdgcn_s_sleep(127); }
      else if (gi == 5)            { for (int i = 0; i < sg; ++i) __builtin_amdgcn_s_sleep(80); }
      else if (gi == 2 || gi == 7) { for (int i = 0; i < sg; ++i) __builtin_amdgcn_s_sleep(40); } }
    if (gi == 0 || gi == 9)      pg8::gemm_phase(F.lds, S, EpiSel<G_HG>{E}, F.wave);
    else if (gi == 2 || gi == 7) pg8::gemm_phase(F.lds, S, EpiSel<G_FFN>{E}, F.wave);
    else if (gi == 4)            pg8::gemm_phase(F.lds, S, EpiSel<G_DOWN>{E}, F.wave);
    else if (gi == 5)            pg8::gemm_phase(F.lds, S, EpiSel<G_UP>{E}, F.wave);
    else                         pg8::gemm_phase(F.lds, S, EpiSel<G_RES>{E}, F.wave);
    if (gi == 4 && F.bid >= 165) {
        const Frame F2 = with_ids(F); convert_caches(F2, (F2.bid - 165) * NWAVES + F2.wave, (F2.G - 165) * NWAVES); }
}
#undef GRP

#define XB_TMO      128
#define XB_XCNT(j)  (256  + 64 * (j))
#define XB_XSUB(j)  (1280 + 64 * (j))
#define XB_XGEN(j)  (2304 + 64 * (j))
#define XB_TOP      3328
#define XB_TOPGEN   3392
#define XCD_BAR_WORDS 3456
#define XB_SPIN_CAP (1u << 18)
__device__ __forceinline__ unsigned xb_ld(unsigned* p)              { return __hip_atomic_load(p, __ATOMIC_RELAXED, __HIP_MEMORY_SCOPE_AGENT); }
__device__ __forceinline__ unsigned xb_add(unsigned* p, unsigned v) { return __hip_atomic_fetch_add(p, v, __ATOMIC_RELAXED, __HIP_MEMORY_SCOPE_AGENT); }
__device__ __forceinline__ unsigned xb_xcc_id() { return (unsigned)__builtin_amdgcn_s_getreg((3 << 11) | 20) & 0xFu; }
#define XB_SPIN(cond, bar) do { unsigned _sp = 0; while (cond) { __builtin_amdgcn_s_sleep(1); \
    if ((++_sp & 255u) == 0u) { if (xb_ld(&(bar)[XB_TMO])) break; if (_sp > XB_SPIN_CAP) { atomicAdd(&(bar)[XB_TMO], 1u); break; } } } } while (0)
struct XcdBarrier { unsigned* bar; unsigned x; volatile LAS unsigned* st; };
__device__ __forceinline__ XcdBarrier xcd_barrier_post(unsigned* bar, volatile LAS unsigned* st) {
    XcdBarrier b; b.bar = bar; b.x = xb_xcc_id(); b.st = st;
    if (threadIdx.x == 0) (void)xb_add(&bar[XB_XCNT(b.x)], 1u);
    return b;
}
__device__ __forceinline__ void xcd_barrier_complete(unsigned* bar, unsigned x, unsigned& nloc, unsigned& nx) {
    const unsigned G = gridDim.x * gridDim.y * gridDim.z;
    unsigned sum, cnt, mine, sp = 0u;
    for (;;) {
        sum = 0u; cnt = 0u; mine = 0u;
#pragma unroll
        for (unsigned j = 0; j < 16; ++j) { const unsigned c = xb_ld(&bar[XB_XCNT(j)]); sum += c; cnt += (c > 0u) ? 1u : 0u; mine = (j == x) ? c : mine; }
        if (sum == G) break;
        __builtin_amdgcn_s_sleep(1);
        if ((++sp & 255u) == 0u) { if (xb_ld(&bar[XB_TMO])) break; if (sp > XB_SPIN_CAP) { atomicAdd(&bar[XB_TMO], 1u); break; } }
    }
    nloc = mine > 0u ? mine : 1u; nx = cnt > 0u ? cnt : 1u;
}
__device__ __forceinline__ void xcd_barrier(const XcdBarrier& b) {
    asm volatile("s_waitcnt vmcnt(0)" ::: "memory");
    __syncthreads();
    if (threadIdx.x == 0) {
        unsigned* bar = b.bar;
        __builtin_amdgcn_s_waitcnt(0);
        unsigned nloc = b.st[0], nx = b.st[1];
        if (nloc == 0u) { xcd_barrier_complete(bar, b.x, nloc, nx); b.st[0] = nloc; b.st[1] = nx; }
        const unsigned old = xb_add(&bar[XB_XSUB(b.x)], 1u);
        const unsigned gen = old / nloc;
        if (old + 1u == (gen + 1u) * nloc) {
            __builtin_amdgcn_fence(__ATOMIC_RELEASE, "agent");
            asm volatile("s_waitcnt vmcnt(0)" ::: "memory");
            const unsigned og = xb_add(&bar[XB_TOP], 1u);
            const unsigned tg = og / nx;
            if (og + 1u == (tg + 1u) * nx) xb_add(&bar[XB_TOPGEN], 1u);
            else XB_SPIN(xb_ld(&bar[XB_TOPGEN]) == tg, bar);
            __builtin_amdgcn_fence(__ATOMIC_ACQUIRE, "agent");
            xb_add(&bar[XB_XGEN(b.x)], 1u);
            asm volatile("s_waitcnt vmcnt(0)" ::: "memory");
        } else {
            XB_SPIN(xb_ld(&bar[XB_XGEN(b.x)]) == gen, bar);
            __builtin_amdgcn_fence(__ATOMIC_ACQUIRE, "agent");
            asm volatile("s_waitcnt vmcnt(0)" ::: "memory");
        }
    }
    __syncthreads();
}

constexpr int N_PHASES = 17;
template <bool COOP>
__global__ void __launch_bounds__(NTHREADS, 2) mk_fwd(Args args) {
    extern __shared__ __attribute__((aligned(16))) unsigned char lds[];
    Frame F;
    F.lds = (LAS unsigned char*)lds;
    F.tid = threadIdx.x; F.lane = F.tid & 63; F.wave = __builtin_amdgcn_readfirstlane(F.tid >> 6); F.G = gridDim.x; F.bid = blockIdx.x;
    F.in = args.in; F.out = args.out; F.ws = args.ws;
    volatile LAS unsigned* misc = (volatile LAS unsigned*)(F.lds + MISC_OFF);
    if (F.tid < 16) misc[F.tid] = 0u;
    __syncthreads();
    XcdBarrier xbar; xbar.bar = (unsigned*)(args.ws + WS_CTL); xbar.x = 0; xbar.st = nullptr;
    if (COOP) xbar = xcd_barrier_post((unsigned*)(args.ws + WS_CTL), misc + 8);
    Frame F0 = F;
    for (int ph = args.ph_lo; ph < args.ph_hi; ++ph) {
        if (PROBE_PH >= 0 && F0.bid == 0 && F0.wave == 0) ((volatile LAS unsigned long long*)(F0.lds + MISC_OFF + 128))[ph] = __builtin_amdgcn_s_memrealtime();
        Frame F = F0;
        F.lane = 0; F.tid = 0;
        asm volatile("" : "+s"(F.wave), "+s"(F.bid), "+s"(F.G));
        F.z = 0; asm volatile("" : "+s"(F.z));
        F.ws = F0.ws + F.z; F.out = F0.out + F.z;
        int g0 = 0, g1 = 0;
        switch (ph) {
        case 1: g0 = 0; g1 = 1; break;
        case 2: if (F.G == 256 && F.bid >= 192) { g0 = 9; g1 = 10; } break;
        case 3: g0 = 1; g1 = 2; break;
        case 5: g0 = 2; g1 = 3; break;
        case 6: g0 = 3; g1 = 4; break;
        case 8: g0 = 4; g1 = 5; break;
        case 10: g0 = 5; g1 = 6; break;
        case 12: g0 = 6; g1 = 7; break;
        case 14: g0 = 7; g1 = 8; break;
        case 15: g0 = 8; g1 = 9; break;
        default: break;
        }
        if (g1 > g0) {
#pragma unroll 1
            for (int gi = g0; gi < g1; ++gi) run_gemm(F, gi);
            if (ph == 2) scan_late_tail(F);
        } else {
            switch (ph) {
            case 0: phase_prep(with_ids<1>(F)); break;
            case 2: phase_scan(with_ids<2>(F)); break;
            case 4: phase_rowpass(with_ids<3>(F), 0); break;
            case 7: phase_rowpass(with_ids<4>(F), 1); break;
            case 9: phase_mlarow(with_ids<5>(F)); break;
            case 11: phase_attn(with_ids<6>(F)); break;
            case 13: phase_rowpass(with_ids<7>(F), 2); break;
            default: phase_rowpass(with_ids<8>(F), 3); break;
            }
        }
        if (COOP) { if (ph + 1 < args.ph_hi) { xcd_barrier(xbar); } }
    }
    if (PROBE_PH >= 0 && F0.bid == 0 && F0.wave == 0) {
        volatile LAS unsigned long long* ts = (volatile LAS unsigned long long*)(F0.lds + MISC_OFF + 128);
        const unsigned long long tend = __builtin_amdgcn_s_memrealtime();
        const unsigned long long t1 = (PROBE_PH + 1 < args.ph_hi) ? ts[PROBE_PH + 1] : tend;
        const unsigned long long wait = (t1 - ts[PROBE_PH]) * PROBE_MULT;
        while (__builtin_amdgcn_s_memrealtime() - tend < wait) __builtin_amdgcn_s_sleep(8);
    }
}

extern "C" void kernel_launch(void* const* d_in, const int* in_sizes, int n_in, void* d_out, int out_size, void* d_ws, size_t ws_size, hipStream_t stream) {
    static int grid = 0;
    if (grid == 0) {
        if (n_in != 21 || (size_t)out_size != O_END || ws_size < WS_END) { fprintf(stderr, "kernel_launch: unexpected sizes n_in %d out %d (want %zu) ws %zu (need %zu)\n", n_in, out_size, (size_t)O_END, ws_size, (size_t)WS_END); grid = -1; return; }
        int dev = 0, cus = 0, per_cu = 0;
        hipGetDevice(&dev); hipDeviceGetAttribute(&cus, hipDeviceAttributeMultiprocessorCount, dev);
        hipFuncSetAttribute((const void*)mk_fwd<true>, hipFuncAttributeMaxDynamicSharedMemorySize, LDS_BYTES);
        hipFuncSetAttribute((const void*)mk_fwd<false>, hipFuncAttributeMaxDynamicSharedMemorySize, LDS_BYTES);
        hipOccupancyMaxActiveBlocksPerMultiprocessor(&per_cu, (const void*)mk_fwd<true>, NTHREADS, LDS_BYTES);
        (void)hipGetLastError();
        if (per_cu < 1) { fprintf(stderr, "kernel_launch: the occupancy query reports %d workgroups per CU for this kernel: it cannot be made resident, nothing launched\n", per_cu); grid = -1; return; }
        if (cus != 256) { fprintf(stderr, "kernel_launch: built for a 256-CU device (one main GEMM unit per CU in the fused residual epilogues, sample-row units on the last 64 workgroups of the scan phase); this device reports %d CUs, nothing launched\n", cus); grid = -1; return; }
        grid = cus;
    }
    if (grid < 0) return;
    if (hipMemsetAsync((char*)d_ws + WS_CTL, 0, CTL_BYTES, stream) != hipSuccess) { fprintf(stderr, "kernel_launch: memset of the barrier words failed\n"); return; }
    Args a{};
    for (int i = 0; i < 21; ++i) a.in[i] = (const float*)d_in[i];
    a.out = (float*)d_out; a.ws = (unsigned char*)d_ws;
#if MK_ONE_LAUNCH
    a.ph_lo = 0; a.ph_hi = N_PHASES;
    void* kargs[] = {&a};
    hipError_t e = hipLaunchCooperativeKernel((const void*)mk_fwd<true>, dim3(grid), dim3(NTHREADS), kargs, LDS_BYTES, stream);
    if (e != hipSuccess) fprintf(stderr, "cooperative launch failed: %s (grid %d)\n", hipGetErrorString(e), grid);
#else
    for (int ph = 0; ph < N_PHASES; ++ph) {
        a.ph_lo = ph; a.ph_hi = ph + 1;
        hipLaunchKernelGGL(mk_fwd<false>, dim3(grid), dim3(NTHREADS), LDS_BYTES, stream, a);
    }
#endif
}
```

```cpp
#include <hip/hip_runtime.h>
#include <hip/hip_cooperative_groups.h>
#include <cstdio>
#include <cstdint>
namespace cg = cooperative_groups;

#ifndef MK_ONE_LAUNCH
#define MK_ONE_LAUNCH 1
#endif

#ifndef PROBE_KDUP_GI
#define PROBE_KDUP_GI -1
#endif
#ifndef PROBE_PH
#define PROBE_PH -1
#endif
#define PROBE_MULT 2
#define LAS __attribute__((address_space(3)))
#define GAS __attribute__((address_space(1)))
#define DI __device__ __forceinline__
typedef unsigned short bf16_t;
typedef short bf16x8 __attribute__((ext_vector_type(8)));
typedef float f32x4 __attribute__((ext_vector_type(4)));
typedef _Float16 h16x2 __attribute__((ext_vector_type(2)));
typedef float f32x2 __attribute__((ext_vector_type(2)));
typedef float f32x16 __attribute__((ext_vector_type(16)));
typedef unsigned u32x4 __attribute__((ext_vector_type(4)));
typedef unsigned u32x2 __attribute__((ext_vector_type(2)));
typedef __bf16 bf16x2_t __attribute__((ext_vector_type(2)));

constexpr int DM = 2048, NB = 4, SEQ = 2048, DB = 8, DS = 32, PAST = 1024;
constexpr int TP = NB * SEQ, TS = DB * DS, T = TP + TS;
constexpr int HH = 16, DK = 128, DV = 128;
constexpr int QL = 512, KVL = 512, NOPE = 128, ROPE = 64, VD = 128, QHD = NOPE + ROPE;
constexpr int NDOWN = QL + KVL + ROPE, NDOWNP = 1280;
constexpr int FF = 5632, FF2 = 2 * FF;
constexpr int KVSEQ = PAST + DS;
constexpr int KVROWS = TP + DB * KVSEQ;
constexpr float EPS = 1e-6f;
constexpr int NTHREADS = 512, NWAVES = 8;

constexpr size_t O_Y = 0;
constexpr size_t O_HG = (size_t)T * DM;
constexpr size_t O_CKV = O_HG + (size_t)12 * HH * DK * DV;
constexpr size_t O_KPE = O_CKV + (size_t)T * KVL;
constexpr size_t O_CONVP = O_KPE + (size_t)T * ROPE;
constexpr size_t O_CONVS = O_CONVP + (size_t)2 * NB * 2 * FF2;
constexpr size_t O_END = O_CONVS + (size_t)2 * DB * 2 * FF2;

constexpr size_t al256(size_t x) { return (x + 255) & ~(size_t)255; }
constexpr size_t WS_WT_HIN = 0;
constexpr size_t WS_WT_HOUT = WS_WT_HIN + (size_t)8192 * 2048 * 2;
constexpr size_t WS_WT_DOWN = WS_WT_HOUT + (size_t)2048 * 2048 * 2;
constexpr size_t WS_WT_UQ = WS_WT_DOWN + (size_t)NDOWNP * 2048 * 2;
constexpr size_t WS_WT_K = WS_WT_UQ + (size_t)3072 * 512 * 2;
constexpr size_t WS_WT_V = WS_WT_K + (size_t)2048 * 512 * 2;
constexpr size_t WS_WT_MOUT = WS_WT_V + (size_t)2048 * 512 * 2;
constexpr size_t WS_WT_FIN = WS_WT_MOUT + (size_t)2048 * 2048 * 2;
constexpr size_t WS_WT_FOUT = WS_WT_FIN + (size_t)2 * FF2 * 2048 * 2;
constexpr size_t WS_TAB = WS_WT_FOUT + (size_t)2 * 2048 * FF * 2;
constexpr size_t WS_LB = WS_TAB + (size_t)2048 * 32 * 2 * 4;
constexpr size_t WS_X = WS_LB + 2048 * 4;
constexpr size_t WS_HPAD = WS_X + (size_t)T * DM * 4;
constexpr size_t WS_H = WS_HPAD + (size_t)2 * DM * 2;
constexpr size_t WS_M = WS_H + (size_t)T * DM * 2;
constexpr size_t WS_R2 = WS_M;
constexpr size_t WS_R = WS_M + (size_t)T * DM * 4;
constexpr size_t WS_QB = WS_R;
constexpr size_t WS_FG = WS_QB + (size_t)T * DM * 2;
constexpr size_t WS_VT2 = WS_FG + (size_t)T * DM * 4;
constexpr size_t WS_SG = WS_VT2 + (size_t)T * DM * 2;
constexpr size_t WS_OG = WS_SG + (size_t)T * DM * 2;
constexpr size_t WS_RA_END = WS_OG + (size_t)T * DM * 2;
constexpr size_t WS_ACT = WS_R;
constexpr size_t WS_RB_END = WS_ACT + (size_t)T * FF * 2;
constexpr size_t WS_DOWN = WS_R;
constexpr size_t WS_CQ = WS_DOWN + (size_t)T * NDOWNP * 4;
constexpr size_t WS_CKVA = WS_CQ + (size_t)T * QL * 2;
constexpr size_t WS_KPEA = WS_CKVA + (size_t)KVROWS * KVL * 2;
constexpr size_t WS_QA = WS_KPEA + (size_t)KVROWS * ROPE * 2;
constexpr size_t WS_KN = WS_QA + (size_t)T * 3072 * 2;
constexpr size_t WS_VT = WS_KN + (size_t)KVROWS * 2048 * 2;
constexpr size_t WS_AO = WS_VT + (size_t)2048 * KVROWS * 2;
constexpr size_t WS_RC_END = WS_AO + (size_t)T * DM * 2;
constexpr size_t cmax(size_t a, size_t b) { return a > b ? a : b; }
constexpr size_t WS_SLAB = cmax(WS_RA_END, cmax(WS_RB_END, WS_RC_END));
constexpr size_t WS_CTL = WS_SLAB + (size_t)22 * TS * DM * 4;
constexpr size_t CTL_BYTES = 65536;
constexpr size_t WS_XCH = WS_CTL + CTL_BYTES;
constexpr size_t WS_END = WS_XCH + (size_t)2 * 32 * 256 * 8 * 4;

constexpr int KS_2048 = 8, KS_5632 = 11;
constexpr int LDS_BYTES = 147456;
constexpr int MISC_OFF = LDS_BYTES - 512;

template <class T> DI T* as_global(T* p) { return (T*)(GAS T*)p; }
DI float bf2f(unsigned short b) { return __uint_as_float((unsigned)b << 16); }
DI unsigned pk2(float lo, float hi) { f32x2 v = {lo, hi}; bf16x2_t b = __builtin_convertvector(v, bf16x2_t); return __builtin_bit_cast(unsigned, b); }
DI float fexp(float x) { return __builtin_amdgcn_exp2f(x * 1.4426950408889634f); }
DI float sigmoidf_(float x) { return __builtin_amdgcn_rcpf(1.f + fexp(-x)); }
DI float siluf_(float x) { return x * sigmoidf_(x); }
template <int M> DI float xor_lane(float v) { static_assert(M >= 1 && M < 32, "ds_swizzle bit mode"); return __int_as_float(__builtin_amdgcn_ds_swizzle(__float_as_int(v), 0x1f | (M << 10))); }
DI float sum_xor32(float v) { auto rr = __builtin_amdgcn_permlane32_swap(__float_as_uint(v), __float_as_uint(v), false, false); return __uint_as_float(rr[0]) + __uint_as_float(rr[1]); }
DI float max_xor32(float v) { auto rr = __builtin_amdgcn_permlane32_swap(__float_as_uint(v), __float_as_uint(v), false, false); return fmaxf(__uint_as_float(rr[0]), __uint_as_float(rr[1])); }
DI float wave_sum(float v) { v += xor_lane<1>(v); v += xor_lane<2>(v); v += xor_lane<4>(v); v += xor_lane<8>(v); v += xor_lane<16>(v); return sum_xor32(v); }

namespace pg8 {
constexpr int BM = 256, BK = 64, HALF = 128, HTB = HALF * BK * 2, STAGE_BYTES = 8 * HTB, NXCD = 8, WGM = 8;
__host__ __device__ __forceinline__ int lds_byte(int r, int c) { const int st = (r >> 4) * 2 + (c >> 5), rr = r & 15, cc = c & 31, ob = rr * 64 + cc * 2; return st * 1024 + (ob ^ (((ob >> 9) & 1) << 5)); }
__host__ __device__ __forceinline__ void stage_rc(int b, int& R, int& C) { const int st = b / 1024, sb = b % 1024, swz = sb ^ (((sb >> 9) & 1) << 5); R = (st >> 1) * 16 + swz / 64; C = (st & 1) * 32 + (swz % 64) / 2; }

struct Unit { const char* A; const char* B; int r0, pn, nt, di, aux; };

__device__ __forceinline__ void decode_group(const void* A, const void* Bt, int K, int rs0, int rstep, int nM, int nN, int ks, int ntk, int di, int L, Unit& u) {
    int pml, pn, sl = 0;
    if (ks == 1) {
        const int nwg = nM * nN; int wgid = L;
        { const int q = nwg / NXCD, r = nwg % NXCD, xcd = wgid % NXCD, off = wgid / NXCD; wgid = (xcd < r ? xcd * (q + 1) : r * (q + 1) + (xcd - r) * q) + off; }
        const int nig = WGM * nN, gid = wgid / nig, fm = gid * WGM, gsz = (nM - fm) < WGM ? (nM - fm) : WGM;
        pml = fm + ((wgid % nig) % gsz); pn = (wgid % nig) / gsz;
    } else { sl = L % ks; const int tile = L / ks; pn = tile % nN; pml = tile / nN; }
    u.r0 = rs0 + pml * rstep; u.pn = pn; u.nt = ntk; u.di = di; u.aux = sl;
    u.A = (const char*)A + ((long)u.r0 * K + (long)sl * ntk * BK) * 2;
    u.B = (const char*)Bt + ((long)pn * BM * K + (long)sl * ntk * BK) * 2;
}
struct Group { const void* A; const void* Bt; int rs0, rstep, nM, nN, ks, ntk, di; };
struct PhaseSched {
    Group g[3]; int ng, K, G, c;
#if PROBE_KDUP_GI >= 0
    int kdup;
#endif
    __device__ __forceinline__ bool next(int i, Unit& u) const {
        int L = i * G + c;
#pragma unroll
        for (int k = 0; k < 3; ++k) if (k < ng) { const int cnt = g[k].nM * g[k].nN * g[k].ks;
            if (L < cnt) { decode_group(g[k].A, g[k].Bt, K, g[k].rs0, g[k].rstep, g[k].nM, g[k].nN, g[k].ks, g[k].ntk, g[k].di, L, u); return true; } L -= cnt; }
        return false;
    }
};

template <class Epi>
__device__ __forceinline__ void gemm_phase(LAS unsigned char* lds, const PhaseSched& S, const Epi& E, int tid_in) {
    Unit cur, nxt; int ui = 0;
    if (!S.next(0, cur)) return;
    int tid; { unsigned ones = ~0u; asm volatile("" : "+s"(ones)); tid = tid_in * 64 + (int)__builtin_amdgcn_mbcnt_hi(ones, __builtin_amdgcn_mbcnt_lo(ones, 0u)); }
    const int wid = __builtin_amdgcn_readfirstlane(tid >> 6), lane = tid & 63, wr = wid >> 2, wc = wid & 3, fr = lane & 15, fq = lane >> 4;
    const int K = S.K;
    unsigned voffA[2], voffB[2];
#pragma unroll
    for (int i = 0; i < 2; ++i) { int R, C; stage_rc(tid * 16 + i * 8192, R, C);
        voffA[i] = (unsigned)(R * K + C) * 2u; voffB[i] = (unsigned)(R * K + C) * 2u; }
    const size_t kstep = (size_t)(BK * 2);
    const size_t hstep = (size_t)HALF * K * 2;
    const unsigned ldsw = (unsigned)wid * 1024u;
    const int aoff = lds_byte(wr * 64 + fr, fq * 8), boff = lds_byte(wc * 32 + fr, fq * 8);
#define PG8_SA(b, h) (((b) * 2 + (h)) * HTB)
#define PG8_SB(b, h) ((4 + (b) * 2 + (h)) * HTB)
#define PG8_STAGE(bufoff, gbase, voff) do { _Pragma("unroll") for (int _i = 0; _i < 2; ++_i) \
        __builtin_amdgcn_global_load_lds((const unsigned*)((const char*)(gbase) + (voff)[_i]), (LAS unsigned*)(lds + (bufoff) + ldsw + _i * 8192), 16, 0, 0); } while (0)
#define PG8_LDA(dst, b, h) do { _Pragma("unroll") for (int m = 0; m < 4; ++m) _Pragma("unroll") for (int k = 0; k < 2; ++k) dst[m][k] = *(const LAS bf16x8*)(lds + PG8_SA(b, h) + aoff + m * 2048 + k * 1024); } while (0)
#define PG8_LDB(dst, b, h) do { _Pragma("unroll") for (int n = 0; n < 2; ++n) _Pragma("unroll") for (int k = 0; k < 2; ++k) dst[n][k] = *(const LAS bf16x8*)(lds + PG8_SB(b, h) + boff + n * 2048 + k * 1024); } while (0)
#define PG8_MMA(ai, bj, At, Bt) do { __builtin_amdgcn_s_setprio(1); _Pragma("unroll") for (int m = 0; m < 4; ++m) _Pragma("unroll") for (int n = 0; n < 2; ++n) _Pragma("unroll") for (int k = 0; k < 2; ++k) \
        acc[ai][bj][m][n] = __builtin_amdgcn_mfma_f32_16x16x32_bf16(Bt[n][k], At[m][k], acc[ai][bj][m][n], 0, 0, 0); __builtin_amdgcn_s_setprio(0); } while (0)
#define PG8_WAIT_V(n) asm volatile("s_waitcnt vmcnt(" #n ")" ::: "memory")
#define PG8_WAIT_L(n) asm volatile("s_waitcnt lgkmcnt(" #n ")" ::: "memory")
#define PG8_BAR __builtin_amdgcn_s_barrier()
#define PG8_SCHED __builtin_amdgcn_sched_barrier(0)
    f32x4 acc[2][2][4][2];
#pragma unroll
    for (int a = 0; a < 2; ++a)
#pragma unroll
        for (int b = 0; b < 2; ++b)
#pragma unroll
            for (int m = 0; m < 4; ++m)
#pragma unroll
                for (int n = 0; n < 2; ++n) acc[a][b][m][n] = (f32x4){0.f, 0.f, 0.f, 0.f};
    bf16x8 At[4][2], B0[2][2], B1[2][2];
    const char* cA = cur.A; const char* cB = cur.B;
    PG8_STAGE(PG8_SB(0, 0), cB, voffB); PG8_STAGE(PG8_SB(0, 1), cB + hstep, voffB); PG8_STAGE(PG8_SA(0, 0), cA, voffA); PG8_STAGE(PG8_SA(0, 1), cA + hstep, voffA);
    if (wr == 1) PG8_BAR;
    PG8_WAIT_V(2); PG8_BAR;
    PG8_STAGE(PG8_SB(1, 0), cB + kstep, voffB); PG8_STAGE(PG8_SA(1, 0), cA + kstep, voffA); PG8_STAGE(PG8_SB(1, 1), cB + hstep + kstep, voffB);
    PG8_WAIT_V(6); PG8_BAR;
    for (;;) {
        const bool has_next = S.next(ui + 1, nxt);
        const char* nA = has_next ? nxt.A : cA; const char* nB = has_next ? nxt.B : cB;
#if PROBE_KDUP_GI >= 0
        const int ntr = cur.nt, nt = S.kdup ? 2 * ntr : ntr;
#define PG8_TIDX(x) ((x) >= ntr ? (x) - ntr : (x))
#else
        const int nt = cur.nt;
#define PG8_TIDX(x) (x)
#endif
        for (int t = 0; t < nt; t += 2) {
            const bool last = (t == nt - 2);
            const char* a1 = cA + (size_t)(PG8_TIDX(t) + 1) * kstep;
            const char* a2 = last ? nA : cA + (size_t)PG8_TIDX(t + 2) * kstep; const char* b2 = last ? nB : cB + (size_t)PG8_TIDX(t + 2) * kstep;
            const char* a3 = a2 + kstep; const char* b3 = b2 + kstep;
            PG8_LDB(B0, 0, 0); PG8_LDB(B1, 0, 1); PG8_SCHED; PG8_LDA(At, 0, 0); PG8_STAGE(PG8_SA(1, 1), a1 + hstep, voffA);
            PG8_WAIT_V(8); PG8_WAIT_L(0); PG8_BAR; PG8_MMA(0, 0, At, B0); PG8_MMA(0, 1, At, B1); PG8_BAR; PG8_SCHED;
            PG8_LDA(At, 0, 1); PG8_STAGE(PG8_SB(0, 0), b2, voffB); PG8_STAGE(PG8_SB(0, 1), b2 + hstep, voffB); PG8_STAGE(PG8_SA(0, 0), a2, voffA);
            PG8_WAIT_V(8); PG8_WAIT_L(0); PG8_BAR; PG8_MMA(1, 0, At, B0); PG8_MMA(1, 1, At, B1); PG8_BAR; PG8_SCHED;
            PG8_LDB(B0, 1, 0); PG8_LDB(B1, 1, 1); PG8_SCHED; PG8_LDA(At, 1, 0); PG8_STAGE(PG8_SA(0, 1), a2 + hstep, voffA);
            PG8_WAIT_V(8); PG8_WAIT_L(0); PG8_BAR; PG8_MMA(0, 0, At, B0); PG8_MMA(0, 1, At, B1); PG8_BAR; PG8_SCHED;
            PG8_LDA(At, 1, 1); PG8_STAGE(PG8_SB(1, 0), b3, voffB); PG8_STAGE(PG8_SB(1, 1), b3 + hstep, voffB); PG8_STAGE(PG8_SA(1, 0), a3, voffA);
            PG8_WAIT_V(8); PG8_WAIT_L(0); PG8_BAR; PG8_MMA(1, 0, At, B0); PG8_MMA(1, 1, At, B1); PG8_BAR; PG8_SCHED;
        }
        if (wr == 0) PG8_BAR;
        E(acc, cur, wr, wc, fr, fq);
        if (!has_next) break;
#pragma unroll
        for (int a = 0; a < 2; ++a)
#pragma unroll
            for (int b = 0; b < 2; ++b)
#pragma unroll
                for (int m = 0; m < 4; ++m)
#pragma unroll
                    for (int n = 0; n < 2; ++n) acc[a][b][m][n] = (f32x4){0.f, 0.f, 0.f, 0.f};
        cur = nxt; cA = nA; cB = nB; ++ui;
        if (wr == 1) PG8_BAR;
    }
    PG8_WAIT_V(0);
    PG8_BAR;
#undef PG8_TIDX
#undef PG8_SA
#undef PG8_SB
#undef PG8_STAGE
#undef PG8_LDA
#undef PG8_LDB
#undef PG8_MMA
#undef PG8_WAIT_V
#undef PG8_WAIT_L
#undef PG8_BAR
#undef PG8_SCHED
}
}

struct Args { const float* in[21]; float* out; unsigned char* ws; int ph_lo, ph_hi; };

struct Frame {
    LAS unsigned char* lds;
    int tid, lane, wave, G, bid;
    const float* const* in; float* out; unsigned char* ws; int z;
};

template <int TAG = 0> DI Frame with_ids(Frame F) { unsigned ones = ~0u; asm volatile("; ids %1" : "+s"(ones) : "n"(TAG));
    F.lane = (int)__builtin_amdgcn_mbcnt_hi(ones, __builtin_amdgcn_mbcnt_lo(ones, 0u)); F.tid = F.wave * 64 + F.lane; return F; }

enum EpiDesc { D_HGRN = 0, D_M = 1, D_MSLAB = 2, D_FFN0 = 3, D_FFN1 = 4, D_DOWN = 5, D_Q = 6, D_KN = 7, D_VT = 8, D_VT2 = 9, D_VT2S = 10 };
DI float shl16_1(float v) { return __int_as_float(__builtin_amdgcn_update_dpp(0, __float_as_int(v), 0x101, 0xf, 0xf, false)); }
template <int N> DI float ror16(float v) { return __int_as_float(__builtin_amdgcn_update_dpp(0, __float_as_int(v), 0x120 + N, 0xf, 0xf, false)); }
struct EpiAll {
    unsigned char* ws; float* out; LAS unsigned char* lds; const float* const* in; int wave, z, which;
#if PROBE_KDUP_GI >= 0
    int kd;
#endif
    DI int hw_tid() const { unsigned ones = ~0u; asm volatile("" : "+s"(ones)); return wave * 64 + (int)__builtin_amdgcn_mbcnt_hi(ones, __builtin_amdgcn_mbcnt_lo(ones, 0u)); }
    DI void st_bf16(bf16_t* p, f32x4 v) const { u32x2 w; w.x = pk2(v[0], v[1]); w.y = pk2(v[2], v[3]); *(u32x2*)p = w; }
    DI static int PCOL(int fq) { return 4 * fq + ((fq & 1) ? 12 : 0); }
    DI static u32x4 pair16(u32x2 w0, u32x2 w1) {
        auto rx = __builtin_amdgcn_permlane16_swap(w0.x, w1.x, false, false); auto ry = __builtin_amdgcn_permlane16_swap(w0.y, w1.y, false, false);
        u32x4 r = {rx[0], ry[0], rx[1], ry[1]};
        asm volatile("" : "+v"(r.x), "+v"(r.y), "+v"(r.z), "+v"(r.w));
        return r;
    }
    DI static u32x2 pkb(f32x4 v) { return (u32x2){pk2(v[0], v[1]), pk2(v[2], v[3])}; }
    DI void ffn_epi(const f32x4 (&acc)[2][2][4][2], const pg8::Unit& u, int wr, int wc, int fr, int fq) const {
        { int t_ = hw_tid();
          const int lane_ = t_ & 63, wid_ = __builtin_amdgcn_readfirstlane(t_ >> 6); fr = lane_ & 15; fq = lane_ >> 4; wr = wid_ >> 2; wc = wid_ & 3; }
        const int layer = u.di - D_FFN0;
        float rs[2][4];
        { const float* R2 = (const float*)(ws + WS_R2);
#pragma unroll
          for (int ai = 0; ai < 2; ++ai)
#pragma unroll
              for (int m = 0; m < 4; ++m) { int gr_ = u.r0 + 128 * ai + 64 * wr + 16 * m + fr; gr_ = gr_ < 0 ? 0 : (gr_ >= T ? T - 1 : gr_); rs[ai][m] = R2[gr_]; } }
        LAS float* HALO = (LAS float*)(lds + 131072);
        if (fr >= 14) {
#pragma unroll
            for (int ai = 0; ai < 2; ++ai)
#pragma unroll
                for (int bj = 0; bj < 2; ++bj)
#pragma unroll
                    for (int n = 0; n < 2; ++n) *(LAS f32x4*)(HALO + ((2 * ai + wr) * 2 + (fr - 14)) * 256 + 128 * bj + 32 * wc + 16 * n + 4 * fq) = acc[ai][bj][3][n] * rs[ai][3];
        }
        asm volatile("s_waitcnt lgkmcnt(0)" ::: "memory"); __builtin_amdgcn_s_barrier(); asm volatile("" ::: "memory");
        const int f0 = u.r0 + 2, l0 = u.r0 + 255;
        const bool special = ((f0 & (SEQ - 1)) <= 1) || ((f0 >> 11) != (l0 >> 11)) || ((l0 & (SEQ - 1)) >= SEQ - 2) || (l0 >= TP);
        const float* cwl = as_global(in[18 + z]) + (size_t)layer * 3 * FF2; const float* cbl = as_global(in[19 + z]) + (size_t)layer * FF2; const float* sc = as_global(in[5 + z]);
        bf16_t* ACT = (bf16_t*)(ws + WS_ACT);
#pragma unroll
        for (int n = 0; n < 2; ++n) {
            const int tc = 32 * wc + 16 * n + 4 * fq, j0 = u.pn * 128 + tc;
            const f32x4 wg0 = *(const f32x4*)(cwl + j0), wg1 = *(const f32x4*)(cwl + FF2 + j0), wg2 = *(const f32x4*)(cwl + 2 * FF2 + j0), bg = *(const f32x4*)(cbl + j0);
            const f32x4 wu0 = *(const f32x4*)(cwl + FF + j0), wu1 = *(const f32x4*)(cwl + FF2 + FF + j0), wu2 = *(const f32x4*)(cwl + 2 * FF2 + FF + j0), bu = *(const f32x4*)(cbl + FF + j0);
#pragma unroll
            for (int ai = 0; ai < 2; ++ai) {
                const int sp = 2 * ai + wr;
                f32x4 pg = (f32x4){0.f, 0.f, 0.f, 0.f}, pu = pg;
                if (sp >= 1 && fr >= 14) { pg = *(const LAS f32x4*)(HALO + ((sp - 1) * 2 + (fr - 14)) * 256 + tc); pu = *(const LAS f32x4*)(HALO + ((sp - 1) * 2 + (fr - 14)) * 256 + 128 + tc); }
                f32x4 pg2, pu2;
#pragma unroll
                for (int i = 0; i < 4; ++i) { pg2[i] = ror16<2>(pg[i]); pu2[i] = ror16<2>(pu[i]); }
                asm volatile("" : "+v"(pg2[0]), "+v"(pg2[1]), "+v"(pg2[2]), "+v"(pg2[3]), "+v"(pu2[0]), "+v"(pu2[1]), "+v"(pu2[2]), "+v"(pu2[3]));
#pragma unroll
                for (int m = 0; m < 4; ++m) {
                    const f32x4 g = acc[ai][0][m][n] * rs[ai][m], uu = acc[ai][1][m][n] * rs[ai][m];
                    const int lr = 128 * ai + 64 * wr + 16 * m + fr, gr = u.r0 + lr;
                    f32x4 g1r, g2r, u1r, u2r;
#pragma unroll
                    for (int i = 0; i < 4; ++i) { g1r[i] = ror16<1>(g[i]); g2r[i] = ror16<2>(g[i]); u1r[i] = ror16<1>(uu[i]); u2r[i] = ror16<2>(uu[i]); }
                    f32x4 g1, g2, u1, u2, pg1, pu1;
#pragma unroll
                    for (int i = 0; i < 4; ++i) { pg1[i] = shl16_1(pg2[i]); pu1[i] = shl16_1(pu2[i]); }
                    asm volatile("" : "+v"(pg1[0]), "+v"(pg1[1]), "+v"(pg1[2]), "+v"(pg1[3]), "+v"(pu1[0]), "+v"(pu1[1]), "+v"(pu1[2]), "+v"(pu1[3]));
                    asm volatile("" : "+v"(g1r[0]), "+v"(g1r[1]), "+v"(g1r[2]), "+v"(g1r[3]), "+v"(u1r[0]), "+v"(u1r[1]), "+v"(u1r[2]), "+v"(u1r[3]));
                    asm volatile("" : "+v"(g2r[0]), "+v"(g2r[1]), "+v"(g2r[2]), "+v"(g2r[3]), "+v"(u2r[0]), "+v"(u2r[1]), "+v"(u2r[2]), "+v"(u2r[3]));
#pragma unroll
                    for (int i = 0; i < 4; ++i) { g1[i] = fr >= 1 ? g1r[i] : pg1[i]; g2[i] = fr >= 2 ? g2r[i] : pg2[i]; u1[i] = fr >= 1 ? u1r[i] : pu1[i]; u2[i] = fr >= 2 ? u2r[i] : pu2[i]; }
                    if (special && gr < T) {
                        const int p = gr < TP ? (gr & (SEQ - 1)) : ((gr - TP) & (DS - 1));
                        if (p < 2) {
                            const f32x4 z4 = (f32x4){0.f, 0.f, 0.f, 0.f};
                            if (gr >= TP) { const float* sp_ = sc + ((size_t)(layer * DB + ((gr - TP) >> 5)) * 2) * FF2 + j0;
                                if (p == 0) { g2 = *(const f32x4*)sp_; u2 = *(const f32x4*)(sp_ + FF); g1 = *(const f32x4*)(sp_ + FF2); u1 = *(const f32x4*)(sp_ + FF2 + FF); }
                                else { g2 = *(const f32x4*)(sp_ + FF2); u2 = *(const f32x4*)(sp_ + FF2 + FF); } }
                            else { if (p == 0) { g1 = z4; u1 = z4; } g2 = z4; u2 = z4; }
                        }
                        if (lr >= 2) {
                            if (gr < TP) { if (p >= SEQ - 2) { float* o = out + O_CONVP + ((size_t)((layer * NB + (gr >> 11)) * 2 + (p - (SEQ - 2)))) * FF2 + j0; *(f32x4*)o = g; *(f32x4*)(o + FF) = uu; } }
                            else if (p >= DS - 2) { float* o = out + O_CONVS + ((size_t)((layer * DB + ((gr - TP) >> 5)) * 2 + (p - (DS - 2)))) * FF2 + j0; *(f32x4*)o = g; *(f32x4*)(o + FF) = uu; }
                        }
                    }
                    if (lr >= 2 && gr < T) {
                        f32x4 a;
#pragma unroll
                        for (int i = 0; i < 4; ++i) { const float cg = bg[i] + wg0[i] * g2[i] + wg1[i] * g1[i] + wg2[i] * g[i], cu = bu[i] + wu0[i] * u2[i] + wu1[i] * u1[i] + wu2[i] * uu[i]; a[i] = siluf_(cg) * cu; }
                        st_bf16(ACT + (size_t)gr * FF + j0, a);
                    }
                    pg2 = g2r; pu2 = u2r;
                    __builtin_amdgcn_sched_barrier(0);
                }
            }
        }
    }
    DI void row_stats(const f32x4 (&acc)[2][2][4][2], int e, int pm, int pn, int wr, int wc, int fr, int fq, int t_, unsigned target) const {
        LAS float* P = (LAS float*)(lds + 131072); LAS float* S = (LAS float*)(lds + 131072 + 4096);
#pragma unroll
        for (int ai = 0; ai < 2; ++ai)
#pragma unroll
            for (int m = 0; m < 4; ++m) { float q = 0.f;
#pragma unroll
                for (int bj = 0; bj < 2; ++bj)
#pragma unroll
                    for (int n = 0; n < 2; ++n) { const f32x4 x = acc[ai][bj][m][n]; q += (x[0] * x[0] + x[1] * x[1]) + (x[2] * x[2] + x[3] * x[3]); }
                q += xor_lane<16>(q); q = sum_xor32(q);
                if (fq == 0) P[(128 * ai + 64 * wr + 16 * m + fr) * 4 + wc] = q; }
        asm volatile("s_waitcnt lgkmcnt(0)" ::: "memory"); __builtin_amdgcn_s_barrier(); asm volatile("" ::: "memory");
        unsigned* slots = (unsigned*)(ws + WS_XCH) + (size_t)((e * 32 + pm) * 256) * 8;
        unsigned* cnt = (unsigned*)(ws + WS_CTL + 16384) + (e * 32 + pm) * 64;
        if (t_ < 256) { const float t = (P[t_ * 4] + P[t_ * 4 + 1]) + (P[t_ * 4 + 2] + P[t_ * 4 + 3]);
            __hip_atomic_store(slots + t_ * 8 + pn, __float_as_uint(t), __ATOMIC_RELAXED, __HIP_MEMORY_SCOPE_AGENT); }
        asm volatile("s_waitcnt vmcnt(0)" ::: "memory");
        if ((t_ & 63) == 0) __hip_atomic_fetch_add(cnt, 1u, __ATOMIC_RELAXED, __HIP_MEMORY_SCOPE_AGENT);
        if (t_ < 64) {
            unsigned sp = 0;
            while ((unsigned)__builtin_amdgcn_readfirstlane(__hip_atomic_load(cnt, __ATOMIC_RELAXED, __HIP_MEMORY_SCOPE_AGENT)) < target) { __builtin_amdgcn_s_sleep(2); if (++sp > (1u << 22)) break; }
        }
        asm volatile("s_waitcnt vmcnt(0) lgkmcnt(0)" ::: "memory"); __builtin_amdgcn_s_barrier(); asm volatile("" ::: "memory");
        if (t_ < 256) { float tot = 0.f;
#pragma unroll
            for (int q = 0; q < 8; ++q) tot += __uint_as_float(__hip_atomic_load(slots + t_ * 8 + q, __ATOMIC_RELAXED, __HIP_MEMORY_SCOPE_AGENT));
            const float rr = __builtin_amdgcn_rsqf(tot * (1.f / DM) + EPS); S[t_] = rr;
            if (e == 1 && pn == 0) ((float*)(ws + WS_R2))[pm * 256 + t_] = rr; }
        asm volatile("s_waitcnt lgkmcnt(0)" ::: "memory"); __builtin_amdgcn_s_barrier(); asm volatile("" ::: "memory");
    }
    DI void res_epi(f32x4 (&acc)[2][2][4][2], const pg8::Unit& u, int wr, int wc, int fr, int fq) const {
        int t_ = hw_tid();
        { const int lane_ = t_ & 63, wid_ = __builtin_amdgcn_readfirstlane(t_ >> 6); fr = lane_ & 15; fq = lane_ >> 4; wr = wid_ >> 2; wc = wid_ & 3; }
        const LAS float* S = (const LAS float*)(lds + 131072 + 4096);
        const int pm = u.r0 >> 8, pn = u.pn; const unsigned target = 64u * (unsigned)(which + 1);
        const float* nw = as_global(in[6 + z]);
        const float* wa = nw + (which == 0 ? 1 : which == 1 ? 3 : which == 2 ? 5 : 7) * DM;
        const float* wb = which == 3 ? nullptr : nw + (which == 0 ? 2 : which == 1 ? 4 : 6) * DM;
        const float* xin32 = as_global(in[0 + z]);
        bf16_t* X16 = (bf16_t*)(ws + WS_X); float* yout = out + O_Y;
        const int col0 = pn * 256 + wc * 32 + 4 * fq;
        LAS float* WL = (LAS float*)(lds + 131072 + 5120);
        if (t_ < 64) *(LAS f32x4*)(WL + t_ * 4) = *(const f32x4*)(wa + pn * 256 + t_ * 4);
        const LAS float* wl = WL + wc * 32 + 4 * fq;
        u32x2 pre[2][4][2][2];
        if (which != 0) {
#pragma unroll
            for (int ai = 0; ai < 2; ++ai)
#pragma unroll
                for (int m = 0; m < 4; ++m) { const size_t ro = (size_t)(u.r0 + 128 * ai + 64 * wr + 16 * m + fr) * DM + col0;
#pragma unroll
                    for (int bj = 0; bj < 2; ++bj)
#pragma unroll
                        for (int n = 0; n < 2; ++n) pre[ai][m][bj][n] = *(const u32x2*)(X16 + ro + bj * 128 + n * 16); }
        }
        row_stats(acc, 0, pm, pn, wr, wc, fr, fq, t_, target);
#pragma unroll
        for (int ai = 0; ai < 2; ++ai)
#pragma unroll
            for (int m = 0; m < 4; ++m) { const int lr = 128 * ai + 64 * wr + 16 * m + fr; const float r1 = S[lr]; const size_t ro = (size_t)(u.r0 + lr) * DM + col0;
#pragma unroll
                for (int bj = 0; bj < 2; ++bj) { u32x2 w2[2];
#pragma unroll
                    for (int n = 0; n < 2; ++n) { const int co = bj * 128 + n * 16; const f32x4 ww = *(const LAS f32x4*)(wl + co);
                        f32x4 xi;
                        if (which == 0) xi = *(const f32x4*)(xin32 + ro + co);
                        else { const u32x2 p = pre[ai][m][bj][n]; xi = (f32x4){__uint_as_float(p.x << 16), __uint_as_float(p.x & 0xffff0000u), __uint_as_float(p.y << 16), __uint_as_float(p.y & 0xffff0000u)}; }
                        const f32x4 v = xi + acc[ai][bj][m][n] * r1 * ww; acc[ai][bj][m][n] = v;
                        if (which == 3) *(f32x4*)(yout + ro + co) = v; else w2[n] = pkb(v); }
                    if (which != 3) *(u32x4*)(X16 + (size_t)(u.r0 + lr) * DM + pn * 256 + wc * 32 + PCOL(fq) + bj * 128) = pair16(w2[0], w2[1]); }
                __builtin_amdgcn_sched_barrier(0); }
        if (wb) row_stats(acc, 1, pm, pn, wr, wc, fr, fq, t_, target);
    }

};
enum EpiGroup { G_HG = 0, G_RES = 1, G_FFN = 2, G_DOWN = 3, G_UP = 4 };
#define EPI_EACH4 _Pragma("unroll") for (int ai = 0; ai < 2; ++ai) _Pragma("unroll") for (int m = 0; m < 4; ++m) _Pragma("unroll") for (int bj = 0; bj < 2; ++bj) _Pragma("unroll") for (int n = 0; n < 2; ++n)
template <int G> struct EpiSel {
    EpiAll e;
    DI static void st_bf16(bf16_t* p, f32x4 v) { u32x2 w; w.x = pk2(v[0], v[1]); w.y = pk2(v[2], v[3]); *(u32x2*)p = w; }
    DI static int PCOL(int fq) { return 4 * fq + ((fq & 1) ? 12 : 0); }
    DI static void st_pair(unsigned char* p, u32x2 w0, u32x2 w1) {
        auto rx = __builtin_amdgcn_permlane16_swap(w0.x, w1.x, false, false);
        auto ry = __builtin_amdgcn_permlane16_swap(w0.y, w1.y, false, false);
        *(u32x4*)p = (u32x4){rx[0], ry[0], rx[1], ry[1]};
    }
    DI static u32x2 pkb(f32x4 v) { return (u32x2){pk2(v[0], v[1]), pk2(v[2], v[3])}; }
    DI static u32x2 pkh(f32x4 v) { const h16x2 p0 = {(_Float16)v[0], (_Float16)v[1]}, p1 = {(_Float16)v[2], (_Float16)v[3]}; return (u32x2){__builtin_bit_cast(unsigned, p0), __builtin_bit_cast(unsigned, p1)}; }
#define EPI_EACH3 _Pragma("unroll") for (int ai = 0; ai < 2; ++ai) _Pragma("unroll") for (int m = 0; m < 4; ++m) _Pragma("unroll") for (int bj = 0; bj < 2; ++bj)
    template <int STRIDE> DI static void plain_bf16(const f32x4 (&acc)[2][2][4][2], unsigned char* base, unsigned off0) {
        EPI_EACH3 st_pair(base + (off0 + (unsigned)(((size_t)(128 * ai + 16 * m) * STRIDE + 128 * bj) * 2)), pkb(acc[ai][bj][m][0]), pkb(acc[ai][bj][m][1]));
    }
    template <int STRIDE> DI static void plain_f32(const f32x4 (&acc)[2][2][4][2], unsigned char* base, unsigned off0) {
        EPI_EACH4 *(f32x4*)(base + (off0 + (unsigned)(((size_t)(128 * ai + 16 * m) * STRIDE + 128 * bj + 16 * n) * 4))) = acc[ai][bj][m][n];
    }
    template <int BJ> DI static void q_half(const f32x4 (&acc)[2][2][4][2], unsigned char* base, unsigned off0, int prow0, bool sample, int hc, int fq) {
        constexpr float QS = 0.07216878364870322f * 1.4426950408889634f;
        if (hc >= NOPE) {
            float f0[2], f1[2];
#pragma unroll
            for (int n = 0; n < 2; ++n) { const int i0 = (hc + 16 * n + 4 * fq - NOPE) >> 1;
                f0[n] = __builtin_amdgcn_exp2f((float)i0 * -0.41524101186092029f) * 0.15915494309189535f; f1[n] = __builtin_amdgcn_exp2f((float)(i0 + 1) * -0.41524101186092029f) * 0.15915494309189535f; }
#pragma unroll
            for (int ai = 0; ai < 2; ++ai)
#pragma unroll
                for (int m = 0; m < 4; ++m) { const int r = prow0 + 128 * ai + 16 * m; const float fp = (float)(sample ? PAST + (r & (DS - 1)) : (r & (SEQ - 1)));
                    u32x2 wq[2];
#pragma unroll
                    for (int n = 0; n < 2; ++n) { const f32x4 v = acc[ai][BJ][m][n]; const float r0 = __builtin_amdgcn_fractf(fp * f0[n]), r1 = __builtin_amdgcn_fractf(fp * f1[n]);
                        const float c0 = __builtin_amdgcn_cosf(r0), s0 = __builtin_amdgcn_sinf(r0), c1 = __builtin_amdgcn_cosf(r1), s1 = __builtin_amdgcn_sinf(r1); f32x4 o;
                        o[0] = v[0] * c0 - v[1] * s0; o[1] = v[1] * c0 + v[0] * s0; o[2] = v[2] * c1 - v[3] * s1; o[3] = v[3] * c1 + v[2] * s1;
                        wq[n] = pkb(o * QS); }
                    st_pair(base + (off0 + (unsigned)((128 * ai + 16 * m) * 3072 + 128 * BJ) * 2u), wq[0], wq[1]); }
        } else {
#pragma unroll
            for (int ai = 0; ai < 2; ++ai)
#pragma unroll
                for (int m = 0; m < 4; ++m) st_pair(base + (off0 + (unsigned)((128 * ai + 16 * m) * 3072 + 128 * BJ) * 2u), pkb(acc[ai][BJ][m][0] * QS), pkb(acc[ai][BJ][m][1] * QS));
        }
    }
    DI void operator()(f32x4 (&acc)[2][2][4][2], const pg8::Unit& u, int wr, int wc, int fr, int fq) const {
#if PROBE_KDUP_GI >= 0
        if (e.kd) {
#pragma unroll
            for (int a = 0; a < 2; ++a)
#pragma unroll
                for (int b = 0; b < 2; ++b)
#pragma unroll
                    for (int m = 0; m < 4; ++m)
#pragma unroll
                        for (int n = 0; n < 2; ++n) acc[a][b][m][n] = acc[a][b][m][n] * 0.5f; }
#endif
        if (G == G_FFN) { e.ffn_epi(acc, u, wr, wc, fr, fq); return; }
        if (G == G_RES && u.di == D_M) { e.res_epi(acc, u, wr, wc, fr, fq); return; }
        { int t_ = e.hw_tid(); const int lane_ = t_ & 63, wid_ = __builtin_amdgcn_readfirstlane(t_ >> 6); fr = lane_ & 15; fq = lane_ >> 4; wr = wid_ >> 2; wc = wid_ & 3; }
        unsigned char* ws = e.ws;
        const int di = u.di, row0 = u.r0 + wr * 64 + fr, col0 = u.pn * 256 + wc * 32 + fq * 4, colp = u.pn * 256 + wc * 32 + PCOL(fq);
        if (G == G_RES) {
            unsigned char* base = ws + WS_SLAB + (size_t)u.aux * TS * DM * 2; const unsigned off0 = (unsigned)((row0 - TP) * DM + colp) * 2u;
            EPI_EACH3 st_pair(base + (off0 + (unsigned)(((size_t)(128 * ai + 16 * m) * DM + 128 * bj) * 2)), pkh(acc[ai][bj][m][0]), pkh(acc[ai][bj][m][1]));
        }
        else if (G == G_DOWN) {
            const float* R2 = (const float*)(ws + WS_R2); float rs[2][4];
#pragma unroll
            for (int ai = 0; ai < 2; ++ai)
#pragma unroll
                for (int m = 0; m < 4; ++m) { const int r_ = row0 + 128 * ai + 16 * m; rs[ai][m] = R2[r_ < T ? r_ : T - 1]; }
            unsigned char* base = ws + WS_DOWN; const unsigned off0 = (unsigned)(row0 * NDOWNP + colp) * 2u;
            EPI_EACH3 st_pair(base + (off0 + (unsigned)(((size_t)(128 * ai + 16 * m) * NDOWNP + 128 * bj) * 2)), pkh(acc[ai][bj][m][0] * rs[ai][m]), pkh(acc[ai][bj][m][1] * rs[ai][m]));
        }
        else if (G == G_HG) {
            if (di == D_HGRN) {
                const int sec = u.pn >> 3, c0 = col0 & 2047; const unsigned eo = (unsigned)(row0 * DM + (colp & 2047));
                if (sec == 1) {
                    unsigned char* base = ws + WS_FG; const LAS float* lbp = (const LAS float*)(e.lds + 131072) + c0;
                    EPI_EACH3 { u32x2 wl[2];
#pragma unroll
                        for (int n = 0; n < 2; ++n) { const f32x4 l = *(const LAS f32x4*)(lbp + 128 * bj + 16 * n); const f32x4 v = acc[ai][bj][m][n]; f32x4 o;
                            for (int i = 0; i < 4; ++i) o[i] = __logf(l[i] + (1.f - l[i]) * sigmoidf_(v[i]));
                            wl[n] = pkh(o); }
                        st_pair(base + (eo * 2u + (unsigned)(((128 * ai + 16 * m) * DM + 128 * bj) * 2)), wl[0], wl[1]); }
                } else {
                    unsigned char* base = ws + (sec == 0 ? WS_QB : WS_SG);
                    EPI_EACH3 { u32x2 wl[2];
#pragma unroll
                        for (int n = 0; n < 2; ++n) { const f32x4 v = acc[ai][bj][m][n]; f32x4 o; for (int i = 0; i < 4; ++i) o[i] = siluf_(v[i]); wl[n] = pkb(o); }
                        st_pair(base + (eo * 2u + (unsigned)(((128 * ai + 16 * m) * DM + 128 * bj) * 2)), wl[0], wl[1]); }
                }
            } else { plain_bf16<T>(acc, ws + WS_VT2 + (di == D_VT2S ? (size_t)TP * 2 : 0), (unsigned)(row0 * T + colp) * 2u); }
        }
        else {
            if (di == D_KN)      plain_bf16<2048>(acc, ws + WS_KN, (unsigned)(row0 * 2048 + colp) * 2u);
            else if (di == D_VT) plain_bf16<KVROWS>(acc, ws + WS_VT, (unsigned)(row0 * KVROWS + colp) * 2u);
            else {
                const int hc0 = (u.pn * 256 + wc * 32) % QHD, hc1 = (u.pn * 256 + 128 + wc * 32) % QHD;
                const bool sample = u.r0 >= TP; const int prow0 = sample ? row0 - TP : row0;
                unsigned char* base = ws + WS_QA; const unsigned off0 = (unsigned)(row0 * 3072 + colp) * 2u;
                q_half<0>(acc, base, off0, prow0, sample, hc0, fq); q_half<1>(acc, base, off0, prow0, sample, hc1, fq);
            }
        }
    }
};
#undef EPI_EACH4
#undef EPI_EACH3


enum RowMap { RM_ID = 0, RM_UQ = 1, RM_UKV = 2, RM_HIN = 3, RM_FIN = 4 };
DI int map_row(int mode, int n) {
    if (mode == RM_UQ) { const int h = n / QHD, j = n % QHD; if (j < NOPE) return n; const int i = j - NOPE; return h * QHD + NOPE + (i < 32 ? 2 * i : 2 * (i - 32) + 1); }
    if (mode == RM_FIN) { const int j = n < FF ? n : n - FF; return 256 * (j >> 7) + (n < FF ? 0 : 128) + (j & 127); }
    if (mode == RM_HIN) { return n < 4096 ? n : (n < 6144 ? n + 2048 : n - 2048); }
    if (mode == RM_UKV) { const int h = n >> 8, j = n & 255; return (j < 128 ? 0 : 2048) + h * 128 + (j & 127); }
    return n;
}
DI void transpose_item(const float* W, int K, int N, bf16_t* WT, int mode, LAS float* scr, int item, int lane, const float* sk) {
    const int nblk = N / 32, kb = item / nblk, nb = item % nblk, k0 = 64 * kb, n0 = 32 * nb;
    float tv[32];
    { const float* wp = W + (size_t)(k0 + (lane >> 5)) * N + n0 + (lane & 31);
#pragma unroll
      for (int i = 0; i < 32; ++i) tv[i] = __builtin_nontemporal_load(wp + (size_t)(2 * i) * N); }
#pragma unroll
    for (int i = 0; i < 32; ++i) scr[(2 * i + (lane >> 5)) * 33 + (lane & 31)] = tv[i];
    asm volatile("s_waitcnt lgkmcnt(0)" ::: "memory");
    const int c = lane & 7;
    f32x4 ka = (f32x4){1.f, 1.f, 1.f, 1.f}, kc = ka;
    if (sk) { ka = *(const f32x4*)(sk + k0 + 8 * c); kc = *(const f32x4*)(sk + k0 + 8 * c + 4); }
#pragma unroll
    for (int j = 0; j < 4; ++j) { const int n = (lane >> 3) + 8 * j; const LAS float* s = scr + (8 * c) * 33 + n;
        u32x4 o; o.x = pk2(s[0 * 33] * ka[0], s[1 * 33] * ka[1]); o.y = pk2(s[2 * 33] * ka[2], s[3 * 33] * ka[3]); o.z = pk2(s[4 * 33] * kc[0], s[5 * 33] * kc[1]); o.w = pk2(s[6 * 33] * kc[2], s[7 * 33] * kc[3]);
        *(u32x4*)(WT + (size_t)map_row(mode, n0 + n) * K + k0 + 8 * c) = o; }
    asm volatile("s_waitcnt lgkmcnt(0)" ::: "memory");
}
DI const float* xrow_ptr(const Frame& F, int row) { return row < TP ? as_global(F.in[0 + F.z]) + (size_t)row * DM : as_global(F.in[1 + F.z]) + (size_t)(row - TP) * DM; }

DI void norm_row_bf16(const float* xr, const float* w, bf16_t* hr, int lane) {
    f32x4 v[8]; float s = 0.f;
#pragma unroll
    for (int j = 0; j < 8; ++j) { v[j] = *(const f32x4*)(xr + 4 * lane + 256 * j); s += (v[j][0] * v[j][0] + v[j][1] * v[j][1]) + (v[j][2] * v[j][2] + v[j][3] * v[j][3]); }
    const float r = __builtin_amdgcn_rsqf(wave_sum(s) * (1.f / DM) + EPS);
#pragma unroll
    for (int j = 0; j < 8; ++j) { const f32x4 ww = *(const f32x4*)(w + 4 * lane + 256 * j); u32x2 o; o.x = pk2(v[j][0] * r * ww[0], v[j][1] * r * ww[1]); o.y = pk2(v[j][2] * r * ww[2], v[j][3] * r * ww[3]);
        *(u32x2*)(hr + 4 * lane + 256 * j) = o; }
}

constexpr int I_HIN = 32 * 256, I_HOUT = 32 * 64, I_DOWN = 32 * 34, I_UQ = 8 * 96, I_UKV = 8 * 128, I_MOUT = 32 * 64, I_FIN = 32 * 352, I_FOUT = 88 * 64;
constexpr int CONV_NITEMS = I_HIN + I_HOUT + I_DOWN + I_UQ + I_UKV + I_MOUT + 2 * I_FIN + 2 * I_FOUT;
DI void convert_items(const Frame& F, int it0, int it1, int gw, int NGW) {
    LAS float* scr = (LAS float*)(F.lds + F.wave * 16384);
    unsigned char* ws = F.ws;
    for (int it = it0 + gw; it < it1; it += NGW) {
        int r = it; const float* W; bf16_t* WT; int K, N, mode = RM_ID; const float* sk = nullptr; const float* nw = as_global(F.in[6 + F.z]);
        if (r < I_HIN) { W = as_global(F.in[8 + F.z]); K = 2048; N = 8192; WT = (bf16_t*)(ws + WS_WT_HIN); mode = RM_HIN; }
        else if ((r -= I_HIN) < I_HOUT) { W = as_global(F.in[10 + F.z]); K = 2048; N = 2048; WT = (bf16_t*)(ws + WS_WT_HOUT); }
        else if ((r -= I_HOUT) < I_DOWN) { W = as_global(F.in[11 + F.z]); K = 2048; N = NDOWN; WT = (bf16_t*)(ws + WS_WT_DOWN); sk = nw + 4 * DM; }
        else if ((r -= I_DOWN) < I_UQ) { W = as_global(F.in[14 + F.z]); K = 512; N = 3072; WT = (bf16_t*)(ws + WS_WT_UQ); mode = RM_UQ; }
        else if ((r -= I_UQ) < I_UKV) { W = as_global(F.in[15 + F.z]); K = 512; N = 4096; WT = (bf16_t*)(ws + WS_WT_K); mode = RM_UKV; }
        else if ((r -= I_UKV) < I_MOUT) { W = as_global(F.in[16 + F.z]); K = 2048; N = 2048; WT = (bf16_t*)(ws + WS_WT_MOUT); }
        else if ((r -= I_MOUT) < 2 * I_FIN) { const int l = r / I_FIN; r -= l * I_FIN; W = as_global(F.in[17 + F.z]) + (size_t)l * 2048 * FF2; K = 2048; N = FF2; WT = (bf16_t*)(ws + WS_WT_FIN) + (size_t)l * FF2 * 2048; mode = RM_FIN; sk = nw + (l == 0 ? 2 : 6) * DM; }
        else { r -= 2 * I_FIN; const int l = r / I_FOUT; r -= l * I_FOUT; W = as_global(F.in[20 + F.z]) + (size_t)l * FF * 2048; K = FF; N = 2048; WT = (bf16_t*)(ws + WS_WT_FOUT) + (size_t)l * 2048 * FF; }
        transpose_item(W, K, N, WT, mode, scr, r, F.lane, sk);
    }
}
DI void convert_items_pipelined(const Frame& F, int it0, int it1, int gw, int NGW) {
    LAS float* scr = (LAS float*)(F.lds + F.wave * 16384);
    const float* W = as_global(F.in[8 + F.z]); bf16_t* WT = (bf16_t*)(F.ws + WS_WT_HIN);
    constexpr int K = 2048, N = 8192, nblk = N / 32;
    int it = it0 + gw; if (it >= it1) return;
    const int lane = F.lane; float tv[32];
    { const int k0 = 64 * (it / nblk), n0 = 32 * (it % nblk); const float* wp = W + (size_t)(k0 + (lane >> 5)) * N + n0 + (lane & 31);
#pragma unroll
      for (int i = 0; i < 32; ++i) tv[i] = __builtin_nontemporal_load(wp + (size_t)(2 * i) * N); }
    for (;;) {
        const int itn = it + NGW; const bool more = itn < it1; float tn[32];
        if (more) { const int k0 = 64 * (itn / nblk), n0 = 32 * (itn % nblk); const float* wp = W + (size_t)(k0 + (lane >> 5)) * N + n0 + (lane & 31);
#pragma unroll
            for (int i = 0; i < 32; ++i) tn[i] = __builtin_nontemporal_load(wp + (size_t)(2 * i) * N); }
        { const int k0 = 64 * (it / nblk), n0 = 32 * (it % nblk);
#pragma unroll
          for (int i = 0; i < 32; ++i) scr[(2 * i + (lane >> 5)) * 33 + (lane & 31)] = tv[i];
          asm volatile("s_waitcnt lgkmcnt(0)" ::: "memory");
          const int c = lane & 7;
#pragma unroll
          for (int j = 0; j < 4; ++j) { const int n = (lane >> 3) + 8 * j; const LAS float* p = scr + (8 * c) * 33 + n;
              u32x4 o; o.x = pk2(p[0 * 33], p[1 * 33]); o.y = pk2(p[2 * 33], p[3 * 33]); o.z = pk2(p[4 * 33], p[5 * 33]); o.w = pk2(p[6 * 33], p[7 * 33]);
              *(u32x4*)(WT + (size_t)map_row(RM_HIN, n0 + n) * K + k0 + 8 * c) = o; }
          asm volatile("s_waitcnt lgkmcnt(0)" ::: "memory"); }
        if (!more) break;
        it = itn;
#pragma unroll
        for (int i = 0; i < 32; ++i) tv[i] = tn[i];
    }
}
DI void phase_prep(const Frame& F) {
    const int gw = F.bid * NWAVES + F.wave, NGW = F.G * NWAVES;
    unsigned char* ws = F.ws;
    convert_items_pipelined(F, 0, I_HIN, gw, NGW);
    unsigned zz = 0u; asm volatile("" : "+v"(zz)); const u32x4 zero4 = {zz, zz, zz, zz};
    if (gw == 0) { u32x4* hp = (u32x4*)(ws + WS_HPAD); for (int i = F.lane; i < 2 * DM * 2 / 16; i += 64) hp[i] = zero4; }
    { const int gt = F.bid * NTHREADS + F.tid, NGT = F.G * NTHREADS; u32x4* p = (u32x4*)((bf16_t*)(ws + WS_WT_DOWN) + (size_t)NDOWN * 2048);
      for (int i = gt; i < (NDOWNP - NDOWN) * 256; i += NGT) p[i] = zero4; }
    { const int gt = F.bid * NTHREADS + F.tid, NGT = F.G * NTHREADS; float* tab = (float*)(ws + WS_TAB);
      for (int i = gt; i < 2048 * 32; i += NGT) { const int pos = i >> 5, k = i & 31;
          double inv = 1.0;
          for (int q = 0; q < k; ++q) inv *= 0.7498942093324559;
          const double rev = (double)pos * inv * 0.15915494309189535; const float fr = (float)(rev - floor(rev));
          tab[2 * i] = __builtin_amdgcn_cosf(fr); tab[2 * i + 1] = __builtin_amdgcn_sinf(fr); }
      float* lb = (float*)(ws + WS_LB); const float* lg = as_global(F.in[7 + F.z]);
      for (int i = gt; i < 2048; i += NGT) { const float a = lg[i], b = lg[2048 + i], c = lg[4096 + i]; const float mx = fmaxf(a, fmaxf(b, c));
          const float ea = fexp(a - mx), eb = fexp(b - mx), ec = fexp(c - mx); lb[i] = ea / (ea + eb + ec); } }
    { const float* nw0 = as_global(F.in[6 + F.z]); const int lane = F.lane;
      int m = gw; f32x4 v[8];
      if (m < T) { const float* xr = xrow_ptr(F, m);
#pragma unroll
          for (int j = 0; j < 8; ++j) v[j] = __builtin_nontemporal_load((const f32x4*)(xr + 4 * lane + 256 * j)); }
      while (m < T) {
          const int mn = m + NGW; f32x4 vn[8];
          if (mn < T) { const float* xr = xrow_ptr(F, mn);
#pragma unroll
              for (int j = 0; j < 8; ++j) vn[j] = __builtin_nontemporal_load((const f32x4*)(xr + 4 * lane + 256 * j)); }
          float sq = 0.f;
#pragma unroll
          for (int j = 0; j < 8; ++j) sq += (v[j][0] * v[j][0] + v[j][1] * v[j][1]) + (v[j][2] * v[j][2] + v[j][3] * v[j][3]);
          const float rr = __builtin_amdgcn_rsqf(wave_sum(sq) * (1.f / DM) + EPS);
          bf16_t* hr = (bf16_t*)(ws + WS_H) + (size_t)m * DM;
#pragma unroll
          for (int j = 0; j < 8; ++j) { const f32x4 ww = *(const f32x4*)(nw0 + 4 * lane + 256 * j); u32x2 o; o.x = pk2(v[j][0] * rr * ww[0], v[j][1] * rr * ww[1]); o.y = pk2(v[j][2] * rr * ww[2], v[j][3] * rr * ww[3]);
              *(u32x2*)(hr + 4 * lane + 256 * j) = o; }
          m = mn;
#pragma unroll
          for (int j = 0; j < 8; ++j) v[j] = vn[j];
      } }
}

#define MFMA32(a, b, c) __builtin_amdgcn_mfma_f32_32x32x16_bf16((a), (b), (c), 0, 0, 0)
DI int crow16(int reg, int hf) { return (reg & 3) + 8 * (reg >> 2) + 4 * hf; }
DI bf16x8 pack_half(const f32x16& x, int ks) {
    u32x4 w; w.x = pk2(x[8 * ks], x[8 * ks + 1]); w.y = pk2(x[8 * ks + 2], x[8 * ks + 3]); w.z = pk2(x[8 * ks + 4], x[8 * ks + 5]); w.w = pk2(x[8 * ks + 6], x[8 * ks + 7]); return __builtin_bit_cast(bf16x8, w);
}
DI void phase_scan(const Frame& F) {
    constexpr int PQ = 272, PK2 = 144;
    constexpr int L_QT = 0, L_KT = 64 * PQ, L_Q2 = 2 * 64 * PQ, L_K2T = 3 * 64 * PQ, L_P = L_K2T + 128 * PK2, L_DEC = L_P + 8 * 128 * 4, L_OB = L_DEC + 512;
    constexpr int OBP = 68;
    static_assert(L_OB + 2 * 128 * OBP * 4 + 512 <= MISC_OFF, "scan LDS map");
    LAS unsigned char* lds = F.lds;
    LAS float* P = (LAS float*)(lds + L_P); LAS float* DEC = (LAS float*)(lds + L_DEC); LAS float* OB = (LAS float*)(lds + L_OB);
    const bf16_t* Qb = (const bf16_t*)(F.ws + WS_QB); const _Float16* FG = (const _Float16*)(F.ws + WS_FG); const bf16_t* VT2 = (const bf16_t*)(F.ws + WS_VT2);
    const bf16_t* SG = (const bf16_t*)(F.ws + WS_SG); bf16_t* OG = (bf16_t*)(F.ws + WS_OG); const float* gnw = as_global(F.in[9 + F.z]);
    const int lane = F.lane, w = F.wave, r = lane & 31, hf = lane >> 5, dvb = w & 3, half = w >> 2;
    const bool late_sample = F.G == 256;
    if (late_sample && F.bid >= 64 && F.bid < 192) convert_items(F, I_HIN, CONV_NITEMS, (F.bid - 64) * NWAVES + F.wave, 192 * NWAVES);
    if (late_sample && F.bid >= 64 && F.bid < 192) {
        if (F.wave == 0) { unsigned sp = 0; unsigned* cnt = (unsigned*)(F.ws + WS_CTL + 32768);
            while ((unsigned)__builtin_amdgcn_readfirstlane(__hip_atomic_load(cnt, __ATOMIC_RELAXED, __HIP_MEMORY_SCOPE_AGENT)) < 64u) { __builtin_amdgcn_s_sleep(32); if (++sp > (1u << 18)) break; }
            __builtin_amdgcn_fence(__ATOMIC_ACQUIRE, "agent"); asm volatile("s_waitcnt vmcnt(0)" ::: "memory"); }
        __syncthreads();
    }
    for (int item = F.bid; item < 192; item += F.G) {
        int s, h, L, row0;
        if (item < 64) { s = item >> 4; h = item & 15; L = SEQ; row0 = s * SEQ; }
        else { const int it = item - 64; s = 4 + (it >> 4); h = it & 15; L = DS; row0 = TP + (s - 4) * DS; }
        const int nch = (L + 63) >> 6;
        f32x16 St[2];
        if (s < 4) {
#pragma unroll
            for (int d = 0; d < 2; ++d)
#pragma unroll
                for (int i = 0; i < 16; ++i) St[d][i] = 0.f;
        } else {
            int sb = (64 * half + 4 * hf) * DV + dvb * 32 + r; asm volatile("" : "+v"(sb));
            const float* st = as_global(F.in[2 + F.z]) + (size_t)((s - 4) * HH + h) * DK * DV + sb;
#pragma unroll
            for (int d = 0; d < 2; ++d)
#pragma unroll
                for (int i = 0; i < 16; ++i) St[d][i] = st[(32 * d + (i & 3) + 8 * (i >> 2)) * DV];
        }
        const int vrow = (h * DV + dvb * 32 + r) * T + row0;
        LAS float* GW = (LAS float*)(lds + L_OB + 2 * 128 * OBP * 4);
        if (F.tid < 128) GW[F.tid] = gnw[F.tid];
        unsigned fgN[8], qN[8], sgN[8]; u32x4 vnN[4]; u32x2 vkN[2][2];
#define SCAN_LOAD_A(CH) do { const int t0_ = (CH) * 64, nv_ = (L - t0_) < 64 ? (L - t0_) : 64; \
            int rb_ = (row0 + t0_) * DM + h * DK + 2 * lane; asm volatile("" : "+v"(rb_)); \
            _Pragma("unroll") for (int i = 0; i < 8; ++i) { const int ti = 8 * w + i, tl = ti < nv_ ? ti : nv_ - 1; \
                fgN[i] = *(const unsigned*)(FG + rb_ + tl * DM); qN[i] = *(const unsigned*)(Qb + rb_ + tl * DM); } } while (0)
#define SCAN_LOAD_V(CH) do { const int t0_ = (CH) * 64, nv_ = (L - t0_) < 64 ? (L - t0_) : 64; int vo_ = vrow + t0_; asm volatile("" : "+v"(vo_));   \
            _Pragma("unroll") for (int ks = 0; ks < 4; ++ks) { const int c_ = 16 * ks < nv_ ? 16 * ks : 0; vnN[ks] = *(const u32x4*)(VT2 + (vo_ + c_ + 8 * hf)); } \
            _Pragma("unroll") for (int k2 = 0; k2 < 2; ++k2) { const int c_ = (32 * half < nv_ ? 32 * half : 0) + 16 * k2 + 4 * hf; \
                vkN[k2][0] = *(const u32x2*)(VT2 + (vo_ + c_)); vkN[k2][1] = *(const u32x2*)(VT2 + (vo_ + c_ + 8)); } } while (0)
#define SCAN_LOAD_G(CH) do { const int t0_ = (CH) * 64, nv_ = (L - t0_) < 64 ? (L - t0_) : 64; \
            int rb_ = (row0 + t0_) * DM + h * DK + 2 * lane; asm volatile("" : "+v"(rb_)); \
            _Pragma("unroll") for (int i = 0; i < 8; ++i) { const int ti = 8 * w + i, tl = ti < nv_ ? ti : nv_ - 1; sgN[i] = *(const unsigned*)(SG + rb_ + tl * DM); } } while (0)
        SCAN_LOAD_A(0); SCAN_LOAD_V(0); SCAN_LOAD_G(0);
        for (int ch = 0; ch < nch; ++ch) {
            const int t0 = ch * 64, nvalid = (L - t0) < 64 ? (L - t0) : 64;
            int rbase = (row0 + t0 + 8 * w) * DM + h * DK + 2 * lane; asm volatile("" : "+v"(rbase));
            float fgv[8][2], qv[8][2];
            if (nvalid == 64) {
#pragma unroll
                for (int i = 0; i < 8; ++i) { const h16x2 lp = __builtin_bit_cast(h16x2, fgN[i]); fgv[i][0] = (float)lp.x; fgv[i][1] = (float)lp.y; qv[i][0] = __uint_as_float(qN[i] << 16); qv[i][1] = __uint_as_float(qN[i] & 0xffff0000u); }
            } else {
#pragma unroll
                for (int i = 0; i < 8; ++i) { const bool ok = (8 * w + i) < nvalid;
                    const h16x2 lp = __builtin_bit_cast(h16x2, fgN[i]); fgv[i][0] = ok ? (float)lp.x : 0.f; fgv[i][1] = ok ? (float)lp.y : 0.f;
                    qv[i][0] = ok ? __uint_as_float(qN[i] << 16) : 0.f; qv[i][1] = ok ? __uint_as_float(qN[i] & 0xffff0000u) : 0.f; }
            }
            float cum[8][2]; float run0 = 0.f, run1 = 0.f;
#pragma unroll
            for (int i = 0; i < 8; ++i) { run0 += fgv[i][0]; run1 += fgv[i][1]; cum[i][0] = run0; cum[i][1] = run1; }
            *(LAS f32x2*)(P + w * 128 + 2 * lane) = (f32x2){run0, run1};
            __syncthreads();
            float pre0 = 0.f, pre1 = 0.f, ref0 = 0.f, ref1 = 0.f, bl0 = 0.f, bl1 = 0.f;
#pragma unroll
            for (int q = 0; q < 8; ++q) { const f32x2 p = *(const LAS f32x2*)(P + q * 128 + 2 * lane); if (q < w) { pre0 += p[0]; pre1 += p[1]; } if (q < 4) { ref0 += p[0]; ref1 += p[1]; } bl0 += p[0]; bl1 += p[1]; }
            const float er0 = fexp(ref0), er1 = fexp(ref1), c20 = fexp(bl0 - ref0), c21 = fexp(bl1 - ref1);
            if (w == 0) *(LAS f32x2*)(DEC + 2 * lane) = (f32x2){fexp(bl0), fexp(bl1)};
            float k2c[2][8];
#pragma unroll
            for (int i = 0; i < 8; ++i) { const int t = 8 * w + i;
                const float e0 = fexp(pre0 + cum[i][0] - ref0), e1 = fexp(pre1 + cum[i][1] - ref1);
                const float qt0 = qv[i][0] * e0, qt1 = qv[i][1] * e1;
                const float kt0 = (1.f - fexp(fgv[i][0])) * __builtin_amdgcn_rcpf(e0), kt1 = (1.f - fexp(fgv[i][1])) * __builtin_amdgcn_rcpf(e1);
                *(LAS unsigned*)(lds + L_QT + t * PQ + 4 * lane) = pk2(qt0, qt1);
                *(LAS unsigned*)(lds + L_KT + t * PQ + 4 * lane) = pk2(kt0, kt1);
                *(LAS unsigned*)(lds + L_Q2 + t * PQ + 4 * lane) = pk2(qt0 * er0, qt1 * er1);
                k2c[0][i] = kt0 * c20; k2c[1][i] = kt1 * c21; }
#pragma unroll
            for (int c = 0; c < 2; ++c) { u32x4 o; o.x = pk2(k2c[c][0], k2c[c][1]); o.y = pk2(k2c[c][2], k2c[c][3]); o.z = pk2(k2c[c][4], k2c[c][5]); o.w = pk2(k2c[c][6], k2c[c][7]);
                *(LAS u32x4*)(lds + L_K2T + (2 * lane + c) * PK2 + 16 * w) = o; }
            __syncthreads();
            if (ch + 1 < nch) SCAN_LOAD_A(ch + 1);
            u32x4 vn[4]; u32x2 vk[2][2];
#pragma unroll
            for (int ks = 0; ks < 4; ++ks) { const bool ok = 16 * ks < nvalid; vn[ks] = ok ? vnN[ks] : (u32x4){0u, 0u, 0u, 0u}; }
#pragma unroll
            for (int k2 = 0; k2 < 2; ++k2) { const bool ok = 32 * half < nvalid; vk[k2][0] = ok ? vkN[k2][0] : (u32x2){0u, 0u}; vk[k2][1] = ok ? vkN[k2][1] : (u32x2){0u, 0u}; }
            if (ch + 1 < nch) SCAN_LOAD_V(ch + 1);
            f32x16 O[2];
#pragma unroll
            for (int d = 0; d < 2; ++d)
#pragma unroll
                for (int i = 0; i < 16; ++i) O[d][i] = 0.f;
            const bool live = (32 * half) < nvalid;
            if (live) {
#pragma unroll
                for (int tb = 0; tb < 2; ++tb) {
                    if (tb == 0 && half == 1) continue;
                    f32x16 X;
#pragma unroll
                    for (int i = 0; i < 16; ++i) X[i] = 0.f;
#pragma unroll
                    for (int ks = 0; ks < 8; ++ks) X = MFMA32(*(const LAS bf16x8*)(lds + L_KT + (32 * half + r) * PQ + 32 * ks + 16 * hf), *(const LAS bf16x8*)(lds + L_QT + (32 * tb + r) * PQ + 32 * ks + 16 * hf), X);
                    if (tb == half) {
#pragma unroll
                        for (int i = 0; i < 16; ++i) X[i] = (crow16(i, hf) <= r) ? X[i] : 0.f;
                    }
#pragma unroll
                    for (int k2 = 0; k2 < 2; ++k2) { const u32x4 vb = {vk[k2][0].x, vk[k2][0].y, vk[k2][1].x, vk[k2][1].y};
                        O[tb] = MFMA32(pack_half(X, k2), __builtin_bit_cast(bf16x8, vb), O[tb]); }
                }
            }
#pragma unroll
            for (int d = 0; d < 2; ++d)
#pragma unroll
                for (int k2 = 0; k2 < 2; ++k2) { const bf16x8 sb = pack_half(St[d], k2);
#pragma unroll
                    for (int tb = 0; tb < 2; ++tb) { const LAS unsigned char* qp = lds + L_Q2 + (32 * tb + r) * PQ + 2 * (64 * half + 32 * d + 16 * k2 + 4 * hf);
                        const u32x2 lo = *(const LAS u32x2*)qp, hi = *(const LAS u32x2*)(qp + 16); const u32x4 qa = {lo.x, lo.y, hi.x, hi.y};
                        O[tb] = MFMA32(__builtin_bit_cast(bf16x8, qa), sb, O[tb]); } }
#pragma unroll
            for (int tb = 0; tb < 2; ++tb)
#pragma unroll
                for (int g = 0; g < 4; ++g) *(LAS f32x4*)(OB + (half * 128 + dvb * 32 + r) * OBP + 32 * tb + 8 * g + 4 * hf) = (f32x4){O[tb][4 * g], O[tb][4 * g + 1], O[tb][4 * g + 2], O[tb][4 * g + 3]};
#pragma unroll
            for (int d = 0; d < 2; ++d) {
#pragma unroll
                for (int g = 0; g < 4; ++g) { const f32x4 dc = *(const LAS f32x4*)(DEC + 64 * half + 32 * d + 8 * g + 4 * hf);
#pragma unroll
                    for (int j = 0; j < 4; ++j) St[d][4 * g + j] *= dc[j]; }
#pragma unroll
                for (int ks = 0; ks < 4; ++ks) if (16 * ks < nvalid || nvalid == 64)
                    St[d] = MFMA32(*(const LAS bf16x8*)(lds + L_K2T + (64 * half + 32 * d + r) * PK2 + 32 * ks + 16 * hf), __builtin_bit_cast(bf16x8, vn[ks]), St[d]);
            }
            __syncthreads();
            { float o0[8], o1[8], q[8];
#pragma unroll
              for (int gq = 0; gq < 2; ++gq) {
                  const f32x4 a0 = *(const LAS f32x4*)(OB + (2 * lane) * OBP + 8 * w + 4 * gq), a1 = *(const LAS f32x4*)(OB + (2 * lane + 1) * OBP + 8 * w + 4 * gq);
                  const f32x4 b0 = *(const LAS f32x4*)(OB + (128 + 2 * lane) * OBP + 8 * w + 4 * gq), b1 = *(const LAS f32x4*)(OB + (128 + 2 * lane + 1) * OBP + 8 * w + 4 * gq);
#pragma unroll
                  for (int j = 0; j < 4; ++j) { const int i = 4 * gq + j; o0[i] = a0[j] + b0[j]; o1[i] = a1[j] + b1[j]; q[i] = o0[i] * o0[i] + o1[i] * o1[i]; } }
              float h4[4], h2[2], h1;
#pragma unroll
              for (int j = 0; j < 4; ++j) { const float keep = (lane & 1) ? q[2 * j + 1] : q[2 * j], send = (lane & 1) ? q[2 * j] : q[2 * j + 1]; h4[j] = keep + xor_lane<1>(send); }
#pragma unroll
              for (int j = 0; j < 2; ++j) { const float keep = (lane & 2) ? h4[2 * j + 1] : h4[2 * j], send = (lane & 2) ? h4[2 * j] : h4[2 * j + 1]; h2[j] = keep + xor_lane<2>(send); }
              { const float keep = (lane & 4) ? h2[1] : h2[0], send = (lane & 4) ? h2[0] : h2[1]; h1 = keep + xor_lane<4>(send); }
              h1 += xor_lane<8>(h1); h1 += xor_lane<16>(h1); h1 = sum_xor32(h1);
              const float rr_l = __builtin_amdgcn_rsqf(h1 * (1.f / DV) + EPS);
              const f32x2 gwv = *(const LAS f32x2*)(GW + 2 * lane); const float gw0 = gwv.x, gw1 = gwv.y;
#pragma unroll
              for (int i = 0; i < 8; ++i) { const int t = 8 * w + i;
                  const float rr = __int_as_float(__builtin_amdgcn_readlane(__float_as_int(rr_l), i));
                  if (t < nvalid) *(unsigned*)(OG + rbase + i * DM) = pk2(o0[i] * rr * gw0 * __uint_as_float(sgN[i] << 16), o1[i] * rr * gw1 * __uint_as_float(sgN[i] & 0xffff0000u)); } }
            if (ch + 1 < nch) SCAN_LOAD_G(ch + 1);
        }
        { int sb = (64 * half + 4 * hf) * DV + dvb * 32 + r; asm volatile("" : "+v"(sb));
          float* so = F.out + O_HG + (size_t)(s * HH + h) * DK * DV + sb;
#pragma unroll
          for (int d = 0; d < 2; ++d)
#pragma unroll
              for (int i = 0; i < 16; ++i) so[(32 * d + (i & 3) + 8 * (i >> 2)) * DV] = St[d][i]; }
    }
    if (!late_sample) {
        const int cb0 = F.G > 64 ? 64 : 0;
        if (F.bid >= cb0) { __syncthreads(); const Frame F3 = with_ids(F); convert_items(F3, I_HIN, CONV_NITEMS, (F3.bid - cb0) * NWAVES + F3.wave, (F3.G - cb0) * NWAVES); }
    }
}
DI void scan_late_tail(const Frame& F) {
    asm volatile("s_waitcnt vmcnt(0)" ::: "memory"); __syncthreads();
    const Frame F2 = with_ids(F);
    if (F2.tid == 0) { __builtin_amdgcn_fence(__ATOMIC_RELEASE, "agent"); asm volatile("s_waitcnt vmcnt(0)" ::: "memory");
        __hip_atomic_fetch_add((unsigned*)(F2.ws + WS_CTL + 32768), 1u, __ATOMIC_RELAXED, __HIP_MEMORY_SCOPE_AGENT); }
    __syncthreads();
    convert_items(F2, I_HIN, CONV_NITEMS, (F2.bid - 64) * NWAVES + F2.wave, 192 * NWAVES);
}

typedef _Float16 h16x4 __attribute__((ext_vector_type(4)));
DI f32x4 ld_h4(const _Float16* p) { const h16x4 h = *(const h16x4*)p; return (f32x4){(float)h[0], (float)h[1], (float)h[2], (float)h[3]}; }
DI void phase_rowpass(const Frame& F, int which) {
    const float* nw = as_global(F.in[6 + F.z]);
    const float* wa = nw + (which == 0 ? 1 : which == 1 ? 3 : which == 2 ? 5 : 7) * DM;
    const float* wb = which == 3 ? nullptr : nw + (which == 0 ? 2 : which == 1 ? 4 : 6) * DM;
    const int lane = F.lane, w = F.wave;
    { LAS float* red = (LAS float*)F.lds;
      const int nsl = (which & 1) ? KS_5632 : KS_2048; const int c = 256 * w + 4 * lane;
      for (int sr = F.bid; sr < TS; sr += F.G) {
          const int m = TP + sr;
          const _Float16* sl = (const _Float16*)(F.ws + WS_SLAB) + (size_t)sr * DM + c;
          f32x4 v = (f32x4){0.f, 0.f, 0.f, 0.f};
          if (which & 1) {
#pragma unroll
              for (int q = 0; q < KS_5632; ++q) v += ld_h4(sl + (size_t)q * TS * DM);
          } else {
#pragma unroll
              for (int q = 0; q < KS_2048; ++q) v += ld_h4(sl + (size_t)q * TS * DM);
          }
          (void)nsl;
          bf16_t* X16 = (bf16_t*)(F.ws + WS_X) + (size_t)m * DM;
          f32x4 xi;
          if (which == 0) xi = *(const f32x4*)(as_global(F.in[1 + F.z]) + (size_t)sr * DM + c);
          else { const u32x2 p = *(const u32x2*)(X16 + c); xi = (f32x4){__uint_as_float(p.x << 16), __uint_as_float(p.x & 0xffff0000u), __uint_as_float(p.y << 16), __uint_as_float(p.y & 0xffff0000u)}; }
          const f32x4 ww = *(const f32x4*)(wa + c);
          const float s1 = wave_sum((v[0] * v[0] + v[1] * v[1]) + (v[2] * v[2] + v[3] * v[3]));
          __syncthreads();
          if (lane == 0) red[w] = s1;
          __syncthreads();
          float t1 = 0.f;
#pragma unroll
          for (int q = 0; q < 8; ++q) t1 += red[q];
          const float r1 = __builtin_amdgcn_rsqf(t1 * (1.f / DM) + EPS);
          const f32x4 x1 = xi + v * r1 * ww;
          if (which == 3) *(f32x4*)(F.out + O_Y + (size_t)m * DM + c) = x1;
          else { u32x2 o; o.x = pk2(x1[0], x1[1]); o.y = pk2(x1[2], x1[3]); *(u32x2*)(X16 + c) = o; }
          if (wb) {
              const float s2 = wave_sum((x1[0] * x1[0] + x1[1] * x1[1]) + (x1[2] * x1[2] + x1[3] * x1[3]));
              if (lane == 0) red[8 + w] = s2;
              __syncthreads();
              float t2 = 0.f;
#pragma unroll
              for (int q = 0; q < 8; ++q) t2 += red[8 + q];
              const float r2 = __builtin_amdgcn_rsqf(t2 * (1.f / DM) + EPS);
              if (w == 0 && lane == 0) ((float*)(F.ws + WS_R2))[m] = r2;
          }
      }
    }
}

DI int kv_row_of(int row) { if (row < TP) return row; const int r = row - TP; return TP + (r >> 5) * KVSEQ + PAST + (r & 31); }
DI void phase_mlarow(const Frame& F) {
    const _Float16* DOWN = (const _Float16*)(F.ws + WS_DOWN); bf16_t* CQ = (bf16_t*)(F.ws + WS_CQ); bf16_t* CKVA = (bf16_t*)(F.ws + WS_CKVA); bf16_t* KPEA = (bf16_t*)(F.ws + WS_KPEA);
    const float* tab = (const float*)(F.ws + WS_TAB); const float* qw = as_global(F.in[12 + F.z]); const float* kw = as_global(F.in[13 + F.z]);
    const int lane = F.lane; const int gw = F.bid * NWAVES + F.wave, NGW = F.G * NWAVES;
    { int m = gw; f32x4 a[2], b[2]; float x1 = 0.f, x2 = 0.f;
#define MLA_LOAD(M, A_, B_, X1_, X2_) do { const _Float16* dr_ = DOWN + (size_t)(M) * NDOWNP; \
          _Pragma("unroll") for (int j = 0; j < 2; ++j) { A_[j] = ld_h4(dr_ + 4 * lane + 256 * j); B_[j] = ld_h4(dr_ + 512 + 4 * lane + 256 * j); } \
          X1_ = (float)dr_[1024 + (lane & 31)]; X2_ = (float)dr_[1024 + 32 + (lane & 31)]; } while (0)
      if (m < T) MLA_LOAD(m, a, b, x1, x2);
      while (m < T) {
          const int mn = m + NGW; f32x4 an[2], bn[2]; float x1n = 0.f, x2n = 0.f;
          if (mn < T) MLA_LOAD(mn, an, bn, x1n, x2n);
          const int kvr = kv_row_of(m); float sa = 0.f, sb = 0.f;
#pragma unroll
          for (int j = 0; j < 2; ++j) { sa += (a[j][0] * a[j][0] + a[j][1] * a[j][1]) + (a[j][2] * a[j][2] + a[j][3] * a[j][3]); sb += (b[j][0] * b[j][0] + b[j][1] * b[j][1]) + (b[j][2] * b[j][2] + b[j][3] * b[j][3]); }
          const float ra = __builtin_amdgcn_rsqf(wave_sum(sa) * (1.f / QL) + EPS), rb = __builtin_amdgcn_rsqf(wave_sum(sb) * (1.f / KVL) + EPS);
#pragma unroll
          for (int j = 0; j < 2; ++j) { const int c = 4 * lane + 256 * j; const f32x4 w1 = *(const f32x4*)(qw + c), w2 = *(const f32x4*)(kw + c);
              const f32x4 q = a[j] * ra * w1, kv = b[j] * rb * w2;
              u32x2 o; o.x = pk2(q[0], q[1]); o.y = pk2(q[2], q[3]); *(u32x2*)(CQ + (size_t)m * QL + c) = o;
              *(f32x4*)(F.out + O_CKV + (size_t)m * KVL + c) = kv;
              u32x2 o2; o2.x = pk2(kv[0], kv[1]); o2.y = pk2(kv[2], kv[3]); *(u32x2*)(CKVA + (size_t)kvr * KVL + c) = o2; }
          if (lane < 32) { const int pos = m < TP ? (m & (SEQ - 1)) : PAST + ((m - TP) & (DS - 1));
              const f32x2 cs = *(const f32x2*)(tab + ((size_t)pos * 32 + lane) * 2); const float o1 = x1 * cs[0] - x2 * cs[1], o2 = x2 * cs[0] + x1 * cs[1];
              F.out[O_KPE + (size_t)m * ROPE + lane] = o1; F.out[O_KPE + (size_t)m * ROPE + 32 + lane] = o2;
              *(unsigned*)(KPEA + (size_t)kvr * ROPE + 2 * lane) = pk2(o1, o2); }
          m = mn; a[0] = an[0]; a[1] = an[1]; b[0] = bn[0]; b[1] = bn[1]; x1 = x1n; x2 = x2n;
      }
#undef MLA_LOAD
    }
}

DI void convert_caches(const Frame& F, int gw, int NGW) {
    bf16_t* CKVA = (bf16_t*)(F.ws + WS_CKVA); bf16_t* KPEA = (bf16_t*)(F.ws + WS_KPEA); const int lane = F.lane;
    { const float* cckv = as_global(F.in[3 + F.z]); const float* ckpe = as_global(F.in[4 + F.z]);
      int i = gw; f32x4 v[2]; float x1 = 0.f, x2 = 0.f;
#define MLC_LOAD(I, V_, X1_, X2_) do { _Pragma("unroll") for (int j = 0; j < 2; ++j) V_[j] = __builtin_nontemporal_load((const f32x4*)(cckv + (size_t)(I) * KVL + 4 * lane + 256 * j)); \
          X1_ = ckpe[(size_t)(I) * ROPE + (lane & 31)]; X2_ = ckpe[(size_t)(I) * ROPE + 32 + (lane & 31)]; } while (0)
      if (i < DB * PAST) MLC_LOAD(i, v, x1, x2);
      while (i < DB * PAST) {
          const int in_ = i + NGW; f32x4 vn[2]; float x1n = 0.f, x2n = 0.f;
          if (in_ < DB * PAST) MLC_LOAD(in_, vn, x1n, x2n);
          const int b = i >> 10, p = i & (PAST - 1); const int kvr = TP + b * KVSEQ + p;
#pragma unroll
          for (int j = 0; j < 2; ++j) { const int c = 4 * lane + 256 * j; u32x2 o; o.x = pk2(v[j][0], v[j][1]); o.y = pk2(v[j][2], v[j][3]); *(u32x2*)(CKVA + (size_t)kvr * KVL + c) = o; }
          if (lane < 32) *(unsigned*)(KPEA + (size_t)kvr * ROPE + 2 * lane) = pk2(x1, x2);
          i = in_; v[0] = vn[0]; v[1] = vn[1]; x1 = x1n; x2 = x2n;
      }
#undef MLC_LOAD
    }
}

struct AttnState { f32x16 ot[4]; float mrun, lrun; };
DI void attn_softmax_pv_begin(f32x16& sc, AttnState& st, bf16x8 (&pf)[2]) {
    float mx = sc[0];
#pragma unroll
    for (int i = 1; i < 16; ++i) mx = fmaxf(mx, sc[i]);
    mx = max_xor32(mx);
    const float mnew = fmaxf(st.mrun, mx), alpha = __builtin_amdgcn_exp2f(st.mrun - mnew);
    float ps = 0.f;
#pragma unroll
    for (int i = 0; i < 16; ++i) { sc[i] = __builtin_amdgcn_exp2f(sc[i] - mnew); ps += sc[i]; }
    st.lrun = st.lrun * alpha + ps; st.mrun = mnew;
#pragma unroll
    for (int d = 0; d < 4; ++d)
#pragma unroll
        for (int i = 0; i < 16; ++i) st.ot[d][i] *= alpha;
    pf[0] = pack_half(sc, 0); pf[1] = pack_half(sc, 1);
}
constexpr int AK_PITCH = 400, AV_PITCH = 136, A_VOFF = 64 * AK_PITCH, A_BUF = A_VOFF + 128 * AV_PITCH;
static_assert(2 * A_BUF <= 131072, "attention LDS map");
DI void attn_prompt_unit(const Frame& F, int s, int h, int qb8) {
    const bf16_t* QA = (const bf16_t*)(F.ws + WS_QA); const bf16_t* KN = (const bf16_t*)(F.ws + WS_KN); const bf16_t* KPEA = (const bf16_t*)(F.ws + WS_KPEA); const bf16_t* VT = (const bf16_t*)(F.ws + WS_VT);
    bf16_t* AO = (bf16_t*)(F.ws + WS_AO);
    LAS unsigned char* lds = F.lds;
    const int tid = F.tid, lane = F.lane, w = F.wave, r = lane & 31, hf = lane >> 5;
    const int kvbase = s * SEQ, qrow0 = s * SEQ + 256 * qb8 + 32 * w, nT = 4 * (qb8 + 1), my_last = 4 * qb8 + (w >> 1);
    bf16x8 qf[12];
    { const bf16_t* qp = QA + (size_t)(qrow0 + r) * 3072 + h * QHD + 8 * hf;
#pragma unroll
      for (int k = 0; k < 12; ++k) qf[k] = *(const bf16x8*)(qp + 16 * k); }
    AttnState st;
#pragma unroll
    for (int d = 0; d < 4; ++d)
#pragma unroll
        for (int i = 0; i < 16; ++i) st.ot[d][i] = 0.f;
    st.mrun = -INFINITY; st.lrun = 0.f;
    unsigned kno[2], vto[2]; int kndst[2], vtdst[2];
#pragma unroll
    for (int i = 0; i < 2; ++i) { const int p = tid + 512 * i;
        kno[i] = (unsigned)((p >> 4) * 2048 + 8 * (p & 15)); kndst[i] = (p >> 4) * AK_PITCH + 16 * (p & 15);
        vto[i] = (unsigned)((p >> 3) * KVROWS + 8 * (p & 7)); vtdst[i] = A_VOFF + (p >> 3) * AV_PITCH + 16 * (p & 7); }
    const unsigned peo = (unsigned)((tid >> 3) * ROPE + 8 * (tid & 7)); const int pedst = (tid >> 3) * AK_PITCH + 256 + 16 * (tid & 7);
    const bf16_t* knB = KN + (size_t)kvbase * 2048 + h * NOPE; const bf16_t* peB = KPEA + (size_t)kvbase * ROPE; const bf16_t* vtB = VT + (size_t)(h * VD) * KVROWS + kvbase;
    u32x4 sk0, sk1, sp, sv0, sv1;
#define ATT_LOAD(T) do { const bf16_t* kn_ = knB + (size_t)(T) * 64 * 2048; const bf16_t* pe_ = peB + (size_t)(T) * 64 * ROPE; const bf16_t* vt_ = vtB + (T) * 64; \
        sk0 = *(const u32x4*)(kn_ + kno[0]); sk1 = *(const u32x4*)(kn_ + kno[1]); sp = *(const u32x4*)(pe_ + peo); sv0 = *(const u32x4*)(vt_ + vto[0]); sv1 = *(const u32x4*)(vt_ + vto[1]); } while (0)
#define ATT_WRITE(B) do { LAS unsigned char* b_ = lds + (B) * A_BUF; \
        *(LAS u32x4*)(b_ + kndst[0]) = sk0; *(LAS u32x4*)(b_ + kndst[1]) = sk1; *(LAS u32x4*)(b_ + pedst) = sp; \
        *(LAS u32x2*)(b_ + vtdst[0]) = (u32x2){sv0.x, sv0.y}; *(LAS u32x2*)(b_ + vtdst[0] + 8) = (u32x2){sv0.z, sv0.w}; \
        *(LAS u32x2*)(b_ + vtdst[1]) = (u32x2){sv1.x, sv1.y}; *(LAS u32x2*)(b_ + vtdst[1] + 8) = (u32x2){sv1.z, sv1.w}; } while (0)
    ATT_LOAD(0); ATT_WRITE(0);
    __syncthreads();
    for (int t = 0; t < nT; ++t) {
        if (t + 1 < nT) ATT_LOAD(t + 1);
        if (t <= my_last) {
            const LAS unsigned char* kb = lds + (t & 1) * A_BUF; const LAS unsigned char* vb = kb + A_VOFF;
#pragma unroll 1
            for (int hh = 0; hh < 2; ++hh) {
                bf16x8 kf[12];
#pragma unroll
                for (int k = 0; k < 12; ++k) kf[k] = *(const LAS bf16x8*)(kb + (32 * hh + r) * AK_PITCH + 32 * k + 16 * hf);
                __builtin_amdgcn_sched_barrier(0);
                f32x16 sc;
#pragma unroll
                for (int i = 0; i < 16; ++i) sc[i] = 0.f;
#pragma unroll
                for (int k = 0; k < 12; ++k) sc = MFMA32(kf[k], qf[k], sc);
                u32x2 vlo[8], vhi[8];
#pragma unroll
                for (int d = 0; d < 4; ++d)
#pragma unroll
                    for (int ks = 0; ks < 2; ++ks) { const LAS unsigned char* vp = vb + (32 * d + r) * AV_PITCH + 2 * (32 * hh + 16 * ks + 4 * hf);
                        vlo[2 * d + ks] = *(const LAS u32x2*)vp; vhi[2 * d + ks] = *(const LAS u32x2*)(vp + 16); }
                __builtin_amdgcn_sched_barrier(0);
                bf16x8 pf[2]; attn_softmax_pv_begin(sc, st, pf);
#pragma unroll
                for (int d = 0; d < 4; ++d)
#pragma unroll
                    for (int ks = 0; ks < 2; ++ks) { const u32x4 vv = {vlo[2 * d + ks].x, vlo[2 * d + ks].y, vhi[2 * d + ks].x, vhi[2 * d + ks].y};
                        st.ot[d] = MFMA32(__builtin_bit_cast(bf16x8, vv), pf[ks], st.ot[d]); }
            }
        }
        if (t + 1 < nT) ATT_WRITE((t + 1) & 1);
        __syncthreads();
    }
#undef ATT_LOAD
#undef ATT_WRITE
    const float inv = __builtin_amdgcn_rcpf(sum_xor32(st.lrun));
    bf16_t* op = AO + (size_t)(qrow0 + r) * DM + h * VD + 4 * hf;
#pragma unroll
    for (int d = 0; d < 4; ++d)
#pragma unroll
        for (int g = 0; g < 4; ++g) { u32x2 o; o.x = pk2(st.ot[d][4 * g] * inv, st.ot[d][4 * g + 1] * inv); o.y = pk2(st.ot[d][4 * g + 2] * inv, st.ot[d][4 * g + 3] * inv); *(u32x2*)(op + d * 32 + 8 * g) = o; }
}
DI void attn_sample_unit(const Frame& F, int b, int h) {
    const bf16_t* QA = (const bf16_t*)(F.ws + WS_QA); const bf16_t* KN = (const bf16_t*)(F.ws + WS_KN); const bf16_t* KPEA = (const bf16_t*)(F.ws + WS_KPEA); const bf16_t* VT = (const bf16_t*)(F.ws + WS_VT);
    bf16_t* AO = (bf16_t*)(F.ws + WS_AO);
    const int lane = F.lane, w = F.wave, r = lane & 31, hf = lane >> 5;
    const int qrow0 = TP + b * DS, kvbase = TP + b * KVSEQ;
    const int tb = 4 * w + (w > 0 ? 1 : 0), te = tb + (w == 0 ? 5 : 4);
    bf16x8 qf[12];
    { const bf16_t* qp = QA + (size_t)(qrow0 + r) * 3072 + h * QHD + 8 * hf;
#pragma unroll
      for (int k = 0; k < 12; ++k) qf[k] = *(const bf16x8*)(qp + 16 * k); }
    AttnState st;
#pragma unroll
    for (int d = 0; d < 4; ++d)
#pragma unroll
        for (int i = 0; i < 16; ++i) st.ot[d][i] = 0.f;
    st.mrun = -INFINITY; st.lrun = 0.f;
    for (int t = tb; t < te; ++t) {
        const int key0 = 32 * t;
        const bf16_t* kp = KN + (size_t)(kvbase + key0 + r) * 2048 + h * NOPE + 8 * hf;
        const bf16_t* pp = KPEA + (size_t)(kvbase + key0 + r) * ROPE + 8 * hf;
        f32x16 sc;
#pragma unroll
        for (int i = 0; i < 16; ++i) sc[i] = 0.f;
#pragma unroll
        for (int k = 0; k < 8; ++k) sc = MFMA32(*(const bf16x8*)(kp + 16 * k), qf[k], sc);
#pragma unroll
        for (int k = 0; k < 4; ++k) sc = MFMA32(*(const bf16x8*)(pp + 16 * k), qf[8 + k], sc);
        bf16x8 pf[2]; attn_softmax_pv_begin(sc, st, pf);
#pragma unroll
        for (int d = 0; d < 4; ++d) {
            const bf16_t* vp = VT + (size_t)(h * VD + d * 32 + r) * KVROWS + kvbase + key0 + 4 * hf;
#pragma unroll
            for (int ks = 0; ks < 2; ++ks) { const u32x2 lo = *(const u32x2*)(vp + 16 * ks), hi = *(const u32x2*)(vp + 16 * ks + 8); const u32x4 vv = {lo.x, lo.y, hi.x, hi.y};
                st.ot[d] = MFMA32(__builtin_bit_cast(bf16x8, vv), pf[ks], st.ot[d]); }
        }
    }
    LAS float* OT = (LAS float*)F.lds; LAS float* ML = (LAS float*)(F.lds + 131072);
    const float lsum = sum_xor32(st.lrun);
#pragma unroll
    for (int d = 0; d < 4; ++d)
#pragma unroll
        for (int i = 0; i < 16; ++i) OT[(w * 64 + 16 * d + i) * 64 + lane] = st.ot[d][i];
    if (hf == 0) { ML[w * 64 + r] = st.mrun; ML[w * 64 + 32 + r] = lsum; }
    __syncthreads();
    float M = -INFINITY;
#pragma unroll
    for (int q = 0; q < 8; ++q) M = fmaxf(M, ML[q * 64 + r]);
    float sc8[8], Lt = 0.f;
#pragma unroll
    for (int q = 0; q < 8; ++q) { sc8[q] = __builtin_amdgcn_exp2f(ML[q * 64 + r] - M); Lt += ML[q * 64 + 32 + r] * sc8[q]; }
    const float inv = __builtin_amdgcn_rcpf(Lt);
    const int d = w >> 1;
    bf16_t* op = AO + (size_t)(qrow0 + r) * DM + h * VD + 4 * hf + d * 32;
#pragma unroll
    for (int gg = 0; gg < 2; ++gg) { const int g = 2 * (w & 1) + gg; float o[4];
#pragma unroll
        for (int j = 0; j < 4; ++j) { float acc = 0.f;
#pragma unroll
            for (int q = 0; q < 8; ++q) acc += OT[(q * 64 + 16 * d + 4 * g + j) * 64 + lane] * sc8[q];
            o[j] = acc * inv; }
        u32x2 ov; ov.x = pk2(o[0], o[1]); ov.y = pk2(o[2], o[3]); *(u32x2*)(op + 8 * g) = ov; }
    __syncthreads();
}
DI void phase_attn(const Frame& F) {
    const int vcu = (F.G % 8 == 0) ? (F.bid % 8) * (F.G / 8) + F.bid / 8 : F.bid;
    for (int p = vcu; p < NB * HH * 4; p += F.G) { const int sh = p >> 2, pr = p & 3, s = sh >> 4, h = sh & 15;
        const int n = pr == 0 ? 1 : pr == 3 ? 3 : 2;
#pragma unroll 1
        for (int k = 0; k < n; ++k) { int qb8 = pr == 0 ? 6 : pr == 1 ? (k == 0 ? 5 : 0) : pr == 2 ? (k == 0 ? 7 : 2) : (k == 0 ? 4 : k == 1 ? 3 : 1);
            asm volatile("" : "+s"(qb8)); attn_prompt_unit(F, s, h, qb8); }
    }
    const Frame F2 = with_ids<9>(F);
    for (int p = vcu; p < NB * HH * 4; p += F2.G) if ((p & 3) < 2) { const int u = (p >> 2) * 2 + (p & 3); attn_sample_unit(F2, u >> 4, u & 15); }
}

#define GRP(Aoff, Boff, rs0, rstep, nM, nN, ks, ntk, di) { S.g[S.ng] = {ws + (Aoff), ws + (Boff), rs0, rstep, nM, nN, ks, ntk, di}; ++S.ng; }
DI void run_gemm(const Frame& F, int gi) {
    unsigned char* ws = F.ws; pg8::PhaseSched S; S.ng = 0; S.G = F.G; S.c = F.bid; S.K = (gi == 3 || gi == 8) ? FF : (gi == 5 ? 512 : 2048);
    if (gi == 9) { S.G = 64; S.c = F.bid - (F.G - 64); }
    switch (gi) {
    case 0: GRP(WS_H, WS_WT_HIN, 0, 256, 32, 24, 1, 32, D_HGRN) GRP(WS_WT_HIN + (size_t)6144 * 2048 * 2, WS_H, 0, 256, 8, 32, 1, 32, D_VT2) break;
    case 9: GRP(WS_H, WS_WT_HIN, TP, 256, 1, 24, 1, 32, D_HGRN) GRP(WS_WT_HIN + (size_t)6144 * 2048 * 2, WS_H + (size_t)TP * 2048 * 2, 0, 256, 8, 1, 1, 32, D_VT2S) break;
    case 1: GRP(WS_OG, WS_WT_HOUT, 0, 256, 32, 8, 1, 32, D_M) GRP(WS_OG, WS_WT_HOUT, TP, 256, 1, 8, KS_2048, 32 / KS_2048, D_MSLAB) break;
    case 2: GRP(WS_X, WS_WT_FIN, -2, 254, 34, 44, 1, 32, D_FFN0) break;
    case 3: GRP(WS_ACT, WS_WT_FOUT, 0, 256, 32, 8, 1, 88, D_M) GRP(WS_ACT, WS_WT_FOUT, TP, 256, 1, 8, KS_5632, 88 / KS_5632, D_MSLAB) break;
    case 4: GRP(WS_X, WS_WT_DOWN, 0, 256, 33, 5, 1, 32, D_DOWN) break;
    case 5: GRP(WS_CKVA, WS_WT_K, 0, 256, 65, 8, 1, 8, D_KN) GRP(WS_WT_V, WS_CKVA, 0, 256, 8, 65, 1, 8, D_VT) GRP(WS_CQ, WS_WT_UQ, 0, 256, 33, 12, 1, 8, D_Q) break;
    case 6: GRP(WS_AO, WS_WT_MOUT, 0, 256, 32, 8, 1, 32, D_M) GRP(WS_AO, WS_WT_MOUT, TP, 256, 1, 8, KS_2048, 32 / KS_2048, D_MSLAB) break;
    case 7: GRP(WS_X, WS_WT_FIN + (size_t)FF2 * 2048 * 2, -2, 254, 34, 44, 1, 32, D_FFN1) break;
    default: GRP(WS_ACT, WS_WT_FOUT + (size_t)2048 * FF * 2, 0, 256, 32, 8, 1, 88, D_M) GRP(WS_ACT, WS_WT_FOUT + (size_t)2048 * FF * 2, TP, 256, 1, 8, KS_5632, 88 / KS_5632, D_MSLAB) break;
    }
#if PROBE_KDUP_GI >= 0
    EpiAll E{F.ws, F.out, F.lds, F.in, F.wave, F.z, gi == 1 ? 0 : gi == 3 ? 1 : gi == 6 ? 2 : 3, gi == PROBE_KDUP_GI}; S.kdup = (gi == PROBE_KDUP_GI);
#else
    EpiAll E{F.ws, F.out, F.lds, F.in, F.wave, F.z, gi == 1 ? 0 : gi == 3 ? 1 : gi == 6 ? 2 : 3};
#endif
    if (gi == 0 || gi == 9) {
        const Frame F2 = with_ids(F); *(LAS f32x4*)(F2.lds + 131072 + F2.tid * 16) = *(const f32x4*)((const float*)(ws + WS_LB) + F2.tid * 4);
        __syncthreads(); }
    if (gi == 0 || gi == 9)      pg8::gemm_phase(F.lds, S, EpiSel<G_HG>{E}, F.wave);
    else if (gi == 2 || gi == 7) pg8::gemm_phase(F.lds, S, EpiSel<G_FFN>{E}, F.wave);
    else if (gi == 4)            pg8::gemm_phase(F.lds, S, EpiSel<G_DOWN>{E}, F.wave);
    else if (gi == 5)            pg8::gemm_phase(F.lds, S, EpiSel<G_UP>{E}, F.wave);
    else                         pg8::gemm_phase(F.lds, S, EpiSel<G_RES>{E}, F.wave);
    if (gi == 4 && F.bid >= 165) {
        const Frame F2 = with_ids(F); convert_caches(F2, (F2.bid - 165) * NWAVES + F2.wave, (F2.G - 165) * NWAVES); }
}
#undef GRP

#define XB_TMO      128
#define XB_XCNT(j)  (256  + 64 * (j))
#define XB_XSUB(j)  (1280 + 64 * (j))
#define XB_XGEN(j)  (2304 + 64 * (j))
#define XB_TOP      3328
#define XB_TOPGEN   3392
#define XCD_BAR_WORDS 3456
#define XB_SPIN_CAP (1u << 18)
__device__ __forceinline__ unsigned xb_ld(unsigned* p)              { return __hip_atomic_load(p, __ATOMIC_RELAXED, __HIP_MEMORY_SCOPE_AGENT); }
__device__ __forceinline__ unsigned xb_add(unsigned* p, unsigned v) { return __hip_atomic_fetch_add(p, v, __ATOMIC_RELAXED, __HIP_MEMORY_SCOPE_AGENT); }
__device__ __forceinline__ unsigned xb_xcc_id() { return (unsigned)__builtin_amdgcn_s_getreg((3 << 11) | 20) & 0xFu; }
#define XB_SPIN(cond, bar) do { unsigned _sp = 0; while (cond) { __builtin_amdgcn_s_sleep(1); \
    if ((++_sp & 255u) == 0u) { if (xb_ld(&(bar)[XB_TMO])) break; if (_sp > XB_SPIN_CAP) { atomicAdd(&(bar)[XB_TMO], 1u); break; } } } } while (0)
struct XcdBarrier { unsigned* bar; unsigned x; volatile LAS unsigned* st; };
__device__ __forceinline__ XcdBarrier xcd_barrier_post(unsigned* bar, volatile LAS unsigned* st) {
    XcdBarrier b; b.bar = bar; b.x = xb_xcc_id(); b.st = st;
    if (threadIdx.x == 0) (void)xb_add(&bar[XB_XCNT(b.x)], 1u);
    return b;
}
__device__ __forceinline__ void xcd_barrier_complete(unsigned* bar, unsigned x, unsigned& nloc, unsigned& nx) {
    const unsigned G = gridDim.x * gridDim.y * gridDim.z;
    unsigned sum, cnt, mine, sp = 0u;
    for (;;) {
        sum = 0u; cnt = 0u; mine = 0u;
#pragma unroll
        for (unsigned j = 0; j < 16; ++j) { const unsigned c = xb_ld(&bar[XB_XCNT(j)]); sum += c; cnt += (c > 0u) ? 1u : 0u; mine = (j == x) ? c : mine; }
        if (sum == G) break;
        __builtin_amdgcn_s_sleep(1);
        if ((++sp & 255u) == 0u) { if (xb_ld(&bar[XB_TMO])) break; if (sp > XB_SPIN_CAP) { atomicAdd(&bar[XB_TMO], 1u); break; } }
    }
    nloc = mine > 0u ? mine : 1u; nx = cnt > 0u ? cnt : 1u;
}
__device__ __forceinline__ void xcd_barrier(const XcdBarrier& b) {
    asm volatile("s_waitcnt vmcnt(0)" ::: "memory");
    __syncthreads();
    if (threadIdx.x == 0) {
        unsigned* bar = b.bar;
        __builtin_amdgcn_s_waitcnt(0);
        unsigned nloc = b.st[0], nx = b.st[1];
        if (nloc == 0u) { xcd_barrier_complete(bar, b.x, nloc, nx); b.st[0] = nloc; b.st[1] = nx; }
        const unsigned old = xb_add(&bar[XB_XSUB(b.x)], 1u);
        const unsigned gen = old / nloc;
        if (old + 1u == (gen + 1u) * nloc) {
            __builtin_amdgcn_fence(__ATOMIC_RELEASE, "agent");
            asm volatile("s_waitcnt vmcnt(0)" ::: "memory");
            const unsigned og = xb_add(&bar[XB_TOP], 1u);
            const unsigned tg = og / nx;
            if (og + 1u == (tg + 1u) * nx) xb_add(&bar[XB_TOPGEN], 1u);
            else XB_SPIN(xb_ld(&bar[XB_TOPGEN]) == tg, bar);
            __builtin_amdgcn_fence(__ATOMIC_ACQUIRE, "agent");
            xb_add(&bar[XB_XGEN(b.x)], 1u);
            asm volatile("s_waitcnt vmcnt(0)" ::: "memory");
        } else {
            XB_SPIN(xb_ld(&bar[XB_XGEN(b.x)]) == gen, bar);
            __builtin_amdgcn_fence(__ATOMIC_ACQUIRE, "agent");
            asm volatile("s_waitcnt vmcnt(0)" ::: "memory");
        }
    }
    __syncthreads();
}

constexpr int N_PHASES = 17;
template <bool COOP>
__global__ void __launch_bounds__(NTHREADS, 2) mk_fwd(Args args) {
    extern __shared__ __attribute__((aligned(16))) unsigned char lds[];
    Frame F;
    F.lds = (LAS unsigned char*)lds;
    F.tid = threadIdx.x; F.lane = F.tid & 63; F.wave = __builtin_amdgcn_readfirstlane(F.tid >> 6); F.G = gridDim.x; F.bid = blockIdx.x;
    F.in = args.in; F.out = args.out; F.ws = args.ws;
    volatile LAS unsigned* misc = (volatile LAS unsigned*)(F.lds + MISC_OFF);
    if (F.tid < 16) misc[F.tid] = 0u;
    __syncthreads();
    XcdBarrier xbar; xbar.bar = (unsigned*)(args.ws + WS_CTL); xbar.x = 0; xbar.st = nullptr;
    if (COOP) xbar = xcd_barrier_post((unsigned*)(args.ws + WS_CTL), misc + 8);
    Frame F0 = F;
    for (int ph = args.ph_lo; ph < args.ph_hi; ++ph) {
        if (PROBE_PH >= 0 && F0.bid == 0 && F0.wave == 0) ((volatile LAS unsigned long long*)(F0.lds + MISC_OFF + 128))[ph] = __builtin_amdgcn_s_memrealtime();
        Frame F = F0;
        F.lane = 0; F.tid = 0;
        asm volatile("" : "+s"(F.wave), "+s"(F.bid), "+s"(F.G));
        F.z = 0; asm volatile("" : "+s"(F.z));
        F.ws = F0.ws + F.z; F.out = F0.out + F.z;
        int g0 = 0, g1 = 0;
        switch (ph) {
        case 1: g0 = 0; g1 = 1; break;
        case 2: if (F.G == 256 && F.bid >= 192) { g0 = 9; g1 = 10; } break;
        case 3: g0 = 1; g1 = 2; break;
        case 5: g0 = 2; g1 = 3; break;
        case 6: g0 = 3; g1 = 4; break;
        case 8: g0 = 4; g1 = 5; break;
        case 10: g0 = 5; g1 = 6; break;
        case 12: g0 = 6; g1 = 7; break;
        case 14: g0 = 7; g1 = 8; break;
        case 15: g0 = 8; g1 = 9; break;
        default: break;
        }
        if (g1 > g0) {
#pragma unroll 1
            for (int gi = g0; gi < g1; ++gi) run_gemm(F, gi);
            if (ph == 2) scan_late_tail(F);
        } else {
            switch (ph) {
            case 0: phase_prep(with_ids<1>(F)); break;
            case 2: phase_scan(with_ids<2>(F)); break;
            case 4: phase_rowpass(with_ids<3>(F), 0); break;
            case 7: phase_rowpass(with_ids<4>(F), 1); break;
            case 9: phase_mlarow(with_ids<5>(F)); break;
            case 11: phase_attn(with_ids<6>(F)); break;
            case 13: phase_rowpass(with_ids<7>(F), 2); break;
            default: phase_rowpass(with_ids<8>(F), 3); break;
            }
        }
        if (COOP) { if (ph + 1 < args.ph_hi) { xcd_barrier(xbar); } }
    }
    if (PROBE_PH >= 0 && F0.bid == 0 && F0.wave == 0) {
        volatile LAS unsigned long long* ts = (volatile LAS unsigned long long*)(F0.lds + MISC_OFF + 128);
        const unsigned long long tend = __builtin_amdgcn_s_memrealtime();
        const unsigned long long t1 = (PROBE_PH + 1 < args.ph_hi) ? ts[PROBE_PH + 1] : tend;
        const unsigned long long wait = (t1 - ts[PROBE_PH]) * PROBE_MULT;
        while (__builtin_amdgcn_s_memrealtime() - tend < wait) __builtin_amdgcn_s_sleep(8);
    }
}

extern "C" void kernel_launch(void* const* d_in, const int* in_sizes, int n_in, void* d_out, int out_size, void* d_ws, size_t ws_size, hipStream_t stream) {
    static int grid = 0;
    if (grid == 0) {
        if (n_in != 21 || (size_t)out_size != O_END || ws_size < WS_END) { fprintf(stderr, "kernel_launch: unexpected sizes n_in %d out %d (want %zu) ws %zu (need %zu)\n", n_in, out_size, (size_t)O_END, ws_size, (size_t)WS_END); grid = -1; return; }
        int dev = 0, cus = 0, per_cu = 0;
        hipGetDevice(&dev); hipDeviceGetAttribute(&cus, hipDeviceAttributeMultiprocessorCount, dev);
        hipFuncSetAttribute((const void*)mk_fwd<true>, hipFuncAttributeMaxDynamicSharedMemorySize, LDS_BYTES);
        hipFuncSetAttribute((const void*)mk_fwd<false>, hipFuncAttributeMaxDynamicSharedMemorySize, LDS_BYTES);
        hipOccupancyMaxActiveBlocksPerMultiprocessor(&per_cu, (const void*)mk_fwd<true>, NTHREADS, LDS_BYTES);
        (void)hipGetLastError();
        if (per_cu < 1) { fprintf(stderr, "kernel_launch: the occupancy query reports %d workgroups per CU for this kernel: it cannot be made resident, nothing launched\n", per_cu); grid = -1; return; }
        if (cus != 256) { fprintf(stderr, "kernel_launch: built for a 256-CU device (one main GEMM unit per CU in the fused residual epilogues, sample-row units on the last 64 workgroups of the scan phase); this device reports %d CUs, nothing launched\n", cus); grid = -1; return; }
        grid = cus;
    }
    if (grid < 0) return;
    if (hipMemsetAsync((char*)d_ws + WS_CTL, 0, CTL_BYTES, stream) != hipSuccess) { fprintf(stderr, "kernel_launch: memset of the barrier words failed\n"); return; }
    Args a{};
    for (int i = 0; i < 21; ++i) a.in[i] = (const float*)d_in[i];
    a.out = (float*)d_out; a.ws = (unsigned char*)d_ws;
#if MK_ONE_LAUNCH
    a.ph_lo = 0; a.ph_hi = N_PHASES;
    void* kargs[] = {&a};
    hipError_t e = hipLaunchCooperativeKernel((const void*)mk_fwd<true>, dim3(grid), dim3(NTHREADS), kargs, LDS_BYTES, stream);
    if (e != hipSuccess) fprintf(stderr, "cooperative launch failed: %s (grid %d)\n", hipGetErrorString(e), grid);
#else
    for (int ph = 0; ph < N_PHASES; ++ph) {
        a.ph_lo = ph; a.ph_hi = ph + 1;
        hipLaunchKernelGGL(mk_fwd<false>, dim3(grid), dim3(NTHREADS), LDS_BYTES, stream, a);
    }
#endif
}
```

```cpp
#include <hip/hip_runtime.h>
#include <hip/hip_cooperative_groups.h>
#include <cstdio>
#include <cstdint>
namespace cg = cooperative_groups;

#ifndef MK_ONE_LAUNCH
#define MK_ONE_LAUNCH 1
#endif

#ifndef PROBE_KDUP_GI
#define PROBE_KDUP_GI -1
#endif
#ifndef PROBE_PH
#define PROBE_PH -1
#endif
#define PROBE_MULT 2
#define LAS __attribute__((address_space(3)))
#define GAS __attribute__((address_space(1)))
#define DI __device__ __forceinline__
typedef unsigned short bf16_t;
typedef short bf16x8 __attribute__((ext_vector_type(8)));
typedef float f32x4 __attribute__((ext_vector_type(4)));
typedef _Float16 h16x2 __attribute__((ext_vector_type(2)));
typedef float f32x2 __attribute__((ext_vector_type(2)));
typedef float f32x16 __attribute__((ext_vector_type(16)));
typedef unsigned u32x4 __attribute__((ext_vector_type(4)));
typedef unsigned u32x2 __attribute__((ext_vector_type(2)));
typedef __bf16 bf16x2_t __attribute__((ext_vector_type(2)));

constexpr int DM = 2048, NB = 4, SEQ = 2048, DB = 8, DS = 32, PAST = 1024;
constexpr int TP = NB * SEQ, TS = DB * DS, T = TP + TS;
constexpr int HH = 16, DK = 128, DV = 128;
constexpr int QL = 512, KVL = 512, NOPE = 128, ROPE = 64, VD = 128, QHD = NOPE + ROPE;
constexpr int NDOWN = QL + KVL + ROPE, NDOWNP = 1280;
constexpr int FF = 5632, FF2 = 2 * FF;
constexpr int KVSEQ = PAST + DS;
constexpr int KVROWS = TP + DB * KVSEQ;
constexpr float EPS = 1e-6f;
constexpr int NTHREADS = 512, NWAVES = 8;

constexpr size_t O_Y = 0;
constexpr size_t O_HG = (size_t)T * DM;
constexpr size_t O_CKV = O_HG + (size_t)12 * HH * DK * DV;
constexpr size_t O_KPE = O_CKV + (size_t)T * KVL;
constexpr size_t O_CONVP = O_KPE + (size_t)T * ROPE;
constexpr size_t O_CONVS = O_CONVP + (size_t)2 * NB * 2 * FF2;
constexpr size_t O_END = O_CONVS + (size_t)2 * DB * 2 * FF2;

constexpr size_t al256(size_t x) { return (x + 255) & ~(size_t)255; }
constexpr size_t WS_WT_HIN = 0;
constexpr size_t WS_WT_HOUT = WS_WT_HIN + (size_t)8192 * 2048 * 2;
constexpr size_t WS_WT_DOWN = WS_WT_HOUT + (size_t)2048 * 2048 * 2;
constexpr size_t WS_WT_UQ = WS_WT_DOWN + (size_t)NDOWNP * 2048 * 2;
constexpr size_t WS_WT_K = WS_WT_UQ + (size_t)3072 * 512 * 2;
constexpr size_t WS_WT_V = WS_WT_K + (size_t)2048 * 512 * 2;
constexpr size_t WS_WT_MOUT = WS_WT_V + (size_t)2048 * 512 * 2;
constexpr size_t WS_WT_FIN = WS_WT_MOUT + (size_t)2048 * 2048 * 2;
constexpr size_t WS_WT_FOUT = WS_WT_FIN + (size_t)2 * FF2 * 2048 * 2;
constexpr size_t WS_TAB = WS_WT_FOUT + (size_t)2 * 2048 * FF * 2;
constexpr size_t WS_LB = WS_TAB + (size_t)2048 * 32 * 2 * 4;
constexpr size_t WS_X = WS_LB + 2048 * 4;
constexpr size_t WS_HPAD = WS_X + (size_t)T * DM * 4;
constexpr size_t WS_H = WS_HPAD + (size_t)2 * DM * 2;
constexpr size_t WS_M = WS_H + (size_t)T * DM * 2;
constexpr size_t WS_R2 = WS_M;
constexpr size_t WS_R = WS_M + (size_t)T * DM * 4;
constexpr size_t WS_QB = WS_R;
constexpr size_t WS_FG = WS_QB + (size_t)T * DM * 2;
constexpr size_t WS_VT2 = WS_FG + (size_t)T * DM * 4;
constexpr size_t WS_SG = WS_VT2 + (size_t)T * DM * 2;
constexpr size_t WS_OG = WS_SG + (size_t)T * DM * 2;
constexpr size_t WS_RA_END = WS_OG + (size_t)T * DM * 2;
constexpr size_t WS_ACT = WS_R;
constexpr size_t WS_RB_END = WS_ACT + (size_t)T * FF * 2;
constexpr size_t WS_DOWN = WS_R;
constexpr size_t WS_CQ = WS_DOWN + (size_t)T * NDOWNP * 4;
constexpr size_t WS_CKVA = WS_CQ + (size_t)T * QL * 2;
constexpr size_t WS_KPEA = WS_CKVA + (size_t)KVROWS * KVL * 2;
constexpr size_t WS_QA = WS_KPEA + (size_t)KVROWS * ROPE * 2;
constexpr size_t WS_KN = WS_QA + (size_t)T * 3072 * 2;
constexpr size_t WS_VT = WS_KN + (size_t)KVROWS * 2048 * 2;
constexpr size_t WS_AO = WS_VT + (size_t)2048 * KVROWS * 2;
constexpr size_t WS_RC_END = WS_AO + (size_t)T * DM * 2;
constexpr size_t cmax(size_t a, size_t b) { return a > b ? a : b; }
constexpr size_t WS_SLAB = cmax(WS_RA_END, cmax(WS_RB_END, WS_RC_END));
constexpr size_t WS_CTL = WS_SLAB + (size_t)22 * TS * DM * 4;
constexpr size_t CTL_BYTES = 65536;
constexpr size_t WS_XCH = WS_CTL + CTL_BYTES;
constexpr size_t WS_END = WS_XCH + (size_t)2 * 32 * 256 * 8 * 4;

constexpr int KS_2048 = 8, KS_5632 = 11;
constexpr int LDS_BYTES = 147456;
constexpr int MISC_OFF = LDS_BYTES - 512;

template <class T> DI T* as_global(T* p) { return (T*)(GAS T*)p; }
DI float bf2f(unsigned short b) { return __uint_as_float((unsigned)b << 16); }
DI unsigned pk2(float lo, float hi) { f32x2 v = {lo, hi}; bf16x2_t b = __builtin_convertvector(v, bf16x2_t); return __builtin_bit_cast(unsigned, b); }
DI float fexp(float x) { return __builtin_amdgcn_exp2f(x * 1.4426950408889634f); }
DI float sigmoidf_(float x) { return __builtin_amdgcn_rcpf(1.f + fexp(-x)); }
DI float siluf_(float x) { return x * sigmoidf_(x); }
template <int M> DI float xor_lane(float v) { static_assert(M >= 1 && M < 32, "ds_swizzle bit mode"); return __int_as_float(__builtin_amdgcn_ds_swizzle(__float_as_int(v), 0x1f | (M << 10))); }
DI float sum_xor32(float v) { auto rr = __builtin_amdgcn_permlane32_swap(__float_as_uint(v), __float_as_uint(v), false, false); return __uint_as_float(rr[0]) + __uint_as_float(rr[1]); }
DI float max_xor32(float v) { auto rr = __builtin_amdgcn_permlane32_swap(__float_as_uint(v), __float_as_uint(v), false, false); return fmaxf(__uint_as_float(rr[0]), __uint_as_float(rr[1])); }
DI float wave_sum(float v) { v += xor_lane<1>(v); v += xor_lane<2>(v); v += xor_lane<4>(v); v += xor_lane<8>(v); v += xor_lane<16>(v); return sum_xor32(v); }

namespace pg8 {
constexpr int BM = 256, BK = 64, HALF = 128, HTB = HALF * BK * 2, STAGE_BYTES = 8 * HTB, NXCD = 8, WGM = 8;
__host__ __device__ __forceinline__ int lds_byte(int r, int c) { const int st = (r >> 4) * 2 + (c >> 5), rr = r & 15, cc = c & 31, ob = rr * 64 + cc * 2; return st * 1024 + (ob ^ (((ob >> 9) & 1) << 5)); }
__host__ __device__ __forceinline__ void stage_rc(int b, int& R, int& C) { const int st = b / 1024, sb = b % 1024, swz = sb ^ (((sb >> 9) & 1) << 5); R = (st >> 1) * 16 + swz / 64; C = (st & 1) * 32 + (swz % 64) / 2; }

struct Unit { const char* A; const char* B; int r0, pn, nt, di, aux; };

__device__ __forceinline__ void decode_group(const void* A, const void* Bt, int K, int rs0, int rstep, int nM, int nN, int ks, int ntk, int di, int L, Unit& u) {
    int pml, pn, sl = 0;
    if (ks == 1) {
        const int nwg = nM * nN; int wgid = L;
        { const int q = nwg / NXCD, r = nwg % NXCD, xcd = wgid % NXCD, off = wgid / NXCD; wgid = (xcd < r ? xcd * (q + 1) : r * (q + 1) + (xcd - r) * q) + off; }
        const int nig = WGM * nN, gid = wgid / nig, fm = gid * WGM, gsz = (nM - fm) < WGM ? (nM - fm) : WGM;
        pml = fm + ((wgid % nig) % gsz); pn = (wgid % nig) / gsz;
    } else { sl = L % ks; const int tile = L / ks; pn = tile % nN; pml = tile / nN; }
    u.r0 = rs0 + pml * rstep; u.pn = pn; u.nt = ntk; u.di = di; u.aux = sl;
    u.A = (const char*)A + ((long)u.r0 * K + (long)sl * ntk * BK) * 2;
    u.B = (const char*)Bt + ((long)pn * BM * K + (long)sl * ntk * BK) * 2;
}
struct Group { const void* A; const void* Bt; int rs0, rstep, nM, nN, ks, ntk, di; };
struct PhaseSched {
    Group g[3]; int ng, K, G, c;
#if PROBE_KDUP_GI >= 0
    int kdup;
#endif
    __device__ __forceinline__ bool next(int i, Unit& u) const {
        int L = i * G + c;
#pragma unroll
        for (int k = 0; k < 3; ++k) if (k < ng) { const int cnt = g[k].nM * g[k].nN * g[k].ks;
            if (L < cnt) { decode_group(g[k].A, g[k].Bt, K, g[k].rs0, g[k].rstep, g[k].nM, g[k].nN, g[k].ks, g[k].ntk, g[k].di, L, u); return true; } L -= cnt; }
        return false;
    }
};

template <class Epi>
__device__ __forceinline__ void gemm_phase(LAS unsigned char* lds, const PhaseSched& S, const Epi& E, int tid_in) {
    Unit cur, nxt; int ui = 0;
    if (!S.next(0, cur)) return;
    int tid; { unsigned ones = ~0u; asm volatile("" : "+s"(ones)); tid = tid_in * 64 + (int)__builtin_amdgcn_mbcnt_hi(ones, __builtin_amdgcn_mbcnt_lo(ones, 0u)); }
    const int wid = __builtin_amdgcn_readfirstlane(tid >> 6), lane = tid & 63, wr = wid >> 2, wc = wid & 3, fr = lane & 15, fq = lane >> 4;
    const int K = S.K;
    unsigned voffA[2], voffB[2];
#pragma unroll
    for (int i = 0; i < 2; ++i) { int R, C; stage_rc(tid * 16 + i * 8192, R, C);
        voffA[i] = (unsigned)(R * K + C) * 2u; voffB[i] = (unsigned)(R * K + C) * 2u; }
    const size_t kstep = (size_t)(BK * 2);
    const size_t hstep = (size_t)HALF * K * 2;
    const unsigned ldsw = (unsigned)wid * 1024u;
    const int aoff = lds_byte(wr * 64 + fr, fq * 8), boff = lds_byte(wc * 32 + fr, fq * 8);
#define PG8_SA(b, h) (((b) * 2 + (h)) * HTB)
#define PG8_SB(b, h) ((4 + (b) * 2 + (h)) * HTB)
#define PG8_STAGE(bufoff, gbase, voff) do { _Pragma("unroll") for (int _i = 0; _i < 2; ++_i) \
        __builtin_amdgcn_global_load_lds((const unsigned*)((const char*)(gbase) + (voff)[_i]), (LAS unsigned*)(lds + (bufoff) + ldsw + _i * 8192), 16, 0, 0); } while (0)
#define PG8_LDA(dst, b, h) do { _Pragma("unroll") for (int m = 0; m < 4; ++m) _Pragma("unroll") for (int k = 0; k < 2; ++k) dst[m][k] = *(const LAS bf16x8*)(lds + PG8_SA(b, h) + aoff + m * 2048 + k * 1024); } while (0)
#define PG8_LDB(dst, b, h) do { _Pragma("unroll") for (int n = 0; n < 2; ++n) _Pragma("unroll") for (int k = 0; k < 2; ++k) dst[n][k] = *(const LAS bf16x8*)(lds + PG8_SB(b, h) + boff + n * 2048 + k * 1024); } while (0)
#define PG8_MMA(ai, bj, At, Bt) do { __builtin_amdgcn_s_setprio(1); _Pragma("unroll") for (int m = 0; m < 4; ++m) _Pragma("unroll") for (int n = 0; n < 2; ++n) _Pragma("unroll") for (int k = 0; k < 2; ++k) \
        acc[ai][bj][m][n] = __builtin_amdgcn_mfma_f32_16x16x32_bf16(Bt[n][k], At[m][k], acc[ai][bj][m][n], 0, 0, 0); __builtin_amdgcn_s_setprio(0); } while (0)
#define PG8_WAIT_V(n) asm volatile("s_waitcnt vmcnt(" #n ")" ::: "memory")
#define PG8_WAIT_L(n) asm volatile("s_waitcnt lgkmcnt(" #n ")" ::: "memory")
#define PG8_BAR __builtin_amdgcn_s_barrier()
#define PG8_SCHED __builtin_amdgcn_sched_barrier(0)
    f32x4 acc[2][2][4][2];
#pragma unroll
    for (int a = 0; a < 2; ++a)
#pragma unroll
        for (int b = 0; b < 2; ++b)
#pragma unroll
            for (int m = 0; m < 4; ++m)
#pragma unroll
                for (int n = 0; n < 2; ++n) acc[a][b][m][n] = (f32x4){0.f, 0.f, 0.f, 0.f};
    bf16x8 At[4][2], B0[2][2], B1[2][2];
    const char* cA = cur.A; const char* cB = cur.B;
    PG8_STAGE(PG8_SB(0, 0), cB, voffB); PG8_STAGE(PG8_SB(0, 1), cB + hstep, voffB); PG8_STAGE(PG8_SA(0, 0), cA, voffA); PG8_STAGE(PG8_SA(0, 1), cA + hstep, voffA);
    if (wr == 1) PG8_BAR;
    PG8_WAIT_V(2); PG8_BAR;
    PG8_STAGE(PG8_SB(1, 0), cB + kstep, voffB); PG8_STAGE(PG8_SA(1, 0), cA + kstep, voffA); PG8_STAGE(PG8_SB(1, 1), cB + hstep + kstep, voffB);
    PG8_WAIT_V(6); PG8_BAR;
    for (;;) {
        const bool has_next = S.next(ui + 1, nxt);
        const char* nA = has_next ? nxt.A : cA; const char* nB = has_next ? nxt.B : cB;
#if PROBE_KDUP_GI >= 0
        const int ntr = cur.nt, nt = S.kdup ? 2 * ntr : ntr;
#define PG8_TIDX(x) ((x) >= ntr ? (x) - ntr : (x))
#else
        const int nt = cur.nt;
#define PG8_TIDX(x) (x)
#endif
        for (int t = 0; t < nt; t += 2) {
            const bool last = (t == nt - 2);
            const char* a1 = cA + (size_t)(PG8_TIDX(t) + 1) * kstep;
            const char* a2 = last ? nA : cA + (size_t)PG8_TIDX(t + 2) * kstep; const char* b2 = last ? nB : cB + (size_t)PG8_TIDX(t + 2) * kstep;
            const char* a3 = a2 + kstep; const char* b3 = b2 + kstep;
            PG8_LDB(B0, 0, 0); PG8_LDB(B1, 0, 1); PG8_SCHED; PG8_LDA(At, 0, 0); PG8_STAGE(PG8_SA(1, 1), a1 + hstep, voffA);
            PG8_WAIT_V(8); PG8_WAIT_L(0); PG8_BAR; PG8_MMA(0, 0, At, B0); PG8_MMA(0, 1, At, B1); PG8_BAR; PG8_SCHED;
            PG8_LDA(At, 0, 1); PG8_STAGE(PG8_SB(0, 0), b2, voffB); PG8_STAGE(PG8_SB(0, 1), b2 + hstep, voffB); PG8_STAGE(PG8_SA(0, 0), a2, voffA);
            PG8_WAIT_V(8); PG8_WAIT_L(0); PG8_BAR; PG8_MMA(1, 0, At, B0); PG8_MMA(1, 1, At, B1); PG8_BAR; PG8_SCHED;
            PG8_LDB(B0, 1, 0); PG8_LDB(B1, 1, 1); PG8_SCHED; PG8_LDA(At, 1, 0); PG8_STAGE(PG8_SA(0, 1), a2 + hstep, voffA);
            PG8_WAIT_V(8); PG8_WAIT_L(0); PG8_BAR; PG8_MMA(0, 0, At, B0); PG8_MMA(0, 1, At, B1); PG8_BAR; PG8_SCHED;
            PG8_LDA(At, 1, 1); PG8_STAGE(PG8_SB(1, 0), b3, voffB); PG8_STAGE(PG8_SB(1, 1), b3 + hstep, voffB); PG8_STAGE(PG8_SA(1, 0), a3, voffA);
            PG8_WAIT_V(8); PG8_WAIT_L(0); PG8_BAR; PG8_MMA(1, 0, At, B0); PG8_MMA(1, 1, At, B1); PG8_BAR; PG8_SCHED;
        }
        if (wr == 0) PG8_BAR;
        E(acc, cur, wr, wc, fr, fq);
        if (!has_next) break;
#pragma unroll
        for (int a = 0; a < 2; ++a)
#pragma unroll
            for (int b = 0; b < 2; ++b)
#pragma unroll
                for (int m = 0; m < 4; ++m)
#pragma unroll
                    for (int n = 0; n < 2; ++n) acc[a][b][m][n] = (f32x4){0.f, 0.f, 0.f, 0.f};
        cur = nxt; cA = nA; cB = nB; ++ui;
        if (wr == 1) PG8_BAR;
    }
    PG8_WAIT_V(0);
    PG8_BAR;
#undef PG8_TIDX
#undef PG8_SA
#undef PG8_SB
#undef PG8_STAGE
#undef PG8_LDA
#undef PG8_LDB
#undef PG8_MMA
#undef PG8_WAIT_V
#undef PG8_WAIT_L
#undef PG8_BAR
#undef PG8_SCHED
}
}

struct Args { const float* in[21]; float* out; unsigned char* ws; int ph_lo, ph_hi; };

struct Frame {
    LAS unsigned char* lds;
    int tid, lane, wave, G, bid;
    const float* const* in; float* out; unsigned char* ws; int z;
};

template <int TAG = 0> DI Frame with_ids(Frame F) { unsigned ones = ~0u; asm volatile("; ids %1" : "+s"(ones) : "n"(TAG));
    F.lane = (int)__builtin_amdgcn_mbcnt_hi(ones, __builtin_amdgcn_mbcnt_lo(ones, 0u)); F.tid = F.wave * 64 + F.lane; return F; }

enum EpiDesc { D_HGRN = 0, D_M = 1, D_MSLAB = 2, D_FFN0 = 3, D_FFN1 = 4, D_DOWN = 5, D_Q = 6, D_KN = 7, D_VT = 8, D_VT2 = 9, D_VT2S = 10 };
DI float shl16_1(float v) { return __int_as_float(__builtin_amdgcn_update_dpp(0, __float_as_int(v), 0x101, 0xf, 0xf, false)); }
template <int N> DI float ror16(float v) { return __int_as_float(__builtin_amdgcn_update_dpp(0, __float_as_int(v), 0x120 + N, 0xf, 0xf, false)); }
struct EpiAll {
    unsigned char* ws; float* out; LAS unsigned char* lds; const float* const* in; int wave, z, which;
#if PROBE_KDUP_GI >= 0
    int kd;
#endif
    DI int hw_tid() const { unsigned ones = ~0u; asm volatile("" : "+s"(ones)); return wave * 64 + (int)__builtin_amdgcn_mbcnt_hi(ones, __builtin_amdgcn_mbcnt_lo(ones, 0u)); }
    DI void st_bf16(bf16_t* p, f32x4 v) const { u32x2 w; w.x = pk2(v[0], v[1]); w.y = pk2(v[2], v[3]); *(u32x2*)p = w; }
    DI static int PCOL(int fq) { return 4 * fq + ((fq & 1) ? 12 : 0); }
    DI static u32x4 pair16(u32x2 w0, u32x2 w1) {
        auto rx = __builtin_amdgcn_permlane16_swap(w0.x, w1.x, false, false); auto ry = __builtin_amdgcn_permlane16_swap(w0.y, w1.y, false, false);
        u32x4 r = {rx[0], ry[0], rx[1], ry[1]};
        asm volatile("" : "+v"(r.x), "+v"(r.y), "+v"(r.z), "+v"(r.w));
        return r;
    }
    DI static u32x2 pkb(f32x4 v) { return (u32x2){pk2(v[0], v[1]), pk2(v[2], v[3])}; }
    DI void ffn_epi(const f32x4 (&acc)[2][2][4][2], const pg8::Unit& u, int wr, int wc, int fr, int fq) const {
        { int t_ = hw_tid();
          const int lane_ = t_ & 63, wid_ = __builtin_amdgcn_readfirstlane(t_ >> 6); fr = lane_ & 15; fq = lane_ >> 4; wr = wid_ >> 2; wc = wid_ & 3; }
        const int layer = u.di - D_FFN0;
        float rs[2][4];
        { const float* R2 = (const float*)(ws + WS_R2);
#pragma unroll
          for (int ai = 0; ai < 2; ++ai)
#pragma unroll
              for (int m = 0; m < 4; ++m) { int gr_ = u.r0 + 128 * ai + 64 * wr + 16 * m + fr; gr_ = gr_ < 0 ? 0 : (gr_ >= T ? T - 1 : gr_); rs[ai][m] = R2[gr_]; } }
        LAS float* HALO = (LAS float*)(lds + 131072);
        if (fr >= 14) {
#pragma unroll
            for (int ai = 0; ai < 2; ++ai)
#pragma unroll
                for (int bj = 0; bj < 2; ++bj)
#pragma unroll
                    for (int n = 0; n < 2; ++n) *(LAS f32x4*)(HALO + ((2 * ai + wr) * 2 + (fr - 14)) * 256 + 128 * bj + 32 * wc + 16 * n + 4 * fq) = acc[ai][bj][3][n] * rs[ai][3];
        }
        asm volatile("s_waitcnt lgkmcnt(0)" ::: "memory"); __builtin_amdgcn_s_barrier(); asm volatile("" ::: "memory");
        const int f0 = u.r0 + 2, l0 = u.r0 + 255;
        const bool special = ((f0 & (SEQ - 1)) <= 1) || ((f0 >> 11) != (l0 >> 11)) || ((l0 & (SEQ - 1)) >= SEQ - 2) || (l0 >= TP);
        const float* cwl = as_global(in[18 + z]) + (size_t)layer * 3 * FF2; const float* cbl = as_global(in[19 + z]) + (size_t)layer * FF2; const float* sc = as_global(in[5 + z]);
        bf16_t* ACT = (bf16_t*)(ws + WS_ACT);
#pragma unroll
        for (int n = 0; n < 2; ++n) {
            const int tc = 32 * wc + 16 * n + 4 * fq, j0 = u.pn * 128 + tc;
            const f32x4 wg0 = *(const f32x4*)(cwl + j0), wg1 = *(const f32x4*)(cwl + FF2 + j0), wg2 = *(const f32x4*)(cwl + 2 * FF2 + j0), bg = *(const f32x4*)(cbl + j0);
            const f32x4 wu0 = *(const f32x4*)(cwl + FF + j0), wu1 = *(const f32x4*)(cwl + FF2 + FF + j0), wu2 = *(const f32x4*)(cwl + 2 * FF2 + FF + j0), bu = *(const f32x4*)(cbl + FF + j0);
#pragma unroll
            for (int ai = 0; ai < 2; ++ai) {
                const int sp = 2 * ai + wr;
                f32x4 pg = (f32x4){0.f, 0.f, 0.f, 0.f}, pu = pg;
                if (sp >= 1 && fr >= 14) { pg = *(const LAS f32x4*)(HALO + ((sp - 1) * 2 + (fr - 14)) * 256 + tc); pu = *(const LAS f32x4*)(HALO + ((sp - 1) * 2 + (fr - 14)) * 256 + 128 + tc); }
                f32x4 pg2, pu2;
#pragma unroll
                for (int i = 0; i < 4; ++i) { pg2[i] = ror16<2>(pg[i]); pu2[i] = ror16<2>(pu[i]); }
                asm volatile("" : "+v"(pg2[0]), "+v"(pg2[1]), "+v"(pg2[2]), "+v"(pg2[3]), "+v"(pu2[0]), "+v"(pu2[1]), "+v"(pu2[2]), "+v"(pu2[3]));
#pragma unroll
                for (int m = 0; m < 4; ++m) {
                    const f32x4 g = acc[ai][0][m][n] * rs[ai][m], uu = acc[ai][1][m][n] * rs[ai][m];
                    const int lr = 128 * ai + 64 * wr + 16 * m + fr, gr = u.r0 + lr;
                    f32x4 g1r, g2r, u1r, u2r;
#pragma unroll
                    for (int i = 0; i < 4; ++i) { g1r[i] = ror16<1>(g[i]); g2r[i] = ror16<2>(g[i]); u1r[i] = ror16<1>(uu[i]); u2r[i] = ror16<2>(uu[i]); }
                    f32x4 g1, g2, u1, u2, pg1, pu1;
#pragma unroll
                    for (int i = 0; i < 4; ++i) { pg1[i] = shl16_1(pg2[i]); pu1[i] = shl16_1(pu2[i]); }
                    asm volatile("" : "+v"(pg1[0]), "+v"(pg1[1]), "+v"(pg1[2]), "+v"(pg1[3]), "+v"(pu1[0]), "+v"(pu1[1]), "+v"(pu1[2]), "+v"(pu1[3]));
                    asm volatile("" : "+v"(g1r[0]), "+v"(g1r[1]), "+v"(g1r[2]), "+v"(g1r[3]), "+v"(u1r[0]), "+v"(u1r[1]), "+v"(u1r[2]), "+v"(u1r[3]));
                    asm volatile("" : "+v"(g2r[0]), "+v"(g2r[1]), "+v"(g2r[2]), "+v"(g2r[3]), "+v"(u2r[0]), "+v"(u2r[1]), "+v"(u2r[2]), "+v"(u2r[3]));
#pragma unroll
                    for (int i = 0; i < 4; ++i) { g1[i] = fr >= 1 ? g1r[i] : pg1[i]; g2[i] = fr >= 2 ? g2r[i] : pg2[i]; u1[i] = fr >= 1 ? u1r[i] : pu1[i]; u2[i] = fr >= 2 ? u2r[i] : pu2[i]; }
                    if (special && gr < T) {
                        const int p = gr < TP ? (gr & (SEQ - 1)) : ((gr - TP) & (DS - 1));
                        if (p < 2) {
                            const f32x4 z4 = (f32x4){0.f, 0.f, 0.f, 0.f};
                            if (gr >= TP) { const float* sp_ = sc + ((size_t)(layer * DB + ((gr - TP) >> 5)) * 2) * FF2 + j0;
                                if (p == 0) { g2 = *(const f32x4*)sp_; u2 = *(const f32x4*)(sp_ + FF); g1 = *(const f32x4*)(sp_ + FF2); u1 = *(const f32x4*)(sp_ + FF2 + FF); }
                                else { g2 = *(const f32x4*)(sp_ + FF2); u2 = *(const f32x4*)(sp_ + FF2 + FF); } }
                            else { if (p == 0) { g1 = z4; u1 = z4; } g2 = z4; u2 = z4; }
                        }
                        if (lr >= 2) {
                            if (gr < TP) { if (p >= SEQ - 2) { float* o = out + O_CONVP + ((size_t)((layer * NB + (gr >> 11)) * 2 + (p - (SEQ - 2)))) * FF2 + j0; *(f32x4*)o = g; *(f32x4*)(o + FF) = uu; } }
                            else if (p >= DS - 2) { float* o = out + O_CONVS + ((size_t)((layer * DB + ((gr - TP) >> 5)) * 2 + (p - (DS - 2)))) * FF2 + j0; *(f32x4*)o = g; *(f32x4*)(o + FF) = uu; }
                        }
                    }
                    if (lr >= 2 && gr < T) {
                        f32x4 a;
#pragma unroll
                        for (int i = 0; i < 4; ++i) { const float cg = bg[i] + wg0[i] * g2[i] + wg1[i] * g1[i] + wg2[i] * g[i], cu = bu[i] + wu0[i] * u2[i] + wu1[i] * u1[i] + wu2[i] * uu[i]; a[i] = siluf_(cg) * cu; }
                        st_bf16(ACT + (size_t)gr * FF + j0, a);
                    }
                    pg2 = g2r; pu2 = u2r;
                    __builtin_amdgcn_sched_barrier(0);
                }
            }
        }
    }
    DI void row_stats(const f32x4 (&acc)[2][2][4][2], int e, int pm, int pn, int wr, int wc, int fr, int fq, int t_, unsigned target) const {
        LAS float* P = (LAS float*)(lds + 131072); LAS float* S = (LAS float*)(lds + 131072 + 4096);
#pragma unroll
        for (int ai = 0; ai < 2; ++ai)
#pragma unroll
            for (int m = 0; m < 4; ++m) { float q = 0.f;
#pragma unroll
                for (int bj = 0; bj < 2; ++bj)
#pragma unroll
                    for (int n = 0; n < 2; ++n) { const f32x4 x = acc[ai][bj][m][n]; q += (x[0] * x[0] + x[1] * x[1]) + (x[2] * x[2] + x[3] * x[3]); }
                q += xor_lane<16>(q); q = sum_xor32(q);
                if (fq == 0) P[(128 * ai + 64 * wr + 16 * m + fr) * 4 + wc] = q; }
        asm volatile("s_waitcnt lgkmcnt(0)" ::: "memory"); __builtin_amdgcn_s_barrier(); asm volatile("" ::: "memory");
        unsigned* slots = (unsigned*)(ws + WS_XCH) + (size_t)((e * 32 + pm) * 256) * 8;
        unsigned* cnt = (unsigned*)(ws + WS_CTL + 16384) + (e * 32 + pm) * 64;
        if (t_ < 256) { const float t = (P[t_ * 4] + P[t_ * 4 + 1]) + (P[t_ * 4 + 2] + P[t_ * 4 + 3]);
            __hip_atomic_store(slots + t_ * 8 + pn, __float_as_uint(t), __ATOMIC_RELAXED, __HIP_MEMORY_SCOPE_AGENT); }
        asm volatile("s_waitcnt vmcnt(0)" ::: "memory");
        if ((t_ & 63) == 0) __hip_atomic_fetch_add(cnt, 1u, __ATOMIC_RELAXED, __HIP_MEMORY_SCOPE_AGENT);
        if (t_ < 64) {
            unsigned sp = 0;
            while ((unsigned)__builtin_amdgcn_readfirstlane(__hip_atomic_load(cnt, __ATOMIC_RELAXED, __HIP_MEMORY_SCOPE_AGENT)) < target) { __builtin_amdgcn_s_sleep(2); if (++sp > (1u << 22)) break; }
        }
        asm volatile("s_waitcnt vmcnt(0) lgkmcnt(0)" ::: "memory"); __builtin_amdgcn_s_barrier(); asm volatile("" ::: "memory");
        if (t_ < 256) { float tot = 0.f;
#pragma unroll
            for (int q = 0; q < 8; ++q) tot += __uint_as_float(__hip_atomic_load(slots + t_ * 8 + q, __ATOMIC_RELAXED, __HIP_MEMORY_SCOPE_AGENT));
            const float rr = __builtin_amdgcn_rsqf(tot * (1.f / DM) + EPS); S[t_] = rr;
            if (e == 1 && pn == 0) ((float*)(ws + WS_R2))[pm * 256 + t_] = rr; }
        asm volatile("s_waitcnt lgkmcnt(0)" ::: "memory"); __builtin_amdgcn_s_barrier(); asm volatile("" ::: "memory");
    }
    DI void res_epi(f32x4 (&acc)[2][2][4][2], const pg8::Unit& u, int wr, int wc, int fr, int fq) const {
        int t_ = hw_tid();
        { const int lane_ = t_ & 63, wid_ = __builtin_amdgcn_readfirstlane(t_ >> 6); fr = lane_ & 15; fq = lane_ >> 4; wr = wid_ >> 2; wc = wid_ & 3; }
        const LAS float* S = (const LAS float*)(lds + 131072 + 4096);
        const int pm = u.r0 >> 8, pn = u.pn; const unsigned target = 64u * (unsigned)(which + 1);
        const float* nw = as_global(in[6 + z]);
        const float* wa = nw + (which == 0 ? 1 : which == 1 ? 3 : which == 2 ? 5 : 7) * DM;
        const float* wb = which == 3 ? nullptr : nw + (which == 0 ? 2 : which == 1 ? 4 : 6) * DM;
        const float* xin32 = as_global(in[0 + z]);
        bf16_t* X16 = (bf16_t*)(ws + WS_X); float* yout = out + O_Y;
        const int col0 = pn * 256 + wc * 32 + 4 * fq;
        LAS float* WL = (LAS float*)(lds + 131072 + 5120);
        if (t_ < 64) *(LAS f32x4*)(WL + t_ * 4) = *(const f32x4*)(wa + pn * 256 + t_ * 4);
        const LAS float* wl = WL + wc * 32 + 4 * fq;
        u32x2 pre[2][4][2][2];
        if (which != 0) {
#pragma unroll
            for (int ai = 0; ai < 2; ++ai)
#pragma unroll
                for (int m = 0; m < 4; ++m) { const size_t ro = (size_t)(u.r0 + 128 * ai + 64 * wr + 16 * m + fr) * DM + col0;
#pragma unroll
                    for (int bj = 0; bj < 2; ++bj)
#pragma unroll
                        for (int n = 0; n < 2; ++n) pre[ai][m][bj][n] = *(const u32x2*)(X16 + ro + bj * 128 + n * 16); }
        }
        row_stats(acc, 0, pm, pn, wr, wc, fr, fq, t_, target);
#pragma unroll
        for (int ai = 0; ai < 2; ++ai)
#pragma unroll
            for (int m = 0; m < 4; ++m) { const int lr = 128 * ai + 64 * wr + 16 * m + fr; const float r1 = S[lr]; const size_t ro = (size_t)(u.r0 + lr) * DM + col0;
#pragma unroll
                for (int bj = 0; bj < 2; ++bj) { u32x2 w2[2];
#pragma unroll
                    for (int n = 0; n < 2; ++n) { const int co = bj * 128 + n * 16; const f32x4 ww = *(const LAS f32x4*)(wl + co);
                        f32x4 xi;
                        if (which == 0) xi = *(const f32x4*)(xin32 + ro + co);
                        else { const u32x2 p = pre[ai][m][bj][n]; xi = (f32x4){__uint_as_float(p.x << 16), __uint_as_float(p.x & 0xffff0000u), __uint_as_float(p.y << 16), __uint_as_float(p.y & 0xffff0000u)}; }
                        const f32x4 v = xi + acc[ai][bj][m][n] * r1 * ww; acc[ai][bj][m][n] = v;
                        if (which == 3) *(f32x4*)(yout + ro + co) = v; else w2[n] = pkb(v); }
                    if (which != 3) *(u32x4*)(X16 + (size_t)(u.r0 + lr) * DM + pn * 256 + wc * 32 + PCOL(fq) + bj * 128) = pair16(w2[0], w2[1]); }
                __builtin_amdgcn_sched_barrier(0); }
        if (wb) row_stats(acc, 1, pm, pn, wr, wc, fr, fq, t_, target);
    }

};
enum EpiGroup { G_HG = 0, G_RES = 1, G_FFN = 2, G_DOWN = 3, G_UP = 4 };
#define EPI_EACH4 _Pragma("unroll") for (int ai = 0; ai < 2; ++ai) _Pragma("unroll") for (int m = 0; m < 4; ++m) _Pragma("unroll") for (int bj = 0; bj < 2; ++bj) _Pragma("unroll") for (int n = 0; n < 2; ++n)
template <int G> struct EpiSel {
    EpiAll e;
    DI static void st_bf16(bf16_t* p, f32x4 v) { u32x2 w; w.x = pk2(v[0], v[1]); w.y = pk2(v[2], v[3]); *(u32x2*)p = w; }
    DI static int PCOL(int fq) { return 4 * fq + ((fq & 1) ? 12 : 0); }
    DI static void st_pair(unsigned char* p, u32x2 w0, u32x2 w1) {
        auto rx = __builtin_amdgcn_permlane16_swap(w0.x, w1.x, false, false);
        auto ry = __builtin_amdgcn_permlane16_swap(w0.y, w1.y, false, false);
        *(u32x4*)p = (u32x4){rx[0], ry[0], rx[1], ry[1]};
    }
    DI static u32x2 pkb(f32x4 v) { return (u32x2){pk2(v[0], v[1]), pk2(v[2], v[3])}; }
    DI static u32x2 pkh(f32x4 v) { const h16x2 p0 = {(_Float16)v[0], (_Float16)v[1]}, p1 = {(_Float16)v[2], (_Float16)v[3]}; return (u32x2){__builtin_bit_cast(unsigned, p0), __builtin_bit_cast(unsigned, p1)}; }
#define EPI_EACH3 _Pragma("unroll") for (int ai = 0; ai < 2; ++ai) _Pragma("unroll") for (int m = 0; m < 4; ++m) _Pragma("unroll") for (int bj = 0; bj < 2; ++bj)
    template <int STRIDE> DI static void plain_bf16(const f32x4 (&acc)[2][2][4][2], unsigned char* base, unsigned off0) {
        EPI_EACH3 st_pair(base + (off0 + (unsigned)(((size_t)(128 * ai + 16 * m) * STRIDE + 128 * bj) * 2)), pkb(acc[ai][bj][m][0]), pkb(acc[ai][bj][m][1]));
    }
    template <int STRIDE> DI static void plain_f32(const f32x4 (&acc)[2][2][4][2], unsigned char* base, unsigned off0) {
        EPI_EACH4 *(f32x4*)(base + (off0 + (unsigned)(((size_t)(128 * ai + 16 * m) * STRIDE + 128 * bj + 16 * n) * 4))) = acc[ai][bj][m][n];
    }
    template <int BJ> DI static void q_half(const f32x4 (&acc)[2][2][4][2], unsigned char* base, unsigned off0, int prow0, bool sample, int hc, int fq) {
        constexpr float QS = 0.07216878364870322f * 1.4426950408889634f;
        if (hc >= NOPE) {
            float f0[2], f1[2];
#pragma unroll
            for (int n = 0; n < 2; ++n) { const int i0 = (hc + 16 * n + 4 * fq - NOPE) >> 1;
                f0[n] = __builtin_amdgcn_exp2f((float)i0 * -0.41524101186092029f) * 0.15915494309189535f; f1[n] = __builtin_amdgcn_exp2f((float)(i0 + 1) * -0.41524101186092029f) * 0.15915494309189535f; }
#pragma unroll
            for (int ai = 0; ai < 2; ++ai)
#pragma unroll
                for (int m = 0; m < 4; ++m) { const int r = prow0 + 128 * ai + 16 * m; const float fp = (float)(sample ? PAST + (r & (DS - 1)) : (r & (SEQ - 1)));
                    u32x2 wq[2];
#pragma unroll
                    for (int n = 0; n < 2; ++n) { const f32x4 v = acc[ai][BJ][m][n]; const float r0 = __builtin_amdgcn_fractf(fp * f0[n]), r1 = __builtin_amdgcn_fractf(fp * f1[n]);
                        const float c0 = __builtin_amdgcn_cosf(r0), s0 = __builtin_amdgcn_sinf(r0), c1 = __builtin_amdgcn_cosf(r1), s1 = __builtin_amdgcn_sinf(r1); f32x4 o;
                        o[0] = v[0] * c0 - v[1] * s0; o[1] = v[1] * c0 + v[0] * s0; o[2] = v[2] * c1 - v[3] * s1; o[3] = v[3] * c1 + v[2] * s1;
                        wq[n] = pkb(o * QS); }
                    st_pair(base + (off0 + (unsigned)((128 * ai + 16 * m) * 3072 + 128 * BJ) * 2u), wq[0], wq[1]); }
        } else {
#pragma unroll
            for (int ai = 0; ai < 2; ++ai)
#pragma unroll
                for (int m = 0; m < 4; ++m) st_pair(base + (off0 + (unsigned)((128 * ai + 16 * m) * 3072 + 128 * BJ) * 2u), pkb(acc[ai][BJ][m][0] * QS), pkb(acc[ai][BJ][m][1] * QS));
        }
    }
    DI void operator()(f32x4 (&acc)[2][2][4][2], const pg8::Unit& u, int wr, int wc, int fr, int fq) const {
#if PROBE_KDUP_GI >= 0
        if (e.kd) {
#pragma unroll
            for (int a = 0; a < 2; ++a)
#pragma unroll
                for (int b = 0; b < 2; ++b)
#pragma unroll
                    for (int m = 0; m < 4; ++m)
#pragma unroll
                        for (int n = 0; n < 2; ++n) acc[a][b][m][n] = acc[a][b][m][n] * 0.5f; }
#endif
        if (G == G_FFN) { e.ffn_epi(acc, u, wr, wc, fr, fq); return; }
        if (G == G_RES && u.di == D_M) { e.res_epi(acc, u, wr, wc, fr, fq); return; }
        { int t_ = e.hw_tid(); const int lane_ = t_ & 63, wid_ = __builtin_amdgcn_readfirstlane(t_ >> 6); fr = lane_ & 15; fq = lane_ >> 4; wr = wid_ >> 2; wc = wid_ & 3; }
        unsigned char* ws = e.ws;
        const int di = u.di, row0 = u.r0 + wr * 64 + fr, col0 = u.pn * 256 + wc * 32 + fq * 4, colp = u.pn * 256 + wc * 32 + PCOL(fq);
        if (G == G_RES) {
            unsigned char* base = ws + WS_SLAB + (size_t)u.aux * TS * DM * 2; const unsigned off0 = (unsigned)((row0 - TP) * DM + colp) * 2u;
            EPI_EACH3 st_pair(base + (off0 + (unsigned)(((size_t)(128 * ai + 16 * m) * DM + 128 * bj) * 2)), pkh(acc[ai][bj][m][0]), pkh(acc[ai][bj][m][1]));
        }
        else if (G == G_DOWN) {
            const float* R2 = (const float*)(ws + WS_R2); float rs[2][4];
#pragma unroll
            for (int ai = 0; ai < 2; ++ai)
#pragma unroll
                for (int m = 0; m < 4; ++m) { const int r_ = row0 + 128 * ai + 16 * m; rs[ai][m] = R2[r_ < T ? r_ : T - 1]; }
            unsigned char* base = ws + WS_DOWN; const unsigned off0 = (unsigned)(row0 * NDOWNP + colp) * 2u;
            EPI_EACH3 st_pair(base + (off0 + (unsigned)(((size_t)(128 * ai + 16 * m) * NDOWNP + 128 * bj) * 2)), pkh(acc[ai][bj][m][0] * rs[ai][m]), pkh(acc[ai][bj][m][1] * rs[ai][m]));
        }
        else if (G == G_HG) {
            if (di == D_HGRN) {
                const int sec = u.pn >> 3, c0 = col0 & 2047; const unsigned eo = (unsigned)(row0 * DM + (colp & 2047));
                if (sec == 1) {
                    unsigned char* base = ws + WS_FG; const LAS float* lbp = (const LAS float*)(e.lds + 131072) + c0;
                    EPI_EACH3 { u32x2 wl[2];
#pragma unroll
                        for (int n = 0; n < 2; ++n) { const f32x4 l = *(const LAS f32x4*)(lbp + 128 * bj + 16 * n); const f32x4 v = acc[ai][bj][m][n]; f32x4 o;
                            for (int i = 0; i < 4; ++i) o[i] = __logf(l[i] + (1.f - l[i]) * sigmoidf_(v[i]));
                            wl[n] = pkh(o); }
                        st_pair(base + (eo * 2u + (unsigned)(((128 * ai + 16 * m) * DM + 128 * bj) * 2)), wl[0], wl[1]); }
                } else {
                    unsigned char* base = ws + (sec == 0 ? WS_QB : WS_SG);
                    EPI_EACH3 { u32x2 wl[2];
#pragma unroll
                        for (int n = 0; n < 2; ++n) { const f32x4 v = acc[ai][bj][m][n]; f32x4 o; for (int i = 0; i < 4; ++i) o[i] = siluf_(v[i]); wl[n] = pkb(o); }
                        st_pair(base + (eo * 2u + (unsigned)(((128 * ai + 16 * m) * DM + 128 * bj) * 2)), wl[0], wl[1]); }
                }
            } else { plain_bf16<T>(acc, ws + WS_VT2 + (di == D_VT2S ? (size_t)TP * 2 : 0), (unsigned)(row0 * T + colp) * 2u); }
        }
        else {
            if (di == D_KN)      plain_bf16<2048>(acc, ws + WS_KN, (unsigned)(row0 * 2048 + colp) * 2u);
            else if (di == D_VT) plain_bf16<KVROWS>(acc, ws + WS_VT, (unsigned)(row0 * KVROWS + colp) * 2u);
            else {
                const int hc0 = (u.pn * 256 + wc * 32) % QHD, hc1 = (u.pn * 256 + 128 + wc * 32) % QHD;
                const bool sample = u.r0 >= TP; const int prow0 = sample ? row0 - TP : row0;
                unsigned char* base = ws + WS_QA; const unsigned off0 = (unsigned)(row0 * 3072 + colp) * 2u;
                q_half<0>(acc, base, off0, prow0, sample, hc0, fq); q_half<1>(acc, base, off0, prow0, sample, hc1, fq);
            }
        }
    }
};
#undef EPI_EACH4
#undef EPI_EACH3


enum RowMap { RM_ID = 0, RM_UQ = 1, RM_UKV = 2, RM_HIN = 3, RM_FIN = 4 };
DI int map_row(int mode, int n) {
    if (mode == RM_UQ) { const int h = n / QHD, j = n % QHD; if (j < NOPE) return n; const int i = j - NOPE; return h * QHD + NOPE + (i < 32 ? 2 * i : 2 * (i - 32) + 1); }
    if (mode == RM_FIN) { const int j = n < FF ? n : n - FF; return 256 * (j >> 7) + (n < FF ? 0 : 128) + (j & 127); }
    if (mode == RM_HIN) { return n < 4096 ? n : (n < 6144 ? n + 2048 : n - 2048); }
    if (mode == RM_UKV) { const int h = n >> 8, j = n & 255; return (j < 128 ? 0 : 2048) + h * 128 + (j & 127); }
    return n;
}
DI void transpose_item(const float* W, int K, int N, bf16_t* WT, int mode, LAS float* scr, int item, int lane, const float* sk) {
    const int nblk = N / 32, kb = item / nblk, nb = item % nblk, k0 = 64 * kb, n0 = 32 * nb;
    float tv[32];
    { const float* wp = W + (size_t)(k0 + (lane >> 5)) * N + n0 + (lane & 31);
#pragma unroll
      for (int i = 0; i < 32; ++i) tv[i] = __builtin_nontemporal_load(wp + (size_t)(2 * i) * N); }
#pragma unroll
    for (int i = 0; i < 32; ++i) scr[(2 * i + (lane >> 5)) * 33 + (lane & 31)] = tv[i];
    asm volatile("s_waitcnt lgkmcnt(0)" ::: "memory");
    const int c = lane & 7;
    f32x4 ka = (f32x4){1.f, 1.f, 1.f, 1.f}, kc = ka;
    if (sk) { ka = *(const f32x4*)(sk + k0 + 8 * c); kc = *(const f32x4*)(sk + k0 + 8 * c + 4); }
#pragma unroll
    for (int j = 0; j < 4; ++j) { const int n = (lane >> 3) + 8 * j; const LAS float* s = scr + (8 * c) * 33 + n;
        u32x4 o; o.x = pk2(s[0 * 33] * ka[0], s[1 * 33] * ka[1]); o.y = pk2(s[2 * 33] * ka[2], s[3 * 33] * ka[3]); o.z = pk2(s[4 * 33] * kc[0], s[5 * 33] * kc[1]); o.w = pk2(s[6 * 33] * kc[2], s[7 * 33] * kc[3]);
        *(u32x4*)(WT + (size_t)map_row(mode, n0 + n) * K + k0 + 8 * c) = o; }
    asm volatile("s_waitcnt lgkmcnt(0)" ::: "memory");
}
DI const float* xrow_ptr(const Frame& F, int row) { return row < TP ? as_global(F.in[0 + F.z]) + (size_t)row * DM : as_global(F.in[1 + F.z]) + (size_t)(row - TP) * DM; }

DI void norm_row_bf16(const float* xr, const float* w, bf16_t* hr, int lane) {
    f32x4 v[8]; float s = 0.f;
#pragma unroll
    for (int j = 0; j < 8; ++j) { v[j] = *(const f32x4*)(xr + 4 * lane + 256 * j); s += (v[j][0] * v[j][0] + v[j][1] * v[j][1]) + (v[j][2] * v[j][2] + v[j][3] * v[j][3]); }
    const float r = __builtin_amdgcn_rsqf(wave_sum(s) * (1.f / DM) + EPS);
#pragma unroll
    for (int j = 0; j < 8; ++j) { const f32x4 ww = *(const f32x4*)(w + 4 * lane + 256 * j); u32x2 o; o.x = pk2(v[j][0] * r * ww[0], v[j][1] * r * ww[1]); o.y = pk2(v[j][2] * r * ww[2], v[j][3] * r * ww[3]);
        *(u32x2*)(hr + 4 * lane + 256 * j) = o; }
}

constexpr int I_HIN = 32 * 256, I_HOUT = 32 * 64, I_DOWN = 32 * 34, I_UQ = 8 * 96, I_UKV = 8 * 128, I_MOUT = 32 * 64, I_FIN = 32 * 352, I_FOUT = 88 * 64;
constexpr int CONV_NITEMS = I_HIN + I_HOUT + I_DOWN + I_UQ + I_UKV + I_MOUT + 2 * I_FIN + 2 * I_FOUT;
DI void convert_items(const Frame& F, int it0, int it1, int gw, int NGW) {
    LAS float* scr = (LAS float*)(F.lds + F.wave * 16384);
    unsigned char* ws = F.ws;
    for (int it = it0 + gw; it < it1; it += NGW) {
        int r = it; const float* W; bf16_t* WT; int K, N, mode = RM_ID; const float* sk = nullptr; const float* nw = as_global(F.in[6 + F.z]);
        if (r < I_HIN) { W = as_global(F.in[8 + F.z]); K = 2048; N = 8192; WT = (bf16_t*)(ws + WS_WT_HIN); mode = RM_HIN; }
        else if ((r -= I_HIN) < I_HOUT) { W = as_global(F.in[10 + F.z]); K = 2048; N = 2048; WT = (bf16_t*)(ws + WS_WT_HOUT); }
        else if ((r -= I_HOUT) < I_DOWN) { W = as_global(F.in[11 + F.z]); K = 2048; N = NDOWN; WT = (bf16_t*)(ws + WS_WT_DOWN); sk = nw + 4 * DM; }
        else if ((r -= I_DOWN) < I_UQ) { W = as_global(F.in[14 + F.z]); K = 512; N = 3072; WT = (bf16_t*)(ws + WS_WT_UQ); mode = RM_UQ; }
        else if ((r -= I_UQ) < I_UKV) { W = as_global(F.in[15 + F.z]); K = 512; N = 4096; WT = (bf16_t*)(ws + WS_WT_K); mode = RM_UKV; }
        else if ((r -= I_UKV) < I_MOUT) { W = as_global(F.in[16 + F.z]); K = 2048; N = 2048; WT = (bf16_t*)(ws + WS_WT_MOUT); }
        else if ((r -= I_MOUT) < 2 * I_FIN) { const int l = r / I_FIN; r -= l * I_FIN; W = as_global(F.in[17 + F.z]) + (size_t)l * 2048 * FF2; K = 2048; N = FF2; WT = (bf16_t*)(ws + WS_WT_FIN) + (size_t)l * FF2 * 2048; mode = RM_FIN; sk = nw + (l == 0 ? 2 : 6) * DM; }
        else { r -= 2 * I_FIN; const int l = r / I_FOUT; r -= l * I_FOUT; W = as_global(F.in[20 + F.z]) + (size_t)l * FF * 2048; K = FF; N = 2048; WT = (bf16_t*)(ws + WS_WT_FOUT) + (size_t)l * 2048 * FF; }
        transpose_item(W, K, N, WT, mode, scr, r, F.lane, sk);
    }
}
DI void convert_items_pipelined(const Frame& F, int it0, int it1, int gw, int NGW) {
    LAS float* scr = (LAS float*)(F.lds + F.wave * 16384);
    const float* W = as_global(F.in[8 + F.z]); bf16_t* WT = (bf16_t*)(F.ws + WS_WT_HIN);
    constexpr int K = 2048, N = 8192, nblk = N / 32;
    int it = it0 + gw; if (it >= it1) return;
    const int lane = F.lane; float tv[32];
    { const int k0 = 64 * (it / nblk), n0 = 32 * (it % nblk); const float* wp = W + (size_t)(k0 + (lane >> 5)) * N + n0 + (lane & 31);
#pragma unroll
      for (int i = 0; i < 32; ++i) tv[i] = __builtin_nontemporal_load(wp + (size_t)(2 * i) * N); }
    for (;;) {
        const int itn = it + NGW; const bool more = itn < it1; float tn[32];
        if (more) { const int k0 = 64 * (itn / nblk), n0 = 32 * (itn % nblk); const float* wp = W + (size_t)(k0 + (lane >> 5)) * N + n0 + (lane & 31);
#pragma unroll
            for (int i = 0; i < 32; ++i) tn[i] = __builtin_nontemporal_load(wp + (size_t)(2 * i) * N); }
        { const int k0 = 64 * (it / nblk), n0 = 32 * (it % nblk);
#pragma unroll
          for (int i = 0; i < 32; ++i) scr[(2 * i + (lane >> 5)) * 33 + (lane & 31)] = tv[i];
          asm volatile("s_waitcnt lgkmcnt(0)" ::: "memory");
          const int c = lane & 7;
#pragma unroll
          for (int j = 0; j < 4; ++j) { const int n = (lane >> 3) + 8 * j; const LAS float* p = scr + (8 * c) * 33 + n;
              u32x4 o; o.x = pk2(p[0 * 33], p[1 * 33]); o.y = pk2(p[2 * 33], p[3 * 33]); o.z = pk2(p[4 * 33], p[5 * 33]); o.w = pk2(p[6 * 33], p[7 * 33]);
              *(u32x4*)(WT + (size_t)map_row(RM_HIN, n0 + n) * K + k0 + 8 * c) = o; }
          asm volatile("s_waitcnt lgkmcnt(0)" ::: "memory"); }
        if (!more) break;
        it = itn;
#pragma unroll
        for (int i = 0; i < 32; ++i) tv[i] = tn[i];
    }
}
DI void phase_prep(const Frame& F) {
    const int gw = F.bid * NWAVES + F.wave, NGW = F.G * NWAVES;
    unsigned char* ws = F.ws;
    convert_items_pipelined(F, 0, I_HIN, gw, NGW);
    unsigned zz = 0u; asm volatile("" : "+v"(zz)); const u32x4 zero4 = {zz, zz, zz, zz};
    if (gw == 0) { u32x4* hp = (u32x4*)(ws + WS_HPAD); for (int i = F.lane; i < 2 * DM * 2 / 16; i += 64) hp[i] = zero4; }
    { const int gt = F.bid * NTHREADS + F.tid, NGT = F.G * NTHREADS; u32x4* p = (u32x4*)((bf16_t*)(ws + WS_WT_DOWN) + (size_t)NDOWN * 2048);
      for (int i = gt; i < (NDOWNP - NDOWN) * 256; i += NGT) p[i] = zero4; }
    { const int gt = F.bid * NTHREADS + F.tid, NGT = F.G * NTHREADS; float* tab = (float*)(ws + WS_TAB);
      for (int i = gt; i < 2048 * 32; i += NGT) { const int pos = i >> 5, k = i & 31;
          double inv = 1.0;
          for (int q = 0; q < k; ++q) inv *= 0.7498942093324559;
          const double rev = (double)pos * inv * 0.15915494309189535; const float fr = (float)(rev - floor(rev));
          tab[2 * i] = __builtin_amdgcn_cosf(fr); tab[2 * i + 1] = __builtin_amdgcn_sinf(fr); }
      float* lb = (float*)(ws + WS_LB); const float* lg = as_global(F.in[7 + F.z]);
      for (int i = gt; i < 2048; i += NGT) { const float a = lg[i], b = lg[2048 + i], c = lg[4096 + i]; const float mx = fmaxf(a, fmaxf(b, c));
          const float ea = fexp(a - mx), eb = fexp(b - mx), ec = fexp(c - mx); lb[i] = ea / (ea + eb + ec); } }
    { const float* nw0 = as_global(F.in[6 + F.z]); const int lane = F.lane;
      int m = gw; f32x4 v[8];
      if (m < T) { const float* xr = xrow_ptr(F, m);
#pragma unroll
          for (int j = 0; j < 8; ++j) v[j] = __builtin_nontemporal_load((const f32x4*)(xr + 4 * lane + 256 * j)); }
      while (m < T) {
          const int mn = m + NGW; f32x4 vn[8];
          if (mn < T) { const float* xr = xrow_ptr(F, mn);
#pragma unroll
              for (int j = 0; j < 8; ++j) vn[j] = __builtin_nontemporal_load((const f32x4*)(xr + 4 * lane + 256 * j)); }
          float sq = 0.f;
#pragma unroll
          for (int j = 0; j < 8; ++j) sq += (v[j][0] * v[j][0] + v[j][1] * v[j][1]) + (v[j][2] * v[j][2] + v[j][3] * v[j][3]);
          const float rr = __builtin_amdgcn_rsqf(wave_sum(sq) * (1.f / DM) + EPS);
          bf16_t* hr = (bf16_t*)(ws + WS_H) + (size_t)m * DM;
#pragma unroll
          for (int j = 0; j < 8; ++j) { const f32x4 ww = *(const f32x4*)(nw0 + 4 * lane + 256 * j); u32x2 o; o.x = pk2(v[j][0] * rr * ww[0], v[j][1] * rr * ww[1]); o.y = pk2(v[j][2] * rr * ww[2], v[j][3] * rr * ww[3]);
              *(u32x2*)(hr + 4 * lane + 256 * j) = o; }
          m = mn;
#pragma unroll
          for (int j = 0; j < 8; ++j) v[j] = vn[j];
      } }
}

#define MFMA32(a, b, c) __builtin_amdgcn_mfma_f32_32x32x16_bf16((a), (b), (c), 0, 0, 0)
DI int crow16(int reg, int hf) { return (reg & 3) + 8 * (reg >> 2) + 4 * hf; }
DI bf16x8 pack_half(const f32x16& x, int ks) {
    u32x4 w; w.x = pk2(x[8 * ks], x[8 * ks + 1]); w.y = pk2(x[8 * ks + 2], x[8 * ks + 3]); w.z = pk2(x[8 * ks + 4], x[8 * ks + 5]); w.w = pk2(x[8 * ks + 6], x[8 * ks + 7]); return __builtin_bit_cast(bf16x8, w);
}
DI void phase_scan(const Frame& F) {
    constexpr int PQ = 272, PK2 = 144;
    constexpr int L_QT = 0, L_KT = 64 * PQ, L_Q2 = 2 * 64 * PQ, L_K2T = 3 * 64 * PQ, L_P = L_K2T + 128 * PK2, L_DEC = L_P + 8 * 128 * 4, L_OB = L_DEC + 512;
    constexpr int OBP = 68;
    static_assert(L_OB + 2 * 128 * OBP * 4 + 512 <= MISC_OFF, "scan LDS map");
    LAS unsigned char* lds = F.lds;
    LAS float* P = (LAS float*)(lds + L_P); LAS float* DEC = (LAS float*)(lds + L_DEC); LAS float* OB = (LAS float*)(lds + L_OB);
    const bf16_t* Qb = (const bf16_t*)(F.ws + WS_QB); const _Float16* FG = (const _Float16*)(F.ws + WS_FG); const bf16_t* VT2 = (const bf16_t*)(F.ws + WS_VT2);
    const bf16_t* SG = (const bf16_t*)(F.ws + WS_SG); bf16_t* OG = (bf16_t*)(F.ws + WS_OG); const float* gnw = as_global(F.in[9 + F.z]);
    const int lane = F.lane, w = F.wave, r = lane & 31, hf = lane >> 5, dvb = w & 3, half = w >> 2;
    const bool late_sample = F.G == 256;
    if (late_sample && F.bid >= 64 && F.bid < 192) convert_items(F, I_HIN, CONV_NITEMS, (F.bid - 64) * NWAVES + F.wave, 192 * NWAVES);
    if (late_sample && F.bid >= 64 && F.bid < 192) {
        if (F.wave == 0) { unsigned sp = 0; unsigned* cnt = (unsigned*)(F.ws + WS_CTL + 32768);
            while ((unsigned)__builtin_amdgcn_readfirstlane(__hip_atomic_load(cnt, __ATOMIC_RELAXED, __HIP_MEMORY_SCOPE_AGENT)) < 64u) { __builtin_amdgcn_s_sleep(32); if (++sp > (1u << 18)) break; }
            __builtin_amdgcn_fence(__ATOMIC_ACQUIRE, "agent"); asm volatile("s_waitcnt vmcnt(0)" ::: "memory"); }
        __syncthreads();
    }
    for (int item = F.bid; item < 192; item += F.G) {
        int s, h, L, row0;
        if (item < 64) { s = item >> 4; h = item & 15; L = SEQ; row0 = s * SEQ; }
        else { const int it = item - 64; s = 4 + (it >> 4); h = it & 15; L = DS; row0 = TP + (s - 4) * DS; }
        const int nch = (L + 63) >> 6;
        f32x16 St[2];
        if (s < 4) {
#pragma unroll
            for (int d = 0; d < 2; ++d)
#pragma unroll
                for (int i = 0; i < 16; ++i) St[d][i] = 0.f;
        } else {
            int sb = (64 * half + 4 * hf) * DV + dvb * 32 + r; asm volatile("" : "+v"(sb));
            const float* st = as_global(F.in[2 + F.z]) + (size_t)((s - 4) * HH + h) * DK * DV + sb;
#pragma unroll
            for (int d = 0; d < 2; ++d)
#pragma unroll
                for (int i = 0; i < 16; ++i) St[d][i] = st[(32 * d + (i & 3) + 8 * (i >> 2)) * DV];
        }
        const int vrow = (h * DV + dvb * 32 + r) * T + row0;
        LAS float* GW = (LAS float*)(lds + L_OB + 2 * 128 * OBP * 4);
        if (F.tid < 128) GW[F.tid] = gnw[F.tid];
        unsigned fgN[8], qN[8], sgN[8]; u32x4 vnN[4]; u32x2 vkN[2][2];
#define SCAN_LOAD_A(CH) do { const int t0_ = (CH) * 64, nv_ = (L - t0_) < 64 ? (L - t0_) : 64; \
            int rb_ = (row0 + t0_) * DM + h * DK + 2 * lane; asm volatile("" : "+v"(rb_)); \
            _Pragma("unroll") for (int i = 0; i < 8; ++i) { const int ti = 8 * w + i, tl = ti < nv_ ? ti : nv_ - 1; \
                fgN[i] = *(const unsigned*)(FG + rb_ + tl * DM); qN[i] = *(const unsigned*)(Qb + rb_ + tl * DM); } } while (0)
#define SCAN_LOAD_V(CH) do { const int t0_ = (CH) * 64, nv_ = (L - t0_) < 64 ? (L - t0_) : 64; int vo_ = vrow + t0_; asm volatile("" : "+v"(vo_));   \
            _Pragma("unroll") for (int ks = 0; ks < 4; ++ks) { const int c_ = 16 * ks < nv_ ? 16 * ks : 0; vnN[ks] = *(const u32x4*)(VT2 + (vo_ + c_ + 8 * hf)); } \
            _Pragma("unroll") for (int k2 = 0; k2 < 2; ++k2) { const int c_ = (32 * half < nv_ ? 32 * half : 0) + 16 * k2 + 4 * hf; \
                vkN[k2][0] = *(const u32x2*)(VT2 + (vo_ + c_)); vkN[k2][1] = *(const u32x2*)(VT2 + (vo_ + c_ + 8)); } } while (0)
#define SCAN_LOAD_G(CH) do { const int t0_ = (CH) * 64, nv_ = (L - t0_) < 64 ? (L - t0_) : 64; \
            int rb_ = (row0 + t0_) * DM + h * DK + 2 * lane; asm volatile("" : "+v"(rb_)); \
            _Pragma("unroll") for (int i = 0; i < 8; ++i) { const int ti = 8 * w + i, tl = ti < nv_ ? ti : nv_ - 1; sgN[i] = *(const unsigned*)(SG + rb_ + tl * DM); } } while (0)
        SCAN_LOAD_A(0); SCAN_LOAD_V(0); SCAN_LOAD_G(0);
        for (int ch = 0; ch < nch; ++ch) {
            const int t0 = ch * 64, nvalid = (L - t0) < 64 ? (L - t0) : 64;
            int rbase = (row0 + t0 + 8 * w) * DM + h * DK + 2 * lane; asm volatile("" : "+v"(rbase));
            float fgv[8][2], qv[8][2];
            if (nvalid == 64) {
#pragma unroll
                for (int i = 0; i < 8; ++i) { const h16x2 lp = __builtin_bit_cast(h16x2, fgN[i]); fgv[i][0] = (float)lp.x; fgv[i][1] = (float)lp.y; qv[i][0] = __uint_as_float(qN[i] << 16); qv[i][1] = __uint_as_float(qN[i] & 0xffff0000u); }
            } else {
#pragma unroll
                for (int i = 0; i < 8; ++i) { const bool ok = (8 * w + i) < nvalid;
                    const h16x2 lp = __builtin_bit_cast(h16x2, fgN[i]); fgv[i][0] = ok ? (float)lp.x : 0.f; fgv[i][1] = ok ? (float)lp.y : 0.f;
                    qv[i][0] = ok ? __uint_as_float(qN[i] << 16) : 0.f; qv[i][1] = ok ? __uint_as_float(qN[i] & 0xffff0000u) : 0.f; }
            }
            float cum[8][2]; float run0 = 0.f, run1 = 0.f;
#pragma unroll
            for (int i = 0; i < 8; ++i) { run0 += fgv[i][0]; run1 += fgv[i][1]; cum[i][0] = run0; cum[i][1] = run1; }
            *(LAS f32x2*)(P + w * 128 + 2 * lane) = (f32x2){run0, run1};
            __syncthreads();
            float pre0 = 0.f, pre1 = 0.f, ref0 = 0.f, ref1 = 0.f, bl0 = 0.f, bl1 = 0.f;
#pragma unroll
            for (int q = 0; q < 8; ++q) { const f32x2 p = *(const LAS f32x2*)(P + q * 128 + 2 * lane); if (q < w) { pre0 += p[0]; pre1 += p[1]; } if (q < 4) { ref0 += p[0]; ref1 += p[1]; } bl0 += p[0]; bl1 += p[1]; }
            const float er0 = fexp(ref0), er1 = fexp(ref1), c20 = fexp(bl0 - ref0), c21 = fexp(bl1 - ref1);
            if (w == 0) *(LAS f32x2*)(DEC + 2 * lane) = (f32x2){fexp(bl0), fexp(bl1)};
            float k2c[2][8];
#pragma unroll
            for (int i = 0; i < 8; ++i) { const int t = 8 * w + i;
                const float e0 = fexp(pre0 + cum[i][0] - ref0), e1 = fexp(pre1 + cum[i][1] - ref1);
                const float qt0 = qv[i][0] * e0, qt1 = qv[i][1] * e1;
                const float kt0 = (1.f - fexp(fgv[i][0])) * __builtin_amdgcn_rcpf(e0), kt1 = (1.f - fexp(fgv[i][1])) * __builtin_amdgcn_rcpf(e1);
                *(LAS unsigned*)(lds + L_QT + t * PQ + 4 * lane) = pk2(qt0, qt1);
                *(LAS unsigned*)(lds + L_KT + t * PQ + 4 * lane) = pk2(kt0, kt1);
                *(LAS unsigned*)(lds + L_Q2 + t * PQ + 4 * lane) = pk2(qt0 * er0, qt1 * er1);
                k2c[0][i] = kt0 * c20; k2c[1][i] = kt1 * c21; }
#pragma unroll
            for (int c = 0; c < 2; ++c) { u32x4 o; o.x = pk2(k2c[c][0], k2c[c][1]); o.y = pk2(k2c[c][2], k2c[c][3]); o.z = pk2(k2c[c][4], k2c[c][5]); o.w = pk2(k2c[c][6], k2c[c][7]);
                *(LAS u32x4*)(lds + L_K2T + (2 * lane + c) * PK2 + 16 * w) = o; }
            __syncthreads();
            if (ch + 1 < nch) SCAN_LOAD_A(ch + 1);
            u32x4 vn[4]; u32x2 vk[2][2];
#pragma unroll
            for (int ks = 0; ks < 4; ++ks) { const bool ok = 16 * ks < nvalid; vn[ks] = ok ? vnN[ks] : (u32x4){0u, 0u, 0u, 0u}; }
#pragma unroll
            for (int k2 = 0; k2 < 2; ++k2) { const bool ok = 32 * half < nvalid; vk[k2][0] = ok ? vkN[k2][0] : (u32x2){0u, 0u}; vk[k2][1] = ok ? vkN[k2][1] : (u32x2){0u, 0u}; }
            if (ch + 1 < nch) SCAN_LOAD_V(ch + 1);
            f32x16 O[2];
#pragma unroll
            for (int d = 0; d < 2; ++d)
#pragma unroll
                for (int i = 0; i < 16; ++i) O[d][i] = 0.f;
            const bool live = (32 * half) < nvalid;
            if (live) {
#pragma unroll
                for (int tb = 0; tb < 2; ++tb) {
                    if (tb == 0 && half == 1) continue;
                    f32x16 X;
#pragma unroll
                    for (int i = 0; i < 16; ++i) X[i] = 0.f;
#pragma unroll
                    for (int ks = 0; ks < 8; ++ks) X = MFMA32(*(const LAS bf16x8*)(lds + L_KT + (32 * half + r) * PQ + 32 * ks + 16 * hf), *(const LAS bf16x8*)(lds + L_QT + (32 * tb + r) * PQ + 32 * ks + 16 * hf), X);
                    if (tb == half) {
#pragma unroll
                        for (int i = 0; i < 16; ++i) X[i] = (crow16(i, hf) <= r) ? X[i] : 0.f;
                    }
#pragma unroll
                    for (int k2 = 0; k2 < 2; ++k2) { const u32x4 vb = {vk[k2][0].x, vk[k2][0].y, vk[k2][1].x, vk[k2][1].y};
                        O[tb] = MFMA32(pack_half(X, k2), __builtin_bit_cast(bf16x8, vb), O[tb]); }
                }
            }
#pragma unroll
            for (int d = 0; d < 2; ++d)
#pragma unroll
                for (int k2 = 0; k2 < 2; ++k2) { const bf16x8 sb = pack_half(St[d], k2);
#pragma unroll
                    for (int tb = 0; tb < 2; ++tb) { const LAS unsigned char* qp = lds + L_Q2 + (32 * tb + r) * PQ + 2 * (64 * half + 32 * d + 16 * k2 + 4 * hf);
                        const u32x2 lo = *(const LAS u32x2*)qp, hi = *(const LAS u32x2*)(qp + 16); const u32x4 qa = {lo.x, lo.y, hi.x, hi.y};
                        O[tb] = MFMA32(__builtin_bit_cast(bf16x8, qa), sb, O[tb]); } }
#pragma unroll
            for (int tb = 0; tb < 2; ++tb)
#pragma unroll
                for (int g = 0; g < 4; ++g) *(LAS f32x4*)(OB + (half * 128 + dvb * 32 + r) * OBP + 32 * tb + 8 * g + 4 * hf) = (f32x4){O[tb][4 * g], O[tb][4 * g + 1], O[tb][4 * g + 2], O[tb][4 * g + 3]};
#pragma unroll
            for (int d = 0; d < 2; ++d) {
#pragma unroll
                for (int g = 0; g < 4; ++g) { const f32x4 dc = *(const LAS f32x4*)(DEC + 64 * half + 32 * d + 8 * g + 4 * hf);
#pragma unroll
                    for (int j = 0; j < 4; ++j) St[d][4 * g + j] *= dc[j]; }
#pragma unroll
                for (int ks = 0; ks < 4; ++ks) if (16 * ks < nvalid || nvalid == 64)
                    St[d] = MFMA32(*(const LAS bf16x8*)(lds + L_K2T + (64 * half + 32 * d + r) * PK2 + 32 * ks + 16 * hf), __builtin_bit_cast(bf16x8, vn[ks]), St[d]);
            }
            __syncthreads();
            { float o0[8], o1[8], q[8];
#pragma unroll
              for (int gq = 0; gq < 2; ++gq) {
                  const f32x4 a0 = *(const LAS f32x4*)(OB + (2 * lane) * OBP + 8 * w + 4 * gq), a1 = *(const LAS f32x4*)(OB + (2 * lane + 1) * OBP + 8 * w + 4 * gq);
                  const f32x4 b0 = *(const LAS f32x4*)(OB + (128 + 2 * lane) * OBP + 8 * w + 4 * gq), b1 = *(const LAS f32x4*)(OB + (128 + 2 * lane + 1) * OBP + 8 * w + 4 * gq);
#pragma unroll
                  for (int j = 0; j < 4; ++j) { const int i = 4 * gq + j; o0[i] = a0[j] + b0[j]; o1[i] = a1[j] + b1[j]; q[i] = o0[i] * o0[i] + o1[i] * o1[i]; } }
              float h4[4], h2[2], h1;
#pragma unroll
              for (int j = 0; j < 4; ++j) { const float keep = (lane & 1) ? q[2 * j + 1] : q[2 * j], send = (lane & 1) ? q[2 * j] : q[2 * j + 1]; h4[j] = keep + xor_lane<1>(send); }
#pragma unroll
              for (int j = 0; j < 2; ++j) { const float keep = (lane & 2) ? h4[2 * j + 1] : h4[2 * j], send = (lane & 2) ? h4[2 * j] : h4[2 * j + 1]; h2[j] = keep + xor_lane<2>(send); }
              { const float keep = (lane & 4) ? h2[1] : h2[0], send = (lane & 4) ? h2[0] : h2[1]; h1 = keep + xor_lane<4>(send); }
              h1 += xor_lane<8>(h1); h1 += xor_lane<16>(h1); h1 = sum_xor32(h1);
              const float rr_l = __builtin_amdgcn_rsqf(h1 * (1.f / DV) + EPS);
              const f32x2 gwv = *(const LAS f32x2*)(GW + 2 * lane); const float gw0 = gwv.x, gw1 = gwv.y;
#pragma unroll
              for (int i = 0; i < 8; ++i) { const int t = 8 * w + i;
                  const float rr = __int_as_float(__builtin_amdgcn_readlane(__float_as_int(rr_l), i));
                  if (t < nvalid) *(unsigned*)(OG + rbase + i * DM) = pk2(o0[i] * rr * gw0 * __uint_as_float(sgN[i] << 16), o1[i] * rr * gw1 * __uint_as_float(sgN[i] & 0xffff0000u)); } }
            if (ch + 1 < nch) SCAN_LOAD_G(ch + 1);
        }
        { int sb = (64 * half + 4 * hf) * DV + dvb * 32 + r; asm volatile("" : "+v"(sb));
          float* so = F.out + O_HG + (size_t)(s * HH + h) * DK * DV + sb;
#pragma unroll
          for (int d = 0; d < 2; ++d)
#pragma unroll
              for (int i = 0; i < 16; ++i) so[(32 * d + (i & 3) + 8 * (i >> 2)) * DV] = St[d][i]; }
    }
    if (!late_sample) {
        const int cb0 = F.G > 64 ? 64 : 0;
        if (F.bid >= cb0) { __syncthreads(); const Frame F3 = with_ids(F); convert_items(F3, I_HIN, CONV_NITEMS, (F3.bid - cb0) * NWAVES + F3.wave, (F3.G - cb0) * NWAVES); }
    }
}
DI void scan_late_tail(const Frame& F) {
    asm volatile("s_waitcnt vmcnt(0)" ::: "memory"); __syncthreads();
    const Frame F2 = with_ids(F);
    if (F2.tid == 0) { __builtin_amdgcn_fence(__ATOMIC_RELEASE, "agent"); asm volatile("s_waitcnt vmcnt(0)" ::: "memory");
        __hip_atomic_fetch_add((unsigned*)(F2.ws + WS_CTL + 32768), 1u, __ATOMIC_RELAXED, __HIP_MEMORY_SCOPE_AGENT); }
    __syncthreads();
    convert_items(F2, I_HIN, CONV_NITEMS, (F2.bid - 64) * NWAVES + F2.wave, 192 * NWAVES);
}

typedef _Float16 h16x4 __attribute__((ext_vector_type(4)));
DI f32x4 ld_h4(const _Float16* p) { const h16x4 h = *(const h16x4*)p; return (f32x4){(float)h[0], (float)h[1], (float)h[2], (float)h[3]}; }
DI void phase_rowpass(const Frame& F, int which) {
    const float* nw = as_global(F.in[6 + F.z]);
    const float* wa = nw + (which == 0 ? 1 : which == 1 ? 3 : which == 2 ? 5 : 7) * DM;
    const float* wb = which == 3 ? nullptr : nw + (which == 0 ? 2 : which == 1 ? 4 : 6) * DM;
    const int lane = F.lane, w = F.wave;
    { LAS float* red = (LAS float*)F.lds;
      const int nsl = (which & 1) ? KS_5632 : KS_2048; const int c = 256 * w + 4 * lane;
      for (int sr = F.bid; sr < TS; sr += F.G) {
          const int m = TP + sr;
          const _Float16* sl = (const _Float16*)(F.ws + WS_SLAB) + (size_t)sr * DM + c;
          f32x4 v = (f32x4){0.f, 0.f, 0.f, 0.f};
          if (which & 1) {
#pragma unroll
              for (int q = 0; q < KS_5632; ++q) v += ld_h4(sl + (size_t)q * TS * DM);
          } else {
#pragma unroll
              for (int q = 0; q < KS_2048; ++q) v += ld_h4(sl + (size_t)q * TS * DM);
          }
          (void)nsl;
          bf16_t* X16 = (bf16_t*)(F.ws + WS_X) + (size_t)m * DM;
          f32x4 xi;
          if (which == 0) xi = *(const f32x4*)(as_global(F.in[1 + F.z]) + (size_t)sr * DM + c);
          else { const u32x2 p = *(const u32x2*)(X16 + c); xi = (f32x4){__uint_as_float(p.x << 16), __uint_as_float(p.x & 0xffff0000u), __uint_as_float(p.y << 16), __uint_as_float(p.y & 0xffff0000u)}; }
          const f32x4 ww = *(const f32x4*)(wa + c);
          const float s1 = wave_sum((v[0] * v[0] + v[1] * v[1]) + (v[2] * v[2] + v[3] * v[3]));
          __syncthreads();
          if (lane == 0) red[w] = s1;
          __syncthreads();
          float t1 = 0.f;
#pragma unroll
          for (int q = 0; q < 8; ++q) t1 += red[q];
          const float r1 = __builtin_amdgcn_rsqf(t1 * (1.f / DM) + EPS);
          const f32x4 x1 = xi + v * r1 * ww;
          if (which == 3) *(f32x4*)(F.out + O_Y + (size_t)m * DM + c) = x1;
          else { u32x2 o; o.x = pk2(x1[0], x1[1]); o.y = pk2(x1[2], x1[3]); *(u32x2*)(X16 + c) = o; }
          if (wb) {
              const float s2 = wave_sum((x1[0] * x1[0] + x1[1] * x1[1]) + (x1[2] * x1[2] + x1[3] * x1[3]));
              if (lane == 0) red[8 + w] = s2;
              __syncthreads();
              float t2 = 0.f;
#pragma unroll
              for (int q = 0; q < 8; ++q) t2 += red[8 + q];
              const float r2 = __builtin_amdgcn_rsqf(t2 * (1.f / DM) + EPS);
              if (w == 0 && lane == 0) ((float*)(F.ws + WS_R2))[m] = r2;
          }
      }
    }
}

DI int kv_row_of(int row) { if (row < TP) return row; const int r = row - TP; return TP + (r >> 5) * KVSEQ + PAST + (r & 31); }
DI void phase_mlarow(const Frame& F) {
    const _Float16* DOWN = (const _Float16*)(F.ws + WS_DOWN); bf16_t* CQ = (bf16_t*)(F.ws + WS_CQ); bf16_t* CKVA = (bf16_t*)(F.ws + WS_CKVA); bf16_t* KPEA = (bf16_t*)(F.ws + WS_KPEA);
    const float* tab = (const float*)(F.ws + WS_TAB); const float* qw = as_global(F.in[12 + F.z]); const float* kw = as_global(F.in[13 + F.z]);
    const int lane = F.lane; const int gw = F.bid * NWAVES + F.wave, NGW = F.G * NWAVES;
    { int m = gw; f32x4 a[2], b[2]; float x1 = 0.f, x2 = 0.f;
#define MLA_LOAD(M, A_, B_, X1_, X2_) do { const _Float16* dr_ = DOWN + (size_t)(M) * NDOWNP; \
          _Pragma("unroll") for (int j = 0; j < 2; ++j) { A_[j] = ld_h4(dr_ + 4 * lane + 256 * j); B_[j] = ld_h4(dr_ + 512 + 4 * lane + 256 * j); } \
          X1_ = (float)dr_[1024 + (lane & 31)]; X2_ = (float)dr_[1024 + 32 + (lane & 31)]; } while (0)
      if (m < T) MLA_LOAD(m, a, b, x1, x2);
      while (m < T) {
          const int mn = m + NGW; f32x4 an[2], bn[2]; float x1n = 0.f, x2n = 0.f;
          if (mn < T) MLA_LOAD(mn, an, bn, x1n, x2n);
          const int kvr = kv_row_of(m); float sa = 0.f, sb = 0.f;
#pragma unroll
          for (int j = 0; j < 2; ++j) { sa += (a[j][0] * a[j][0] + a[j][1] * a[j][1]) + (a[j][2] * a[j][2] + a[j][3] * a[j][3]); sb += (b[j][0] * b[j][0] + b[j][1] * b[j][1]) + (b[j][2] * b[j][2] + b[j][3] * b[j][3]); }
          const float ra = __builtin_amdgcn_rsqf(wave_sum(sa) * (1.f / QL) + EPS), rb = __builtin_amdgcn_rsqf(wave_sum(sb) * (1.f / KVL) + EPS);
#pragma unroll
          for (int j = 0; j < 2; ++j) { const int c = 4 * lane + 256 * j; const f32x4 w1 = *(const f32x4*)(qw + c), w2 = *(const f32x4*)(kw + c);
              const f32x4 q = a[j] * ra * w1, kv = b[j] * rb * w2;
              u32x2 o; o.x = pk2(q[0], q[1]); o.y = pk2(q[2], q[3]); *(u32x2*)(CQ + (size_t)m * QL + c) = o;
              *(f32x4*)(F.out + O_CKV + (size_t)m * KVL + c) = kv;
              u32x2 o2; o2.x = pk2(kv[0], kv[1]); o2.y = pk2(kv[2], kv[3]); *(u32x2*)(CKVA + (size_t)kvr * KVL + c) = o2; }
          if (lane < 32) { const int pos = m < TP ? (m & (SEQ - 1)) : PAST + ((m - TP) & (DS - 1));
              const f32x2 cs = *(const f32x2*)(tab + ((size_t)pos * 32 + lane) * 2); const float o1 = x1 * cs[0] - x2 * cs[1], o2 = x2 * cs[0] + x1 * cs[1];
              F.out[O_KPE + (size_t)m * ROPE + lane] = o1; F.out[O_KPE + (size_t)m * ROPE + 32 + lane] = o2;
              *(unsigned*)(KPEA + (size_t)kvr * ROPE + 2 * lane) = pk2(o1, o2); }
          m = mn; a[0] = an[0]; a[1] = an[1]; b[0] = bn[0]; b[1] = bn[1]; x1 = x1n; x2 = x2n;
      }
#undef MLA_LOAD
    }
}

DI void convert_caches(const Frame& F, int gw, int NGW) {
    bf16_t* CKVA = (bf16_t*)(F.ws + WS_CKVA); bf16_t* KPEA = (bf16_t*)(F.ws + WS_KPEA); const int lane = F.lane;
    { const float* cckv = as_global(F.in[3 + F.z]); const float* ckpe = as_global(F.in[4 + F.z]);
      int i = gw; f32x4 v[2]; float x1 = 0.f, x2 = 0.f;
#define MLC_LOAD(I, V_, X1_, X2_) do { _Pragma("unroll") for (int j = 0; j < 2; ++j) V_[j] = __builtin_nontemporal_load((const f32x4*)(cckv + (size_t)(I) * KVL + 4 * lane + 256 * j)); \
          X1_ = ckpe[(size_t)(I) * ROPE + (lane & 31)]; X2_ = ckpe[(size_t)(I) * ROPE + 32 + (lane & 31)]; } while (0)
      if (i < DB * PAST) MLC_LOAD(i, v, x1, x2);
      while (i < DB * PAST) {
          const int in_ = i + NGW; f32x4 vn[2]; float x1n = 0.f, x2n = 0.f;
          if (in_ < DB * PAST) MLC_LOAD(in_, vn, x1n, x2n);
          const int b = i >> 10, p = i & (PAST - 1); const int kvr = TP + b * KVSEQ + p;
#pragma unroll
          for (int j = 0; j < 2; ++j) { const int c = 4 * lane + 256 * j; u32x2 o; o.x = pk2(v[j][0], v[j][1]); o.y = pk2(v[j][2], v[j][3]); *(u32x2*)(CKVA + (size_t)kvr * KVL + c) = o; }
          if (lane < 32) *(unsigned*)(KPEA + (size_t)kvr * ROPE + 2 * lane) = pk2(x1, x2);
          i = in_; v[0] = vn[0]; v[1] = vn[1]; x1 = x1n; x2 = x2n;
      }
#undef MLC_LOAD
    }
}

struct AttnState { f32x16 ot[4]; float mrun, lrun; };
DI void attn_softmax_pv_begin(f32x16& sc, AttnState& st, bf16x8 (&pf)[2]) {
    float mx = sc[0];
#pragma unroll
    for (int i = 1; i < 16; ++i) mx = fmaxf(mx, sc[i]);
    mx = max_xor32(mx);
    const float mnew = fmaxf(st.mrun, mx), alpha = __builtin_amdgcn_exp2f(st.mrun - mnew);
    float ps = 0.f;
#pragma unroll
    for (int i = 0; i < 16; ++i) { sc[i] = __builtin_amdgcn_exp2f(sc[i] - mnew); ps += sc[i]; }
    st.lrun = st.lrun * alpha + ps; st.mrun = mnew;
#pragma unroll
    for (int d = 0; d < 4; ++d)
#pragma unroll
        for (int i = 0; i < 16; ++i) st.ot[d][i] *= alpha;
    pf[0] = pack_half(sc, 0); pf[1] = pack_half(sc, 1);
}
constexpr int AK_PITCH = 400, AV_PITCH = 136, A_VOFF = 64 * AK_PITCH, A_BUF = A_VOFF + 128 * AV_PITCH;
static_assert(2 * A_BUF <= 131072, "attention LDS map");
DI void attn_prompt_unit(const Frame& F, int s, int h, int qb8) {
    const bf16_t* QA = (const bf16_t*)(F.ws + WS_QA); const bf16_t* KN = (const bf16_t*)(F.ws + WS_KN); const bf16_t* KPEA = (const bf16_t*)(F.ws + WS_KPEA); const bf16_t* VT = (const bf16_t*)(F.ws + WS_VT);
    bf16_t* AO = (bf16_t*)(F.ws + WS_AO);
    LAS unsigned char* lds = F.lds;
    const int tid = F.tid, lane = F.lane, w = F.wave, r = lane & 31, hf = lane >> 5;
    const int kvbase = s * SEQ, qrow0 = s * SEQ + 256 * qb8 + 32 * w, nT = 4 * (qb8 + 1), my_last = 4 * qb8 + (w >> 1);
    bf16x8 qf[12];
    { const bf16_t* qp = QA + (size_t)(qrow0 + r) * 3072 + h * QHD + 8 * hf;
#pragma unroll
      for (int k = 0; k < 12; ++k) qf[k] = *(const bf16x8*)(qp + 16 * k); }
    AttnState st;
#pragma unroll
    for (int d = 0; d < 4; ++d)
#pragma unroll
        for (int i = 0; i < 16; ++i) st.ot[d][i] = 0.f;
    st.mrun = -INFINITY; st.lrun = 0.f;
    unsigned kno[2], vto[2]; int kndst[2], vtdst[2];
#pragma unroll
    for (int i = 0; i < 2; ++i) { const int p = tid + 512 * i;
        kno[i] = (unsigned)((p >> 4) * 2048 + 8 * (p & 15)); kndst[i] = (p >> 4) * AK_PITCH + 16 * (p & 15);
        vto[i] = (unsigned)((p >> 3) * KVROWS + 8 * (p & 7)); vtdst[i] = A_VOFF + (p >> 3) * AV_PITCH + 16 * (p & 7); }
    const unsigned peo = (unsigned)((tid >> 3) * ROPE + 8 * (tid & 7)); const int pedst = (tid >> 3) * AK_PITCH + 256 + 16 * (tid & 7);
    const bf16_t* knB = KN + (size_t)kvbase * 2048 + h * NOPE; const bf16_t* peB = KPEA + (size_t)kvbase * ROPE; const bf16_t* vtB = VT + (size_t)(h * VD) * KVROWS + kvbase;
    u32x4 sk0, sk1, sp, sv0, sv1;
#define ATT_LOAD(T) do { const bf16_t* kn_ = knB + (size_t)(T) * 64 * 2048; const bf16_t* pe_ = peB + (size_t)(T) * 64 * ROPE; const bf16_t* vt_ = vtB + (T) * 64; \
        sk0 = *(const u32x4*)(kn_ + kno[0]); sk1 = *(const u32x4*)(kn_ + kno[1]); sp = *(const u32x4*)(pe_ + peo); sv0 = *(const u32x4*)(vt_ + vto[0]); sv1 = *(const u32x4*)(vt_ + vto[1]); } while (0)
#define ATT_WRITE(B) do { LAS unsigned char* b_ = lds + (B) * A_BUF; \
        *(LAS u32x4*)(b_ + kndst[0]) = sk0; *(LAS u32x4*)(b_ + kndst[1]) = sk1; *(LAS u32x4*)(b_ + pedst) = sp; \
        *(LAS u32x2*)(b_ + vtdst[0]) = (u32x2){sv0.x, sv0.y}; *(LAS u32x2*)(b_ + vtdst[0] + 8) = (u32x2){sv0.z, sv0.w}; \
        *(LAS u32x2*)(b_ + vtdst[1]) = (u32x2){sv1.x, sv1.y}; *(LAS u32x2*)(b_ + vtdst[1] + 8) = (u32x2){sv1.z, sv1.w}; } while (0)
    ATT_LOAD(0); ATT_WRITE(0);
    __syncthreads();
    for (int t = 0; t < nT; ++t) {
        if (t + 1 < nT) ATT_LOAD(t + 1);
        if (t <= my_last) {
            const LAS unsigned char* kb = lds + (t & 1) * A_BUF; const LAS unsigned char* vb = kb + A_VOFF;
#pragma unroll 1
            for (int hh = 0; hh < 2; ++hh) {
                bf16x8 kf[12];
#pragma unroll
                for (int k = 0; k < 12; ++k) kf[k] = *(const LAS bf16x8*)(kb + (32 * hh + r) * AK_PITCH + 32 * k + 16 * hf);
                __builtin_amdgcn_sched_barrier(0);
                f32x16 sc;
#pragma unroll
                for (int i = 0; i < 16; ++i) sc[i] = 0.f;
#pragma unroll
                for (int k = 0; k < 12; ++k) sc = MFMA32(kf[k], qf[k], sc);
                u32x2 vlo[8], vhi[8];
#pragma unroll
                for (int d = 0; d < 4; ++d)
#pragma unroll
                    for (int ks = 0; ks < 2; ++ks) { const LAS unsigned char* vp = vb + (32 * d + r) * AV_PITCH + 2 * (32 * hh + 16 * ks + 4 * hf);
                        vlo[2 * d + ks] = *(const LAS u32x2*)vp; vhi[2 * d + ks] = *(const LAS u32x2*)(vp + 16); }
                __builtin_amdgcn_sched_barrier(0);
                bf16x8 pf[2]; attn_softmax_pv_begin(sc, st, pf);
#pragma unroll
                for (int d = 0; d < 4; ++d)
#pragma unroll
                    for (int ks = 0; ks < 2; ++ks) { const u32x4 vv = {vlo[2 * d + ks].x, vlo[2 * d + ks].y, vhi[2 * d + ks].x, vhi[2 * d + ks].y};
                        st.ot[d] = MFMA32(__builtin_bit_cast(bf16x8, vv), pf[ks], st.ot[d]); }
            }
        }
        if (t + 1 < nT) ATT_WRITE((t + 1) & 1);
        __syncthreads();
    }
#undef ATT_LOAD
#undef ATT_WRITE
    const float inv = __builtin_amdgcn_rcpf(sum_xor32(st.lrun));
    bf16_t* op = AO + (size_t)(qrow0 + r) * DM + h * VD + 8 * hf;
#pragma unroll
    for (int d = 0; d < 4; ++d)
#pragma unroll
        for (int k = 0; k < 2; ++k) { u32x2 w0, w1;
            w0.x = pk2(st.ot[d][8 * k] * inv, st.ot[d][8 * k + 1] * inv); w0.y = pk2(st.ot[d][8 * k + 2] * inv, st.ot[d][8 * k + 3] * inv);
            w1.x = pk2(st.ot[d][8 * k + 4] * inv, st.ot[d][8 * k + 5] * inv); w1.y = pk2(st.ot[d][8 * k + 6] * inv, st.ot[d][8 * k + 7] * inv);
            auto rx = __builtin_amdgcn_permlane32_swap(w0.x, w1.x, false, false); auto ry = __builtin_amdgcn_permlane32_swap(w0.y, w1.y, false, false);
            *(u32x4*)(op + d * 32 + 16 * k) = (u32x4){rx[0], ry[0], rx[1], ry[1]}; }
}
DI void attn_sample_unit(const Frame& F, int b, int h) {
    const bf16_t* QA = (const bf16_t*)(F.ws + WS_QA); const bf16_t* KN = (const bf16_t*)(F.ws + WS_KN); const bf16_t* KPEA = (const bf16_t*)(F.ws + WS_KPEA); const bf16_t* VT = (const bf16_t*)(F.ws + WS_VT);
    bf16_t* AO = (bf16_t*)(F.ws + WS_AO);
    const int lane = F.lane, w = F.wave, r = lane & 31, hf = lane >> 5;
    const int qrow0 = TP + b * DS, kvbase = TP + b * KVSEQ;
    const int tb = 4 * w + (w > 0 ? 1 : 0), te = tb + (w == 0 ? 5 : 4);
    bf16x8 qf[12];
    { const bf16_t* qp = QA + (size_t)(qrow0 + r) * 3072 + h * QHD + 8 * hf;
#pragma unroll
      for (int k = 0; k < 12; ++k) qf[k] = *(const bf16x8*)(qp + 16 * k); }
    AttnState st;
#pragma unroll
    for (int d = 0; d < 4; ++d)
#pragma unroll
        for (int i = 0; i < 16; ++i) st.ot[d][i] = 0.f;
    st.mrun = -INFINITY; st.lrun = 0.f;
    for (int t = tb; t < te; ++t) {
        const int key0 = 32 * t;
        const bf16_t* kp = KN + (size_t)(kvbase + key0 + r) * 2048 + h * NOPE + 8 * hf;
        const bf16_t* pp = KPEA + (size_t)(kvbase + key0 + r) * ROPE + 8 * hf;
        f32x16 sc;
#pragma unroll
        for (int i = 0; i < 16; ++i) sc[i] = 0.f;
#pragma unroll
        for (int k = 0; k < 8; ++k) sc = MFMA32(*(const bf16x8*)(kp + 16 * k), qf[k], sc);
#pragma unroll
        for (int k = 0; k < 4; ++k) sc = MFMA32(*(const bf16x8*)(pp + 16 * k), qf[8 + k], sc);
        bf16x8 pf[2]; attn_softmax_pv_begin(sc, st, pf);
#pragma unroll
        for (int d = 0; d < 4; ++d) {
            const bf16_t* vp = VT + (size_t)(h * VD + d * 32 + r) * KVROWS + kvbase + key0 + 4 * hf;
#pragma unroll
            for (int ks = 0; ks < 2; ++ks) { const u32x2 lo = *(const u32x2*)(vp + 16 * ks), hi = *(const u32x2*)(vp + 16 * ks + 8); const u32x4 vv = {lo.x, lo.y, hi.x, hi.y};
                st.ot[d] = MFMA32(__builtin_bit_cast(bf16x8, vv), pf[ks], st.ot[d]); }
        }
    }
    LAS float* OT = (LAS float*)F.lds; LAS float* ML = (LAS float*)(F.lds + 131072);
    const float lsum = sum_xor32(st.lrun);
#pragma unroll
    for (int d = 0; d < 4; ++d)
#pragma unroll
        for (int i = 0; i < 16; ++i) OT[(w * 64 + 16 * d + i) * 64 + lane] = st.ot[d][i];
    if (hf == 0) { ML[w * 64 + r] = st.mrun; ML[w * 64 + 32 + r] = lsum; }
    __syncthreads();
    float M = -INFINITY;
#pragma unroll
    for (int q = 0; q < 8; ++q) M = fmaxf(M, ML[q * 64 + r]);
    float sc8[8], Lt = 0.f;
#pragma unroll
    for (int q = 0; q < 8; ++q) { sc8[q] = __builtin_amdgcn_exp2f(ML[q * 64 + r] - M); Lt += ML[q * 64 + 32 + r] * sc8[q]; }
    const float inv = __builtin_amdgcn_rcpf(Lt);
    const int d = w >> 1;
    bf16_t* op = AO + (size_t)(qrow0 + r) * DM + h * VD + 4 * hf + d * 32;
#pragma unroll
    for (int gg = 0; gg < 2; ++gg) { const int g = 2 * (w & 1) + gg; float o[4];
#pragma unroll
        for (int j = 0; j < 4; ++j) { float acc = 0.f;
#pragma unroll
            for (int q = 0; q < 8; ++q) acc += OT[(q * 64 + 16 * d + 4 * g + j) * 64 + lane] * sc8[q];
            o[j] = acc * inv; }
        u32x2 ov; ov.x = pk2(o[0], o[1]); ov.y = pk2(o[2], o[3]); *(u32x2*)(op + 8 * g) = ov; }
    __syncthreads();
}
DI void phase_attn(const Frame& F) {
    const int vcu = (F.G % 8 == 0) ? (F.bid % 8) * (F.G / 8) + F.bid / 8 : F.bid;
    for (int p = vcu; p < NB * HH * 4; p += F.G) { const int sh = p >> 2, pr = p & 3, s = sh >> 4, h = sh & 15;
        const int n = pr == 0 ? 1 : pr == 3 ? 3 : 2;
#pragma unroll 1
        for (int k = 0; k < n; ++k) { int qb8 = pr == 0 ? 6 : pr == 1 ? (k == 0 ? 5 : 0) : pr == 2 ? (k == 0 ? 7 : 2) : (k == 0 ? 4 : k == 1 ? 3 : 1);
            asm volatile("" : "+s"(qb8)); attn_prompt_unit(F, s, h, qb8); }
    }
    const Frame F2 = with_ids<9>(F);
    for (int p = vcu; p < NB * HH * 4; p += F2.G) if ((p & 3) < 2) { const int u = (p >> 2) * 2 + (p & 3); attn_sample_unit(F2, u >> 4, u & 15); }
}

#define GRP(Aoff, Boff, rs0, rstep, nM, nN, ks, ntk, di) { S.g[S.ng] = {ws + (Aoff), ws + (Boff), rs0, rstep, nM, nN, ks, ntk, di}; ++S.ng; }
DI void run_gemm(const Frame& F, int gi) {
    unsigned char* ws = F.ws; pg8::PhaseSched S; S.ng = 0; S.G = F.G; S.c = F.bid; S.K = (gi == 3 || gi == 8) ? FF : (gi == 5 ? 512 : 2048);
    if (gi == 9) { S.G = 64; S.c = F.bid - (F.G - 64); }
    switch (gi) {
    case 0: GRP(WS_H, WS_WT_HIN, 0, 256, 32, 24, 1, 32, D_HGRN) GRP(WS_WT_HIN + (size_t)6144 * 2048 * 2, WS_H, 0, 256, 8, 32, 1, 32, D_VT2) break;
    case 9: GRP(WS_H, WS_WT_HIN, TP, 256, 1, 24, 1, 32, D_HGRN) GRP(WS_WT_HIN + (size_t)6144 * 2048 * 2, WS_H + (size_t)TP * 2048 * 2, 0, 256, 8, 1, 1, 32, D_VT2S) break;
    case 1: GRP(WS_OG, WS_WT_HOUT, 0, 256, 32, 8, 1, 32, D_M) GRP(WS_OG, WS_WT_HOUT, TP, 256, 1, 8, KS_2048, 32 / KS_2048, D_MSLAB) break;
    case 2: GRP(WS_X, WS_WT_FIN, -2, 254, 34, 44, 1, 32, D_FFN0) break;
    case 3: GRP(WS_ACT, WS_WT_FOUT, 0, 256, 32, 8, 1, 88, D_M) GRP(WS_ACT, WS_WT_FOUT, TP, 256, 1, 8, KS_5632, 88 / KS_5632, D_MSLAB) break;
    case 4: GRP(WS_X, WS_WT_DOWN, 0, 256, 33, 5, 1, 32, D_DOWN) break;
    case 5: GRP(WS_CKVA, WS_WT_K, 0, 256, 65, 8, 1, 8, D_KN) GRP(WS_WT_V, WS_CKVA, 0, 256, 8, 65, 1, 8, D_VT) GRP(WS_CQ, WS_WT_UQ, 0, 256, 33, 12, 1, 8, D_Q) break;
    case 6: GRP(WS_AO, WS_WT_MOUT, 0, 256, 32, 8, 1, 32, D_M) GRP(WS_AO, WS_WT_MOUT, TP, 256, 1, 8, KS_2048, 32 / KS_2048, D_MSLAB) break;
    case 7: GRP(WS_X, WS_WT_FIN + (size_t)FF2 * 2048 * 2, -2, 254, 34, 44, 1, 32, D_FFN1) break;
    default: GRP(WS_ACT, WS_WT_FOUT + (size_t)2048 * FF * 2, 0, 256, 32, 8, 1, 88, D_M) GRP(WS_ACT, WS_WT_FOUT + (size_t)2048 * FF * 2, TP, 256, 1, 8, KS_5632, 88 / KS_5632, D_MSLAB) break;
    }
#if PROBE_KDUP_GI >= 0
    EpiAll E{F.ws, F.out, F.lds, F.in, F.wave, F.z, gi == 1 ? 0 : gi == 3 ? 1 : gi == 6 ? 2 : 3, gi == PROBE_KDUP_GI}; S.kdup = (gi == PROBE_KDUP_GI);
#else
    EpiAll E{F.ws, F.out, F.lds, F.in, F.wave, F.z, gi == 1 ? 0 : gi == 3 ? 1 : gi == 6 ? 2 : 3};
#endif
    if (gi == 0 || gi == 9) {
        const Frame F2 = with_ids(F); *(LAS f32x4*)(F2.lds + 131072 + F2.tid * 16) = *(const f32x4*)((const float*)(ws + WS_LB) + F2.tid * 4);
        __syncthreads(); }
    if (gi == 0 || gi == 9)      pg8::gemm_phase(F.lds, S, EpiSel<G_HG>{E}, F.wave);
    else if (gi == 2 || gi == 7) pg8::gemm_phase(F.lds, S, EpiSel<G_FFN>{E}, F.wave);
    else if (gi == 4)            pg8::gemm_phase(F.lds, S, EpiSel<G_DOWN>{E}, F.wave);
    else if (gi == 5)            pg8::gemm_phase(F.lds, S, EpiSel<G_UP>{E}, F.wave);
    else                         pg8::gemm_phase(F.lds, S, EpiSel<G_RES>{E}, F.wave);
    if (gi == 4 && F.bid >= 165) {
        const Frame F2 = with_ids(F); convert_caches(F2, (F2.bid - 165) * NWAVES + F2.wave, (F2.G - 165) * NWAVES); }
}
#undef GRP

#define XB_TMO      128
#define XB_XCNT(j)  (256  + 64 * (j))
#define XB_XSUB(j)  (1280 + 64 * (j))
#define XB_XGEN(j)  (2304 + 64 * (j))
#define XB_TOP      3328
#define XB_TOPGEN   3392
#define XCD_BAR_WORDS 3456
#define XB_SPIN_CAP (1u << 18)
__device__ __forceinline__ unsigned xb_ld(unsigned* p)              { return __hip_atomic_load(p, __ATOMIC_RELAXED, __HIP_MEMORY_SCOPE_AGENT); }
__device__ __forceinline__ unsigned xb_add(unsigned* p, unsigned v) { return __hip_atomic_fetch_add(p, v, __ATOMIC_RELAXED, __HIP_MEMORY_SCOPE_AGENT); }
__device__ __forceinline__ unsigned xb_xcc_id() { return (unsigned)__builtin_amdgcn_s_getreg((3 << 11) | 20) & 0xFu; }
#define XB_SPIN(cond, bar) do { unsigned _sp = 0; while (cond) { __builtin_amdgcn_s_sleep(1); \
    if ((++_sp & 255u) == 0u) { if (xb_ld(&(bar)[XB_TMO])) break; if (_sp > XB_SPIN_CAP) { atomicAdd(&(bar)[XB_TMO], 1u); break; } } } } while (0)
struct XcdBarrier { unsigned* bar; unsigned x; volatile LAS unsigned* st; };
__device__ __forceinline__ XcdBarrier xcd_barrier_post(unsigned* bar, volatile LAS unsigned* st) {
    XcdBarrier b; b.bar = bar; b.x = xb_xcc_id(); b.st = st;
    if (threadIdx.x == 0) (void)xb_add(&bar[XB_XCNT(b.x)], 1u);
    return b;
}
__device__ __forceinline__ void xcd_barrier_complete(unsigned* bar, unsigned x, unsigned& nloc, unsigned& nx) {
    const unsigned G = gridDim.x * gridDim.y * gridDim.z;
    unsigned sum, cnt, mine, sp = 0u;
    for (;;) {
        sum = 0u; cnt = 0u; mine = 0u;
#pragma unroll
        for (unsigned j = 0; j < 16; ++j) { const unsigned c = xb_ld(&bar[XB_XCNT(j)]); sum += c; cnt += (c > 0u) ? 1u : 0u; mine = (j == x) ? c : mine; }
        if (sum == G) break;
        __builtin_amdgcn_s_sleep(1);
        if ((++sp & 255u) == 0u) { if (xb_ld(&bar[XB_TMO])) break; if (sp > XB_SPIN_CAP) { atomicAdd(&bar[XB_TMO], 1u); break; } }
    }
    nloc = mine > 0u ? mine : 1u; nx = cnt > 0u ? cnt : 1u;
}
__device__ __forceinline__ void xcd_barrier(const XcdBarrier& b) {
    asm volatile("s_waitcnt vmcnt(0)" ::: "memory");
    __syncthreads();
    if (threadIdx.x == 0) {
        unsigned* bar = b.bar;
        __builtin_amdgcn_s_waitcnt(0);
        unsigned nloc = b.st[0], nx = b.st[1];
        if (nloc == 0u) { xcd_barrier_complete(bar, b.x, nloc, nx); b.st[0] = nloc; b.st[1] = nx; }
        const unsigned old = xb_add(&bar[XB_XSUB(b.x)], 1u);
        const unsigned gen = old / nloc;
        if (old + 1u == (gen + 1u) * nloc) {
            __builtin_amdgcn_fence(__ATOMIC_RELEASE, "agent");
            asm volatile("s_waitcnt vmcnt(0)" ::: "memory");
            const unsigned og = xb_add(&bar[XB_TOP], 1u);
            const unsigned tg = og / nx;
            if (og + 1u == (tg + 1u) * nx) xb_add(&bar[XB_TOPGEN], 1u);
            else XB_SPIN(xb_ld(&bar[XB_TOPGEN]) == tg, bar);
            __builtin_amdgcn_fence(__ATOMIC_ACQUIRE, "agent");
            xb_add(&bar[XB_XGEN(b.x)], 1u);
            asm volatile("s_waitcnt vmcnt(0)" ::: "memory");
        } else {
            XB_SPIN(xb_ld(&bar[XB_XGEN(b.x)]) == gen, bar);
            __builtin_amdgcn_fence(__ATOMIC_ACQUIRE, "agent");
            asm volatile("s_waitcnt vmcnt(0)" ::: "memory");
        }
    }
    __syncthreads();
}

constexpr int N_PHASES = 17;
template <bool COOP>
__global__ void __launch_bounds__(NTHREADS, 2) mk_fwd(Args args) {
    extern __shared__ __attribute__((aligned(16))) unsigned char lds[];
    Frame F;
    F.lds = (LAS unsigned char*)lds;
    F.tid = threadIdx.x; F.lane = F.tid & 63; F.wave = __builtin_amdgcn_readfirstlane(F.tid >> 6); F.G = gridDim.x; F.bid = blockIdx.x;
    F.in = args.in; F.out = args.out; F.ws = args.ws;
    volatile LAS unsigned* misc = (volatile LAS unsigned*)(F.lds + MISC_OFF);
    if (F.tid < 16) misc[F.tid] = 0u;
    __syncthreads();
    XcdBarrier xbar; xbar.bar = (unsigned*)(args.ws + WS_CTL); xbar.x = 0; xbar.st = nullptr;
    if (COOP) xbar = xcd_barrier_post((unsigned*)(args.ws + WS_CTL), misc + 8);
    Frame F0 = F;
    for (int ph = args.ph_lo; ph < args.ph_hi; ++ph) {
        if (PROBE_PH >= 0 && F0.bid == 0 && F0.wave == 0) ((volatile LAS unsigned long long*)(F0.lds + MISC_OFF + 128))[ph] = __builtin_amdgcn_s_memrealtime();
        Frame F = F0;
        F.lane = 0; F.tid = 0;
        asm volatile("" : "+s"(F.wave), "+s"(F.bid), "+s"(F.G));
        F.z = 0; asm volatile("" : "+s"(F.z));
        F.ws = F0.ws + F.z; F.out = F0.out + F.z;
        int g0 = 0, g1 = 0;
        switch (ph) {
        case 1: g0 = 0; g1 = 1; break;
        case 2: if (F.G == 256 && F.bid >= 192) { g0 = 9; g1 = 10; } break;
        case 3: g0 = 1; g1 = 2; break;
        case 5: g0 = 2; g1 = 3; break;
        case 6: g0 = 3; g1 = 4; break;
        case 8: g0 = 4; g1 = 5; break;
        case 10: g0 = 5; g1 = 6; break;
        case 12: g0 = 6; g1 = 7; break;
        case 14: g0 = 7; g1 = 8; break;
        case 15: g0 = 8; g1 = 9; break;
        default: break;
        }
        if (g1 > g0) {
#pragma unroll 1
            for (int gi = g0; gi < g1; ++gi) run_gemm(F, gi);
            if (ph == 2) scan_late_tail(F);
        } else {
            switch (ph) {
            case 0: phase_prep(with_ids<1>(F)); break;
            case 2: phase_scan(with_ids<2>(F)); break;
            case 4: phase_rowpass(with_ids<3>(F), 0); break;
            case 7: phase_rowpass(with_ids<4>(F), 1); break;
            case 9: phase_mlarow(with_ids<5>(F)); break;
            case 11: phase_attn(with_ids<6>(F)); break;
            case 13: phase_rowpass(with_ids<7>(F), 2); break;
            default: phase_rowpass(with_ids<8>(F), 3); break;
            }
        }
        if (COOP) { if (ph + 1 < args.ph_hi) { xcd_barrier(xbar); } }
    }
    if (PROBE_PH >= 0 && F0.bid == 0 && F0.wave == 0) {
        volatile LAS unsigned long long* ts = (volatile LAS unsigned long long*)(F0.lds + MISC_OFF + 128);
        const unsigned long long tend = __builtin_amdgcn_s_memrealtime();
        const unsigned long long t1 = (PROBE_PH + 1 < args.ph_hi) ? ts[PROBE_PH + 1] : tend;
        const unsigned long long wait = (t1 - ts[PROBE_PH]) * PROBE_MULT;
        while (__builtin_amdgcn_s_memrealtime() - tend < wait) __builtin_amdgcn_s_sleep(8);
    }
}

extern "C" void kernel_launch(void* const* d_in, const int* in_sizes, int n_in, void* d_out, int out_size, void* d_ws, size_t ws_size, hipStream_t stream) {
    static int grid = 0;
    if (grid == 0) {
        if (n_in != 21 || (size_t)out_size != O_END || ws_size < WS_END) { fprintf(stderr, "kernel_launch: unexpected sizes n_in %d out %d (want %zu) ws %zu (need %zu)\n", n_in, out_size, (size_t)O_END, ws_size, (size_t)WS_END); grid = -1; return; }
        int dev = 0, cus = 0, per_cu = 0;
        hipGetDevice(&dev); hipDeviceGetAttribute(&cus, hipDeviceAttributeMultiprocessorCount, dev);
        hipFuncSetAttribute((const void*)mk_fwd<true>, hipFuncAttributeMaxDynamicSharedMemorySize, LDS_BYTES);
        hipFuncSetAttribute((const void*)mk_fwd<false>, hipFuncAttributeMaxDynamicSharedMemorySize, LDS_BYTES);
        hipOccupancyMaxActiveBlocksPerMultiprocessor(&per_cu, (const void*)mk_fwd<true>, NTHREADS, LDS_BYTES);
        (void)hipGetLastError();
        if (per_cu < 1) { fprintf(stderr, "kernel_launch: the occupancy query reports %d workgroups per CU for this kernel: it cannot be made resident, nothing launched\n", per_cu); grid = -1; return; }
        if (cus != 256) { fprintf(stderr, "kernel_launch: built for a 256-CU device (one main GEMM unit per CU in the fused residual epilogues, sample-row units on the last 64 workgroups of the scan phase); this device reports %d CUs, nothing launched\n", cus); grid = -1; return; }
        grid = cus;
    }
    if (grid < 0) return;
    if (hipMemsetAsync((char*)d_ws + WS_CTL, 0, CTL_BYTES, stream) != hipSuccess) { fprintf(stderr, "kernel_launch: memset of the barrier words failed\n"); return; }
    Args a{};
    for (int i = 0; i < 21; ++i) a.in[i] = (const float*)d_in[i];
    a.out = (float*)d_out; a.ws = (unsigned char*)d_ws;
#if MK_ONE_LAUNCH
    a.ph_lo = 0; a.ph_hi = N_PHASES;
    void* kargs[] = {&a};
    hipError_t e = hipLaunchCooperativeKernel((const void*)mk_fwd<true>, dim3(grid), dim3(NTHREADS), kargs, LDS_BYTES, stream);
    if (e != hipSuccess) fprintf(stderr, "cooperative launch failed: %s (grid %d)\n", hipGetErrorString(e), grid);
#else
    for (int ph = 0; ph < N_PHASES; ++ph) {
        a.ph_lo = ph; a.ph_hi = ph + 1;
        hipLaunchKernelGGL(mk_fwd<false>, dim3(grid), dim3(NTHREADS), LDS_BYTES, stream, a);
    }
#endif
}
```
